# Optimizing an MI355X kernel written in HIP

```python
import math
import jax
import jax.numpy as jnp
from jax import lax
import numpy as np

D_MODEL = 2048
BATCH = 2
SEQ = 4096
DEPTH = 2

GRID_W = 64
CTX_LEN = 256
EPS = 1e-6
ROPE_THETA = 10000.0

A_HEADS = 4
A_DK = 64
A_DV = 128
A_WIDTH = A_HEADS * A_DV
A_QK_COLS = A_HEADS * 2 * A_DK
Q_BLOCK = 128

B_WIDTH = 512

C_HEADS = 8
C_KV_HEADS = 2
C_GROUP = C_HEADS // C_KV_HEADS
C_DH = 128
C_WIDTH = C_HEADS * C_DH
C_KV_COLS = C_KV_HEADS * C_DH
WINDOW = 128
BAND_BLOCK = 128

MIX_WIDTH = A_WIDTH + B_WIDTH + C_WIDTH
GROUP_COLS = (A_QK_COLS, A_QK_COLS, A_WIDTH, B_WIDTH, B_WIDTH, B_WIDTH, C_WIDTH, C_KV_COLS, C_KV_COLS)
IN_COLS = sum(GROUP_COLS)
SPLIT_AT = tuple(int(v) for v in np.cumsum(GROUP_COLS)[:-1])

D_FF = 5632
N_EXPERTS = 8
TOP_K = 2
D_FF_EXPERT = 7168
N_DENSE = (DEPTH + 1) // 2
N_MOE = DEPTH // 2

kernel_name = 'hybrid_parallel_heads_diffusion_block'


def rms_norm(x, g):
    xf = x.astype(jnp.float32)
    y = xf * lax.rsqrt(jnp.mean(xf * xf, axis=-1, keepdims=True) + EPS)
    return (y * g.astype(jnp.float32)).astype(x.dtype)


def axial_rope_tables(n_tok, dh):
    rows = n_tok // GRID_W
    row = jnp.repeat(jnp.arange(rows, dtype=jnp.float32), GRID_W)
    col = jnp.tile(jnp.arange(GRID_W, dtype=jnp.float32), rows)
    half = dh // 2
    inv = ROPE_THETA ** (-jnp.arange(0, half, 2, dtype=jnp.float32) / half)
    ar = row[:, None] * inv[None, :]
    ac = col[:, None] * inv[None, :]
    ang = jnp.concatenate([ar, ar, ac, ac], axis=-1)
    return jnp.cos(ang), jnp.sin(ang)


def apply_rope(x, cos, sin):
    x1, x2, x3, x4 = jnp.split(x, 4, axis=-1)
    rot = jnp.concatenate([-x2, x1, -x4, x3], axis=-1)
    bshape = (x.shape[1],) + (1,) * (x.ndim - 3) + (x.shape[-1],)
    out = x.astype(jnp.float32) * cos.reshape(bshape) + rot.astype(jnp.float32) * sin.reshape(bshape)
    return out.astype(x.dtype)


def split_heads(p, qn_a, kn_a, qn_c, kn_c):
    b, n = p.shape[0], p.shape[1]
    a_q, a_k, a_v, b_b, b_c, b_x, c_q, c_k, c_v = jnp.split(p, SPLIT_AT, axis=-1)
    a_q = rms_norm(a_q.reshape(b, n, A_HEADS, 2, A_DK), qn_a)
    a_k = rms_norm(a_k.reshape(b, n, A_HEADS, 2, A_DK), kn_a)
    a_v = a_v.reshape(b, n, A_HEADS, A_DV)
    c_q = rms_norm(c_q.reshape(b, n, C_KV_HEADS, C_GROUP, C_DH), qn_c)
    c_k = rms_norm(c_k.reshape(b, n, C_KV_HEADS, C_DH), kn_c)
    c_v = c_v.reshape(b, n, C_KV_HEADS, C_DH)
    return a_q, a_k, a_v, b_b, b_c, b_x, c_q, c_k, c_v


def diff_lambda(lq1, lk1, lq2, lk2, lam_init):
    f = lambda u, v: jnp.exp(jnp.sum(u.astype(jnp.float32) * v.astype(jnp.float32)))
    return f(lq1, lk1) - f(lq2, lk2) + lam_init


def diff_attend(q, keys, vals, lam):
    s = jnp.einsum('bqhcd,bkhcd->bhcqk', q, keys, preferred_element_type=jnp.float32) * (A_DK ** -0.5)
    p = jax.nn.softmax(s, axis=-1)
    w = p[:, :, 0] - lam * p[:, :, 1]
    return jnp.einsum('bhqk,bkhd->bqhd', w.astype(vals.dtype), vals)


def diff_attention_latent(q, keys, vals, lam):
    b, s = q.shape[0], q.shape[1]
    nb = s // Q_BLOCK
    qb = jnp.moveaxis(q.reshape((b, nb, Q_BLOCK) + q.shape[2:]), 1, 0)
    out = lax.map(lambda qi: diff_attend(qi, keys, vals, lam), qb)
    return jnp.moveaxis(out, 0, 1).reshape(b, s, A_HEADS, A_DV)


def short_conv3(u, w):
    up = jnp.pad(u, ((0, 0), (1, 1), (0, 0)))
    return up[:, :-2] * w[0] + up[:, 1:-1] * w[1] + up[:, 2:] * w[2]


def banded(t):
    b, s = t.shape[0], t.shape[1]
    nb = s // BAND_BLOCK
    tb = t.reshape((b, nb, BAND_BLOCK) + t.shape[2:])
    tp = jnp.pad(tb, ((0, 0), (1, 1), (0, 0), (0, 0), (0, 0)))
    return jnp.concatenate([tp[:, :-2], tp[:, 1:-1], tp[:, 2:]], axis=2)


def band_mask(nb):
    a = jnp.arange(BAND_BLOCK)[:, None]
    j = jnp.arange(3 * BAND_BLOCK)[None, :]
    in_win = jnp.abs(j - a - BAND_BLOCK) <= WINDOW
    blk = jnp.arange(nb)[:, None] - 1 + (jnp.arange(3 * BAND_BLOCK) // BAND_BLOCK)[None, :]
    valid = (blk >= 0) & (blk < nb)
    return in_win[None] & valid[:, None, :]


def softmax_with_sink(s, sink_b):
    sk = jnp.broadcast_to(sink_b, s.shape[:-1] + (1,))
    return jax.nn.softmax(jnp.concatenate([s, sk], axis=-1), axis=-1)[..., :-1]


def window_attention_latent(q, k, v, k_ctx, v_ctx, sink):
    b, s = q.shape[0], q.shape[1]
    nb = s // BAND_BLOCK
    scale = C_DH ** -0.5
    qb = q.reshape(b, nb, BAND_BLOCK, C_KV_HEADS, C_GROUP, C_DH)
    kb, vb = banded(k), banded(v)
    s_loc = jnp.einsum('bnqkgd,bnjkd->bnkgqj', qb, kb, preferred_element_type=jnp.float32) * scale
    s_loc = jnp.where(band_mask(nb)[None, :, None, None], s_loc, -jnp.inf)
    s_ctx = jnp.einsum('bnqkgd,bjkd->bnkgqj', qb, k_ctx, preferred_element_type=jnp.float32) * scale
    sink_b = sink.astype(jnp.float32).reshape(1, 1, C_KV_HEADS, C_GROUP, 1, 1)
    p = softmax_with_sink(jnp.concatenate([s_loc, s_ctx], axis=-1), sink_b)
    n_loc = 3 * BAND_BLOCK
    o = (jnp.einsum('bnkgqj,bnjkd->bnqkgd', p[..., :n_loc].astype(v.dtype), vb)
         + jnp.einsum('bnkgqj,bjkd->bnqkgd', p[..., n_loc:].astype(v.dtype), v_ctx))
    return o.reshape(b, s, C_WIDTH)


def window_attention_context(q, k, v, sink):
    b, n = q.shape[0], q.shape[1]
    s = jnp.einsum('bqkgd,bjkd->bkgqj', q, k, preferred_element_type=jnp.float32) * (C_DH ** -0.5)
    p = softmax_with_sink(s, sink.astype(jnp.float32).reshape(1, C_KV_HEADS, C_GROUP, 1, 1))
    o = jnp.einsum('bkgqj,bjkd->bqkgd', p.astype(v.dtype), v)
    return o.reshape(b, n, C_WIDTH)


def swiglu(h, w1, w3, w2):
    return (jax.nn.silu(h @ w1) * (h @ w3)) @ w2


def moe_swiglu(h, w_r, w1, w3, w2):
    logits = (h @ w_r).astype(jnp.float32)
    top_v, top_i = lax.top_k(logits, TOP_K)
    gates = jax.nn.softmax(top_v, axis=-1)
    weight = jnp.sum(jax.nn.one_hot(top_i, N_EXPERTS, dtype=jnp.float32) * gates[..., None], axis=-2)
    y = jnp.zeros_like(h)
    for e in range(N_EXPERTS):
        y = y + weight[..., e:e + 1].astype(h.dtype) * swiglu(h, w1[e], w3[e], w2[e])
    return y


def setup_inputs(seed: int = 0) -> dict:
    key = jax.random.key(seed)
    ks = iter(jax.random.split(key, 32))
    f32 = jnp.float32
    D = D_MODEL

    def nrm(shape, scale):
        return jax.random.normal(next(ks), shape, f32) * scale

    def gain(shape):
        return 1.0 + 0.02 * jax.random.normal(next(ks), shape, f32)

    return {
        'x': nrm((BATCH, SEQ, D), 1.0),
        'c': nrm((BATCH, D), 1.0),
        'ctx': nrm((BATCH, CTX_LEN, D), 1.0),
        'c_ctx': nrm((D,), 1.0),
        'ada_w': nrm((DEPTH, D, 6 * D), 0.5 * D ** -0.5),
        'ada_b': nrm((DEPTH, 6 * D), 0.02),
        'norm_mix_g': gain((DEPTH, D)),
        'norm_ffn_g': gain((DEPTH, D)),
        'w_in': nrm((DEPTH, D, IN_COLS), D ** -0.5),
        'w_out': nrm((DEPTH, MIX_WIDTH, D), MIX_WIDTH ** -0.5),
        'a_q_norm': gain((DEPTH, A_DK)),
        'a_k_norm': gain((DEPTH, A_DK)),
        'a_lam_q1': nrm((DEPTH, A_DK), 0.1),
        'a_lam_k1': nrm((DEPTH, A_DK), 0.1),
        'a_lam_q2': nrm((DEPTH, A_DK), 0.1),
        'a_lam_k2': nrm((DEPTH, A_DK), 0.1),
        'a_subln_g': gain((DEPTH, A_DV)),
        'b_conv_w': nrm((DEPTH, 3, B_WIDTH), 3 ** -0.5),
        'b_out_g': gain((DEPTH, B_WIDTH)),
        'c_q_norm': gain((DEPTH, C_DH)),
        'c_k_norm': gain((DEPTH, C_DH)),
        'c_sink': nrm((DEPTH, C_HEADS), 0.5),
        'c_out_g': gain((DEPTH, C_WIDTH)),
        'ffn_w1': nrm((N_DENSE, D, D_FF), D ** -0.5),
        'ffn_w3': nrm((N_DENSE, D, D_FF), D ** -0.5),
        'ffn_w2': nrm((N_DENSE, D_FF, D), D_FF ** -0.5),
        'router_w': nrm((N_MOE, D, N_EXPERTS), D ** -0.5),
        'moe_w1': nrm((N_MOE, N_EXPERTS, D, D_FF_EXPERT), D ** -0.5),
        'moe_w3': nrm((N_MOE, N_EXPERTS, D, D_FF_EXPERT), D ** -0.5),
        'moe_w2': nrm((N_MOE, N_EXPERTS, D_FF_EXPERT, D), D_FF_EXPERT ** -0.5),
    }


def reference(x, c, ctx, c_ctx, ada_w, ada_b, norm_mix_g, norm_ffn_g, w_in, w_out,
              a_q_norm, a_k_norm, a_lam_q1, a_lam_k1, a_lam_q2, a_lam_k2, a_subln_g,
              b_conv_w, b_out_g, c_q_norm, c_k_norm, c_sink, c_out_g,
              ffn_w1, ffn_w3, ffn_w2, router_w, moe_w1, moe_w3, moe_w2):
    B, S, _ = x.shape
    L = ctx.shape[1]
    cos_a, sin_a = axial_rope_tables(S, A_DK)
    cos_c, sin_c = axial_rope_tables(S, C_DH)
    xc = ctx
    for l in range(DEPTH):
        last = l == DEPTH - 1
        mod = jax.nn.silu(c) @ ada_w[l] + ada_b[l]
        mod_c = jax.nn.silu(c_ctx) @ ada_w[l] + ada_b[l]
        sh_a, sc_a, g_a, sh_f, sc_f, g_f = [m[:, None, :] for m in jnp.split(mod, 6, axis=-1)]
        csh_a, csc_a, cg_a, csh_f, csc_f, cg_f = jnp.split(mod_c, 6, axis=-1)

        h = rms_norm(x, norm_mix_g[l]) * (1 + sc_a) + sh_a
        hc = rms_norm(xc, norm_mix_g[l]) * (1 + csc_a) + csh_a
        proj = jnp.concatenate([hc, h], axis=1) @ w_in[l]
        norms = (a_q_norm[l], a_k_norm[l], c_q_norm[l], c_k_norm[l])
        aq, ak, av, bb, bc, bx, cq, ck, cv = split_heads(proj[:, L:], *norms)
        aqc, akc, avc, bbc, bcc, bxc, cqc, ckc, cvc = split_heads(proj[:, :L], *norms)
        aq, ak = apply_rope(aq, cos_a, sin_a), apply_rope(ak, cos_a, sin_a)
        cq, ck = apply_rope(cq, cos_c, sin_c), apply_rope(ck, cos_c, sin_c)

        lam_init = 0.8 - 0.6 * math.exp(-0.3 * l)
        lam = diff_lambda(a_lam_q1[l], a_lam_k1[l], a_lam_q2[l], a_lam_k2[l], lam_init)

        ya = diff_attention_latent(aq, jnp.concatenate([ak, akc], axis=1),
                                   jnp.concatenate([av, avc], axis=1), lam)
        ya = (rms_norm(ya, a_subln_g[l]) * (1 - lam_init)).reshape(B, S, A_WIDTH)
        yb = rms_norm(bb * short_conv3(bc * bx, b_conv_w[l]), b_out_g[l])
        yc = rms_norm(window_attention_latent(cq, ck, cv, ckc, cvc, c_sink[l]), c_out_g[l])
        x = x + g_a * (jnp.concatenate([ya, yb, yc], axis=-1) @ w_out[l])

        if not last:
            ya_c = (rms_norm(diff_attend(aqc, akc, avc, lam), a_subln_g[l]) * (1 - lam_init)).reshape(B, L, A_WIDTH)
            yb_c = rms_norm(bbc * short_conv3(bcc * bxc, b_conv_w[l]), b_out_g[l])
            yc_c = rms_norm(window_attention_context(cqc, ckc, cvc, c_sink[l]), c_out_g[l])
            xc = xc + cg_a * (jnp.concatenate([ya_c, yb_c, yc_c], axis=-1) @ w_out[l])

        h2 = rms_norm(x, norm_ffn_g[l]) * (1 + sc_f) + sh_f
        if not last:
            h2c = rms_norm(xc, norm_ffn_g[l]) * (1 + csc_f) + csh_f
            tokens = jnp.concatenate([h2c, h2], axis=1)
        else:
            tokens = h2
        i = l // 2
        if l % 2 == 0:
            y = swiglu(tokens, ffn_w1[i], ffn_w3[i], ffn_w2[i])
        else:
            y = moe_swiglu(tokens, router_w[i], moe_w1[i], moe_w3[i], moe_w2[i])
        if not last:
            xc = xc + cg_f * y[:, :L]
            x = x + g_f * y[:, L:]
        else:
            x = x + g_f * y
    return x
```

```cpp
#include <hip/hip_runtime.h>
#include <cstdio>
#include <cstdint>

#ifndef MK_N_LAUNCHES
#define MK_N_LAUNCHES 1
#endif

#define GAS __attribute__((address_space(1)))
#define LAS __attribute__((address_space(3)))
typedef unsigned short bf16;
typedef short bf16x8 __attribute__((ext_vector_type(8)));
typedef float f32x4 __attribute__((ext_vector_type(4)));
typedef float f32x16 __attribute__((ext_vector_type(16)));
typedef unsigned u32x4 __attribute__((ext_vector_type(4)));
typedef unsigned u32x2 __attribute__((ext_vector_type(2)));

typedef const float* const __attribute__((address_space(4)))* KArgP;
__device__ __forceinline__ unsigned char* karg_ws() { return (unsigned char*)((const void* const __attribute__((address_space(4)))*)__builtin_amdgcn_kernarg_segment_ptr())[31]; }
__device__ __forceinline__ const float* karg_in(int i) { return ((KArgP)__builtin_amdgcn_kernarg_segment_ptr())[i]; }
__device__ __forceinline__ int hide_tid() { int t = threadIdx.x; asm volatile("" : "+v"(t)); return t; }
namespace pg8 {
#define PG8_LAS __attribute__((address_space(3)))
typedef unsigned short bf16_t;
constexpr int BM = 256, BK = 64, HALF = 128, HTB = HALF * BK * 2, STAGE_BYTES = 8 * HTB, NXCD = 8, WGM = 8;

__host__ __device__ __forceinline__ int lds_byte(int r, int c) { const int st = (r >> 4) * 2 + (c >> 5), rr = r & 15, cc = c & 31, ob = rr * 64 + cc * 2; return st * 1024 + (ob ^ (((ob >> 9) & 1) << 5)); }
__host__ __device__ __forceinline__ void stage_rc(int b, int& R, int& C) { const int st = b / 1024, sb = b % 1024, swz = sb ^ (((sb >> 9) & 1) << 5); R = (st >> 1) * 16 + swz / 64; C = (st & 1) * 32 + (swz % 64) / 2; }
__host__ __device__ __forceinline__ int perm32(int rho) { const int n = rho >> 4, i = rho & 15; return 8 * (i >> 2) + 4 * n + (i & 3); }

struct Unit { int pm, pn, pb, kt0, nk, split, tslot, keep, cpart; };
struct Gemm { const bf16_t* A; const bf16_t* Bt; int K; };

struct StaticOrder {
    int nM, nN, nwg, G, c, nkfull;
    __device__ void init(int nM_, int nN_, int G_, int c_, int nk_) { nM = nM_; nN = nN_; nwg = nM * nN; G = G_; c = c_; nkfull = nk_; }
    __device__ void map(int L, Unit& u) const {
        int wgid = L; { const int q = nwg / NXCD, r = nwg % NXCD, xcd = wgid % NXCD, off = wgid / NXCD; wgid = (xcd < r ? xcd * (q + 1) : r * (q + 1) + (xcd - r) * q) + off; }
        const int nig = WGM * nN, gid = wgid / nig, fm = gid * WGM, gsz = (nM - fm) < WGM ? (nM - fm) : WGM;
        u.pm = fm + ((wgid % nig) % gsz); u.pn = (wgid % nig) / gsz; u.pb = u.pn; u.kt0 = 0; u.nk = nkfull; u.split = 0; u.tslot = 0; u.keep = 0; u.cpart = 0;
    }
    __device__ bool next(int i, Unit& u) const { const long L = (long)i * G + c; if (L >= nwg) return false; map((int)L, u); return true; }
};
struct CtxTailOrder {
    StaticOrder so; int SK, two;
    __device__ bool next(int i, Unit& u) const {
        const int L = i * so.G + so.c;
        if (L < so.nwg) { so.map(L, u); u.pm += 2; u.keep = two ? 1 : 0; return true; }
        const int s = L - so.nwg; if (s >= 16 * SK) return false;
        const int tu = s / SK, ks = s - tu * SK;
        u.pm = tu >> 3; u.pn = tu & 7; u.pb = u.pn; u.nk = so.nkfull / SK; u.kt0 = ks * u.nk; u.split = 1; u.tslot = s; u.keep = 0; u.cpart = (two && u.kt0 >= so.nkfull / 2) ? 1 : 0; return true;
    }
};
struct MoeOrder {
    StaticOrder so; const int* pexp;
    __device__ bool next(int i, Unit& u) const { if (!so.next(i, u)) return false; u.pb = __builtin_amdgcn_readfirstlane(pexp[u.pm]) * so.nN + u.pn; return true; }
};
struct MoeTailOrder {
    StaticOrder so; const int* pexp; int NF, R, SK;
    __device__ bool next(int i, Unit& u) const {
        const int L = i * so.G + so.c;
        if (L < NF) { so.map(L, u); }
        else { const int s = L - NF; if (s >= R * SK) return false; const int tu = s / SK, ks = s - tu * SK;
            so.map(NF + tu, u); u.nk = so.nkfull / SK; u.kt0 = ks * u.nk; u.split = 1; u.tslot = s; }
        u.pb = __builtin_amdgcn_readfirstlane(pexp[u.pm]) * so.nN + u.pn; return true;
    }
};
template <class Base> struct RangeOrder {
    Base so; int i0, n;
    __device__ bool next(int i, Unit& u) const { return i < n && so.next(i0 + i, u); }
};
__device__ __forceinline__ void moe_tail_params(int npan, int nN, int G, int& NF, int& R, int& SK) {
    const int total = npan * nN; NF = (total / G) * G; R = total - NF;
    SK = 1; if (R > 0) { if (R * 7 <= G) SK = 7; else if (R * 4 <= G) SK = 4; else if (R * 2 <= G) SK = 2; }
}

typedef int v8i32 __attribute__((ext_vector_type(8)));
typedef int v4i32 __attribute__((ext_vector_type(4)));
__device__ __forceinline__ v8i32 cat8(const bf16x8 lo, const bf16x8 hi) { const v4i32 a = __builtin_bit_cast(v4i32, lo), b = __builtin_bit_cast(v4i32, hi); return (v8i32){a[0], a[1], a[2], a[3], b[0], b[1], b[2], b[3]}; }
__device__ __forceinline__ unsigned pk4_fp8(float a, float b, float c, float d) {
    a = __builtin_amdgcn_fmed3f(a, -448.f, 448.f); b = __builtin_amdgcn_fmed3f(b, -448.f, 448.f); c = __builtin_amdgcn_fmed3f(c, -448.f, 448.f); d = __builtin_amdgcn_fmed3f(d, -448.f, 448.f);
    int p = __builtin_amdgcn_cvt_pk_fp8_f32(a, b, 0, false); p = __builtin_amdgcn_cvt_pk_fp8_f32(c, d, p, true); return (unsigned)p; }
constexpr float S_H = 16.f, S_W13 = 512.f, S_ACT = 8.f, S_W2 = 1024.f, DS1 = 1.0f / (16.f * 512.f), DS2 = 1.0f / (8.f * 1024.f);
__device__ __forceinline__ unsigned cvt_pk_bf16(float lo, float hi) { unsigned r; asm volatile("v_cvt_pk_bf16_f32 %0, %1, %2" : "=v"(r) : "v"(lo), "v"(hi)); return r; }

__device__ __forceinline__ void slab_store(float* slab, const f32x4 (&acc)[2][2][4][2], const f32x4 (&gv)[2][2], const Unit& u, int wr, int wc, int fr, int fq) {
    float* P = slab + (size_t)u.tslot * 65536 + (wr * 64 + fr) * 256 + wc * 32 + 4 * fq;
#pragma unroll
    for (int ai = 0; ai < 2; ++ai)
#pragma unroll
        for (int m = 0; m < 4; ++m)
#pragma unroll
            for (int bj = 0; bj < 2; ++bj)
#pragma unroll
                for (int n = 0; n < 2; ++n) *(f32x4*)(P + (ai * HALF + m * 16) * 256 + bj * HALF + n * 16) = gv[bj][n] * acc[ai][bj][m][n];
}
template <bool P> struct EpiStoreBf16T {
    static constexpr bool PERM = P;
    bf16_t* O; int ldc; float* slab; float ds;
    __device__ __forceinline__ void operator()(const f32x4 (&acc)[2][2][4][2], const Unit& u, int wr, int wc, int fr, int fq) const {
        if (!P && u.split) { const f32x4 one = {ds, ds, ds, ds}; const f32x4 gv[2][2] = {{one, one}, {one, one}}; slab_store(slab, acc, gv, u, wr, wc, fr, fq); return; }
        const int row0 = u.pm * BM + wr * 64 + fr, col0 = u.pn * BM + wc * 32 + (P ? 8 * fq : 4 * fq);
#pragma unroll
        for (int ai = 0; ai < 2; ++ai)
#pragma unroll
            for (int m = 0; m < 4; ++m) { bf16_t* rowp = O + (size_t)(row0 + ai * HALF + m * 16) * ldc + col0;
#pragma unroll
                for (int bj = 0; bj < 2; ++bj) { const f32x4 v0 = acc[ai][bj][m][0] * ds, v1 = acc[ai][bj][m][1] * ds;
                    if (P) { u32x4 w; w.x = cvt_pk_bf16(v0[0], v0[1]); w.y = cvt_pk_bf16(v0[2], v0[3]); w.z = cvt_pk_bf16(v1[0], v1[1]); w.w = cvt_pk_bf16(v1[2], v1[3]);
                        *(u32x4*)(rowp + bj * HALF) = w; }
                    else { u32x2 w0, w1; w0.x = cvt_pk_bf16(v0[0], v0[1]); w0.y = cvt_pk_bf16(v0[2], v0[3]); w1.x = cvt_pk_bf16(v1[0], v1[1]); w1.y = cvt_pk_bf16(v1[2], v1[3]);
                        *(u32x2*)(rowp + bj * HALF) = w0; *(u32x2*)(rowp + bj * HALF + 16) = w1; } } }
    }
};
typedef EpiStoreBf16T<true> EpiStoreBf16;
__device__ __forceinline__ float silu_mul(float a, float b) { return a * __builtin_amdgcn_rcpf(1.0f + __builtin_amdgcn_exp2f(-1.4426950408889634f * a)) * b; }
struct EpiSwiglu {
    static constexpr bool PERM = true;
    bf16_t* O; int ldc;
    __device__ __forceinline__ void operator()(const f32x4 (&acc)[2][2][4][2], const Unit& u, int wr, int wc, int fr, int fq) const {
        const int row0 = u.pm * BM + wr * 64 + fr, col0 = u.pn * HALF + wc * 32 + 8 * fq;
#pragma unroll
        for (int ai = 0; ai < 2; ++ai)
#pragma unroll
            for (int m = 0; m < 4; ++m) { bf16_t* rowp = O + (size_t)(row0 + ai * HALF + m * 16) * ldc + col0;
                const f32x4 a0 = acc[ai][0][m][0], a1 = acc[ai][0][m][1], b0 = acc[ai][1][m][0], b1 = acc[ai][1][m][1];
                u32x4 w; w.x = cvt_pk_bf16(silu_mul(a0[0], b0[0]), silu_mul(a0[1], b0[1])); w.y = cvt_pk_bf16(silu_mul(a0[2], b0[2]), silu_mul(a0[3], b0[3]));
                w.z = cvt_pk_bf16(silu_mul(a1[0], b1[0]), silu_mul(a1[1], b1[1])); w.w = cvt_pk_bf16(silu_mul(a1[2], b1[2]), silu_mul(a1[3], b1[3]));
                *(u32x4*)rowp = w; }
    }
};
template <bool IN8> struct EpiSwiglu8T {
    static constexpr bool PERM = true;
    unsigned char* O; int ldc;
    __device__ __forceinline__ void operator()(const f32x4 (&acc)[2][2][4][2], const Unit& u, int wr, int wc, int fr, int fq) const {
        const int row0 = u.pm * BM + wr * 64 + fr, col0 = u.pn * HALF + wc * 32 + 8 * fq;
#pragma unroll
        for (int ai = 0; ai < 2; ++ai)
#pragma unroll
            for (int m = 0; m < 4; ++m) { unsigned char* rowp = O + (size_t)(row0 + ai * HALF + m * 16) * ldc + col0;
                const float da = IN8 ? DS1 : 1.0f, db = IN8 ? DS1 * S_ACT : S_ACT;
                const f32x4 a0 = acc[ai][0][m][0] * da, a1 = acc[ai][0][m][1] * da, b0 = acc[ai][1][m][0] * db, b1 = acc[ai][1][m][1] * db;
                u32x2 w; w.x = pk4_fp8(silu_mul(a0[0], b0[0]), silu_mul(a0[1], b0[1]), silu_mul(a0[2], b0[2]), silu_mul(a0[3], b0[3]));
                w.y = pk4_fp8(silu_mul(a1[0], b1[0]), silu_mul(a1[1], b1[1]), silu_mul(a1[2], b1[2]), silu_mul(a1[3], b1[3]));
                *(u32x2*)rowp = w; }
    }
};
typedef EpiSwiglu8T<true> EpiSwiglu8;
struct EpiSwigluI8 {
    static constexpr bool PERM = true, SCALES = true;
    unsigned char* O; int ldc; const float* rs; const float* cs;
    __device__ __forceinline__ void stage_scales(PG8_LAS unsigned char* slot, const Unit& u, int tid) const {
        const float* src = tid < 256 ? rs + u.pm * BM + tid : cs + u.pb * BM + (tid - 256);
        __builtin_amdgcn_global_load_lds((const unsigned*)src, (PG8_LAS unsigned*)(slot + (tid >> 6) * 256), 4, 0, 0);
    }
    __device__ __forceinline__ void operator()(const f32x4 (&acc)[2][2][4][2], const Unit& u, int wr, int wc, int fr, int fq, const PG8_LAS unsigned char* slot) const {
        const int row0 = u.pm * BM + wr * 64 + fr, col0 = u.pn * HALF + wc * 32 + 8 * fq;
        const PG8_LAS float* rsl = (const PG8_LAS float*)slot + wr * 64 + fr;
        const PG8_LAS float* csp = (const PG8_LAS float*)slot + 256 + wc * 32 + 8 * fq;
        const float L2E = 1.4426950408889634f;
        const f32x4 ka0 = *(const PG8_LAS f32x4*)csp * -L2E, ka1 = *(const PG8_LAS f32x4*)(csp + 4) * -L2E, kb0 = *(const PG8_LAS f32x4*)(csp + HALF) * (-S_ACT / L2E), kb1 = *(const PG8_LAS f32x4*)(csp + HALF + 4) * (-S_ACT / L2E);
#pragma unroll
        for (int ai = 0; ai < 2; ++ai)
#pragma unroll
            for (int m = 0; m < 4; ++m) { const int row = row0 + ai * HALF + m * 16; const float r = rsl[ai * HALF + m * 16];
                unsigned char* rowp = ldc < 0 ? O + ((size_t)(u.pm * (-ldc) + u.pn) * BM + (row - u.pm * BM)) * 128 + (col0 - u.pn * HALF) : O + (size_t)row * ldc + col0;
                const f32x4 fa0 = __builtin_convertvector(__builtin_bit_cast(v4i32, acc[ai][0][m][0]), f32x4), fa1 = __builtin_convertvector(__builtin_bit_cast(v4i32, acc[ai][0][m][1]), f32x4);
                const f32x4 fb0 = __builtin_convertvector(__builtin_bit_cast(v4i32, acc[ai][1][m][0]), f32x4), fb1 = __builtin_convertvector(__builtin_bit_cast(v4i32, acc[ai][1][m][1]), f32x4);
                const f32x4 a0 = (fa0 * r) * ka0, a1 = (fa1 * r) * ka1, b0 = (fb0 * r) * kb0, b1 = (fb1 * r) * kb1;
                f32x4 e0, e1;
#pragma unroll
                for (int j = 0; j < 4; ++j) { e0[j] = __builtin_amdgcn_exp2f(a0[j]); e1[j] = __builtin_amdgcn_exp2f(a1[j]); }
                e0 = e0 + 1.0f; e1 = e1 + 1.0f;
#pragma unroll
                for (int j = 0; j < 4; ++j) { e0[j] = __builtin_amdgcn_rcpf(e0[j]); e1[j] = __builtin_amdgcn_rcpf(e1[j]); }
                const f32x4 v0 = (a0 * b0) * e0, v1 = (a1 * b1) * e1;
                u32x2 w; w.x = pk4_fp8(v0[0], v0[1], v0[2], v0[3]); w.y = pk4_fp8(v1[0], v1[1], v1[2], v1[3]);
                *(u32x2*)rowp = w; }
    }
};
struct EpiStoreI8 {
    static constexpr bool PERM = true, SCALES = true;
    bf16_t* O; int ldc; const float* rs; const float* cs;
    __device__ __forceinline__ void stage_scales(PG8_LAS unsigned char* slot, const Unit& u, int tid) const {
        const float* src = tid < 256 ? rs + u.pm * BM + tid : cs + u.pb * BM + (tid - 256);
        __builtin_amdgcn_global_load_lds((const unsigned*)src, (PG8_LAS unsigned*)(slot + (tid >> 6) * 256), 4, 0, 0);
    }
    __device__ __forceinline__ void operator()(const f32x4 (&acc)[2][2][4][2], const Unit& u, int wr, int wc, int fr, int fq, const PG8_LAS unsigned char* slot) const {
        const int row0 = u.pm * BM + wr * 64 + fr, col0 = u.pn * BM + wc * 32 + 8 * fq;
        const PG8_LAS float* rsl = (const PG8_LAS float*)slot + wr * 64 + fr;
        const PG8_LAS float* csp = (const PG8_LAS float*)slot + 256 + wc * 32 + 8 * fq;
        f32x4 c[2][2];
#pragma unroll
        for (int bj = 0; bj < 2; ++bj)
#pragma unroll
            for (int n = 0; n < 2; ++n) c[bj][n] = *(const PG8_LAS f32x4*)(csp + bj * HALF + 4 * n);
#pragma unroll
        for (int ai = 0; ai < 2; ++ai)
#pragma unroll
            for (int m = 0; m < 4; ++m) { const float r = rsl[ai * HALF + m * 16]; bf16_t* rowp = O + (size_t)(row0 + ai * HALF + m * 16) * ldc + col0;
#pragma unroll
                for (int bj = 0; bj < 2; ++bj) {
                    const f32x4 v0 = (__builtin_convertvector(__builtin_bit_cast(v4i32, acc[ai][bj][m][0]), f32x4) * r) * c[bj][0], v1 = (__builtin_convertvector(__builtin_bit_cast(v4i32, acc[ai][bj][m][1]), f32x4) * r) * c[bj][1];
                    u32x4 w; w.x = cvt_pk_bf16(v0[0], v0[1]); w.y = cvt_pk_bf16(v0[2], v0[3]); w.z = cvt_pk_bf16(v1[0], v1[1]); w.w = cvt_pk_bf16(v1[2], v1[3]);
                    *(u32x4*)(rowp + bj * HALF) = w; } }
    }
};
template <class E> struct has_mid { template <class T> static constexpr bool f(decltype(T::MID)*) { return T::MID; } template <class T> static constexpr bool f(...) { return false; } static constexpr bool value = f<E>(nullptr); };
template <class E> struct has_scales { template <class T> static constexpr bool f(decltype(T::SCALES)*) { return T::SCALES; } template <class T> static constexpr bool f(...) { return false; } static constexpr bool value = f<E>(nullptr); };
constexpr int SCALE_SLOT_OFF = STAGE_BYTES, SCALE_SLOT_BYTES = 2048;
constexpr size_t SSQ_OFF = (size_t)3 << 20;
template <bool FIRST, bool MIDC> struct EpiResidT {
    static constexpr bool PERM = false, MID = MIDC;
    bf16_t* X; const float* modl; int chunk; float* slab; float ds;
    __device__ __forceinline__ float rowfac(int row) const { const float* ssq = (const float*)(karg_ws() + SSQ_OFF);
        const f32x4 s0 = *(const f32x4*)(ssq + (size_t)row * 8), s1 = *(const f32x4*)(ssq + (size_t)row * 8 + 4);
        return __builtin_amdgcn_rsqf(((s0[0] + s0[1]) + (s0[2] + s0[3]) + (s1[0] + s1[1]) + (s1[2] + s1[3])) * (1.0f / 1024.0f) + 1e-6f); }
    __device__ __forceinline__ void mid(f32x4 (&acc)[2][2][4][2], const Unit& u, int wr, int wc, int fr, int fq) const {
        const int row0 = u.pm * BM + wr * 64 + fr;
#pragma unroll
        for (int ai = 0; ai < 2; ++ai)
#pragma unroll
            for (int m = 0; m < 4; ++m) { const float r = rowfac(row0 + ai * HALF + m * 16);
#pragma unroll
                for (int bj = 0; bj < 2; ++bj)
#pragma unroll
                    for (int n = 0; n < 2; ++n) acc[ai][bj][m][n] = acc[ai][bj][m][n] * r;
                asm volatile("" ::: "memory"); }
    }
    __device__ __forceinline__ void operator()(const f32x4 (&acc)[2][2][4][2], const Unit& u, int wr, int wc, int fr, int fq) const {
        const int pmg = u.pm, v = pmg < 2 ? 2 : ((pmg - 2) >> 4);
        const float* gate = modl + v * 12288 + chunk * 2048;
        const int row0 = pmg * BM + wr * 64 + fr, col0 = u.pn * BM + wc * 32 + 4 * fq;
        f32x4 gv[2][2];
#pragma unroll
        for (int bj = 0; bj < 2; ++bj)
#pragma unroll
            for (int n = 0; n < 2; ++n) gv[bj][n] = *(const f32x4*)(gate + col0 + bj * HALF + n * 16) * ds;
        if (u.split) {
            float* P = slab + (size_t)u.tslot * 65536 + (wr * 64 + fr) * 256 + wc * 32 + 4 * fq;
#pragma unroll
            for (int ai = 0; ai < 2; ++ai)
#pragma unroll
                for (int m = 0; m < 4; ++m) { const float r = (MIDC && u.cpart) ? rowfac(row0 + ai * HALF + m * 16) : 1.0f;
#pragma unroll
                    for (int bj = 0; bj < 2; ++bj)
#pragma unroll
                        for (int n = 0; n < 2; ++n) *(f32x4*)(P + (ai * HALF + m * 16) * 256 + bj * HALF + n * 16) = gv[bj][n] * acc[ai][bj][m][n] * r;
                    asm volatile("" ::: "memory"); }
            return; }
        const float* xin = FIRST ? (pmg < 2 ? karg_in(2) : karg_in(0) - (size_t)512 * 2048) : nullptr;
#pragma unroll
        for (int ai = 0; ai < 2; ++ai)
#pragma unroll
            for (int m = 0; m < 4; ++m) { const size_t ro = (size_t)(row0 + ai * HALF + m * 16) * 2048 + col0;
#pragma unroll
                for (int bj = 0; bj < 2; ++bj)
#pragma unroll
                    for (int n = 0; n < 2; ++n) { const size_t o = ro + bj * HALF + n * 16; f32x4 b;
                        if (FIRST) b = *(const f32x4*)(xin + o);
                        else { const u32x2 w = *(const u32x2*)(X + o); b = (f32x4){__builtin_bit_cast(float, w.x << 16), __builtin_bit_cast(float, w.x & 0xffff0000u), __builtin_bit_cast(float, w.y << 16), __builtin_bit_cast(float, w.y & 0xffff0000u)}; }
                        b = b + gv[bj][n] * acc[ai][bj][m][n];
                        u32x2 w2; w2.x = cvt_pk_bf16(b[0], b[1]); w2.y = cvt_pk_bf16(b[2], b[3]); *(u32x2*)(X + o) = w2; } }
    }
};

template <int MODE  , class Epi, class Sched, bool BLK = false>
__device__ __forceinline__ void gemm_phase(PG8_LAS unsigned char* lds, const Gemm g, const Sched& S, const Epi& E) {
    const int tid = hide_tid(), wid = __builtin_amdgcn_readfirstlane(tid >> 6), lane = tid & 63, wr = wid >> 2, wc = wid & 3, fr = lane & 15, fq = lane >> 4;
    const int K = g.K;
    unsigned voffA[2], voffB[2];
#pragma unroll
    for (int i = 0; i < 2; ++i) { int R, C; stage_rc(tid * 16 + i * 8192, R, C); const int Rb = Epi::PERM ? ((R & ~31) + perm32(R & 31)) : R;
        voffA[i] = BLK ? (unsigned)(R * 64 + C) * 2u : (unsigned)(R * K + C) * 2u; voffB[i] = BLK ? (unsigned)(Rb * 64 + C) * 2u : (unsigned)(Rb * K + C) * 2u; }
    const size_t kstep = BLK ? (size_t)(BM * BK * 2) : (size_t)(BK * 2);
    const size_t hstep = BLK ? (size_t)(HALF * BK * 2) : (size_t)HALF * K * 2;
    const size_t tstep = (size_t)BM * K * 2;
    const unsigned ldsw = (unsigned)wid * 1024u;
    const int aoff = lds_byte(wr * 64 + fr, fq * 8), boff = lds_byte(wc * 32 + fr, fq * 8);
#define PG8_SA(b, h) (((b) * 2 + (h)) * HTB)
#define PG8_SB(b, h) ((4 + (b) * 2 + (h)) * HTB)
#define PG8_STAGE(bufoff, gbase, voff) do { _Pragma("unroll") for (int _i = 0; _i < 2; ++_i) { unsigned _o = (voff)[_i]; asm volatile("" : "+v"(_o)); \
        __builtin_amdgcn_global_load_lds((const unsigned*)((const char*)(gbase) + _o), (PG8_LAS unsigned*)(lds + (bufoff) + ldsw + _i * 8192), 16, 0, 0); } } while (0)
#define PG8_LDA(dst, b, h) do { _Pragma("unroll") for (int m = 0; m < 4; ++m) _Pragma("unroll") for (int k = 0; k < 2; ++k) dst[m][k] = *(const PG8_LAS bf16x8*)(lds + PG8_SA(b, h) + aoff + m * 2048 + k * 1024); } while (0)
#define PG8_LDB(dst, b, h) do { _Pragma("unroll") for (int n = 0; n < 2; ++n) _Pragma("unroll") for (int k = 0; k < 2; ++k) dst[n][k] = *(const PG8_LAS bf16x8*)(lds + PG8_SB(b, h) + boff + n * 2048 + k * 1024); } while (0)
#define PG8_MMA(ai, bj, At, Bt) do { __builtin_amdgcn_s_setprio(1); _Pragma("unroll") for (int m = 0; m < 4; ++m) _Pragma("unroll") for (int n = 0; n < 2; ++n) { \
        if constexpr (MODE == 1) { acc[ai][bj][m][n] = __builtin_amdgcn_mfma_scale_f32_16x16x128_f8f6f4(cat8(Bt[n][0], Bt[n][1]), cat8(At[m][0], At[m][1]), acc[ai][bj][m][n], 0, 0, 0, 0, 0, 0); } \
        else if constexpr (MODE == 2) { _Pragma("unroll") for (int k = 0; k < 2; ++k) acc[ai][bj][m][n] = __builtin_bit_cast(f32x4, __builtin_amdgcn_mfma_i32_16x16x64_i8(__builtin_bit_cast(v4i32, Bt[n][k]), __builtin_bit_cast(v4i32, At[m][k]), __builtin_bit_cast(v4i32, acc[ai][bj][m][n]), 0, 0, 0)); } \
        else { _Pragma("unroll") for (int k = 0; k < 2; ++k) acc[ai][bj][m][n] = __builtin_amdgcn_mfma_f32_16x16x32_bf16(Bt[n][k], At[m][k], acc[ai][bj][m][n], 0, 0, 0); } } \
        __builtin_amdgcn_s_setprio(0); } while (0)
#define PG8_WAIT_V(n) asm volatile("s_waitcnt vmcnt(" #n ")" ::: "memory")
#define PG8_WAIT_L(n) asm volatile("s_waitcnt lgkmcnt(" #n ")" ::: "memory")
#define PG8_BAR __builtin_amdgcn_s_barrier()
#define PG8_SCHED __builtin_amdgcn_sched_barrier(0)
    Unit cur, nxt; int ui = 0;
    if (!S.next(0, cur)) return;
    f32x4 acc[2][2][4][2];
#pragma unroll
    for (int a = 0; a < 2; ++a)
#pragma unroll
        for (int b = 0; b < 2; ++b)
#pragma unroll
            for (int m = 0; m < 4; ++m)
#pragma unroll
                for (int n = 0; n < 2; ++n) acc[a][b][m][n] = (f32x4){0.f, 0.f, 0.f, 0.f};
    bf16x8 At[4][2], B0[2][2], B1[2][2];
    const char* cA = (const char*)g.A + (size_t)cur.pm * tstep + (size_t)cur.kt0 * kstep; const char* cB = (const char*)g.Bt + (size_t)cur.pb * tstep + (size_t)cur.kt0 * kstep;
#define PG8_WOFS(u) ((has_mid<Epi>::value && (u).keep) ? (size_t)((u).nk / 2) * kstep : (size_t)0)
    const char* fA = cA + PG8_WOFS(cur); const char* fB = cB + PG8_WOFS(cur);
    if constexpr (has_scales<Epi>::value) E.stage_scales(lds + SCALE_SLOT_OFF, cur, tid);
    PG8_STAGE(PG8_SB(0, 0), fB, voffB); PG8_STAGE(PG8_SB(0, 1), fB + hstep, voffB); PG8_STAGE(PG8_SA(0, 0), fA, voffA); PG8_STAGE(PG8_SA(0, 1), fA + hstep, voffA);
    if (wr == 1) PG8_BAR;
    PG8_WAIT_V(2); PG8_BAR;
    PG8_STAGE(PG8_SB(1, 0), fB + kstep, voffB); PG8_STAGE(PG8_SA(1, 0), fA + kstep, voffA); PG8_STAGE(PG8_SB(1, 1), fB + hstep + kstep, voffB);
    PG8_WAIT_V(6); PG8_BAR;
    for (;;) {
        const bool has_next = S.next(ui + 1, nxt);
        const char* nA0 = has_next ? (const char*)g.A + (size_t)nxt.pm * tstep + (size_t)nxt.kt0 * kstep : cA; const char* nB0 = has_next ? (const char*)g.Bt + (size_t)nxt.pb * tstep + (size_t)nxt.kt0 * kstep : cB;
        const char* nA = has_next ? nA0 + PG8_WOFS(nxt) : fA; const char* nB = has_next ? nB0 + PG8_WOFS(nxt) : fB;
        const int nt = cur.nk;
        const bool wrapu = has_mid<Epi>::value && cur.keep; const int halfk = nt >> 1;
        for (int t = 0; t < nt; t += 2) {
            const bool last = (t == nt - 2);
#define PG8_KOFF(tt) ((size_t)(wrapu ? ((tt) < halfk ? (tt) + halfk : (tt) - halfk) : (tt)) * kstep)
            const char* a1 = cA + PG8_KOFF(t + 1);
            const char* a2 = last ? nA : cA + PG8_KOFF(t + 2); const char* b2 = last ? nB : cB + PG8_KOFF(t + 2);
            const char* a3 = a2 + kstep; const char* b3 = b2 + kstep;
            if constexpr (has_mid<Epi>::value) { if (wrapu && t == halfk) { const int tz = hide_tid(), wz = __builtin_amdgcn_readfirstlane(tz >> 6), lz = tz & 63; E.mid(acc, cur, wz >> 2, wz & 3, lz & 15, lz >> 4); } }
            if constexpr (has_scales<Epi>::value) { if (last && has_next) E.stage_scales(lds + SCALE_SLOT_OFF + ((ui + 1) & 1) * SCALE_SLOT_BYTES, nxt, tid); }
            PG8_LDB(B0, 0, 0); PG8_LDB(B1, 0, 1); PG8_SCHED; PG8_LDA(At, 0, 0); PG8_STAGE(PG8_SA(1, 1), a1 + hstep, voffA);
            PG8_WAIT_V(8); PG8_WAIT_L(0); PG8_BAR; PG8_MMA(0, 0, At, B0); PG8_MMA(0, 1, At, B1); PG8_BAR; PG8_SCHED;
            PG8_LDA(At, 0, 1); PG8_STAGE(PG8_SB(0, 0), b2, voffB); PG8_STAGE(PG8_SB(0, 1), b2 + hstep, voffB); PG8_STAGE(PG8_SA(0, 0), a2, voffA);
            PG8_WAIT_V(8); PG8_WAIT_L(0); PG8_BAR; PG8_MMA(1, 0, At, B0); PG8_MMA(1, 1, At, B1); PG8_BAR; PG8_SCHED;
            PG8_LDB(B0, 1, 0); PG8_LDB(B1, 1, 1); PG8_SCHED; PG8_LDA(At, 1, 0); PG8_STAGE(PG8_SA(0, 1), a2 + hstep, voffA);
            PG8_WAIT_V(8); PG8_WAIT_L(0); PG8_BAR; PG8_MMA(0, 0, At, B0); PG8_MMA(0, 1, At, B1); PG8_BAR; PG8_SCHED;
            PG8_LDA(At, 1, 1); PG8_STAGE(PG8_SB(1, 0), b3, voffB); PG8_STAGE(PG8_SB(1, 1), b3 + hstep, voffB); PG8_STAGE(PG8_SA(1, 0), a3, voffA);
            PG8_WAIT_V(8); PG8_WAIT_L(0); PG8_BAR; PG8_MMA(1, 0, At, B0); PG8_MMA(1, 1, At, B1); PG8_BAR; PG8_SCHED;
        }
        if (wr == 0) PG8_BAR;
        { const int tz = hide_tid(), wz = __builtin_amdgcn_readfirstlane(tz >> 6), lz = tz & 63;
          if constexpr (has_scales<Epi>::value) E(acc, cur, wz >> 2, wz & 3, lz & 15, lz >> 4, lds + SCALE_SLOT_OFF + (ui & 1) * SCALE_SLOT_BYTES);
          else E(acc, cur, wz >> 2, wz & 3, lz & 15, lz >> 4); }
        if (!has_next) break;
#pragma unroll
        for (int a = 0; a < 2; ++a)
#pragma unroll
            for (int b = 0; b < 2; ++b)
#pragma unroll
                for (int m = 0; m < 4; ++m)
#pragma unroll
                    for (int n = 0; n < 2; ++n) acc[a][b][m][n] = (f32x4){0.f, 0.f, 0.f, 0.f};
        cur = nxt; cA = nA0; cB = nB0; fA = nA; fB = nB; ++ui;
        if (wr == 1) PG8_BAR;
    }
    PG8_WAIT_V(0);
    PG8_BAR;
#undef PG8_SA
#undef PG8_WOFS
#undef PG8_KOFF
#undef PG8_SB
#undef PG8_STAGE
#undef PG8_LDA
#undef PG8_LDB
#undef PG8_MMA
#undef PG8_WAIT_V
#undef PG8_WAIT_L
#undef PG8_BAR
#undef PG8_SCHED
}
}

constexpr int D = 2048, NB = 2, SEQ = 4096, LCTX = 256, NKEY = SEQ + LCTX;
constexpr int MROWS = NB * NKEY;
constexpr int INC = 4608, MIXW = 2048, DFF = 5632, NEXP = 8, DFFE = 7168;
constexpr int C_AQ = 0, C_AK = 512, C_AV = 1024, C_BB = 1536, C_BC = 2048, C_BX = 2560, C_CQ = 3072, C_CK = 4096, C_CV = 4352;
constexpr float EPS = 1e-6f;
constexpr int MAXSLOT = 2 * NB * SEQ + NEXP * 256;
constexpr int NWAVES = 8, NTHR = 512;

constexpr size_t MiB = 1u << 20;
constexpr size_t WS_CTL = 0, CTL_ZERO_BYTES = 128 * 1024;
constexpr size_t WS_MOD = 1 * MiB;
constexpr size_t WS_TOK = 2 * MiB;
constexpr size_t WS_CSM = 2 * MiB + 512 * 1024;
constexpr size_t WS_RSS = 3 * MiB + 576 * 1024;
constexpr size_t WS_RS = 3 * MiB + 512 * 1024;
constexpr size_t WS_CS = 3 * MiB + 768 * 1024;
constexpr size_t WS_CSIN = 3 * MiB + 832 * 1024;
constexpr size_t WS_SSQ = 3 * MiB; static_assert(WS_SSQ == pg8::SSQ_OFF, "SSQ offset");
constexpr size_t WS_WIN = 4 * MiB;
constexpr size_t WS_WOUT = WS_WIN + (size_t)2 * INC * D * 2;
constexpr size_t WS_WF13 = WS_WOUT + (size_t)2 * D * D * 2;
constexpr size_t WS_WF2 = WS_WF13 + (size_t)2 * DFF * D * 2;
constexpr size_t WS_WM13 = WS_WF2 + (size_t)D * DFF * 2;
constexpr size_t WS_WM2 = WS_WM13 + (size_t)NEXP * 2 * DFFE * D * 2;
constexpr size_t WS_XW = WS_WM2 + (size_t)NEXP * D * DFFE * 2;
constexpr size_t WS_HB = WS_XW + (size_t)MROWS * D * 4;
constexpr size_t WS_PROJ = WS_HB + (size_t)MROWS * D * 2;
constexpr size_t WS_VTA = WS_PROJ + (size_t)MROWS * INC * 2;
constexpr size_t WS_VTC = WS_VTA + (size_t)NB * 4 * 128 * NKEY * 2;
constexpr size_t WS_MIX = WS_VTC + (size_t)NB * 2 * 128 * NKEY * 2;
constexpr size_t WS_ACT = WS_MIX + (size_t)MROWS * MIXW * 2;
constexpr size_t WS_HPERM = WS_ACT + (size_t)MAXSLOT * DFFE * 2;
constexpr size_t WS_YS = WS_HPERM + (size_t)MAXSLOT * D * 2;
constexpr size_t WS_SLAB = WS_YS + (size_t)MAXSLOT * D * 2;
constexpr size_t WS_END = WS_SLAB + (size_t)256 * 65536 * 4;
constexpr int CW_BAR = 4096;
constexpr int CW_CNT = 16384;
constexpr int CW_TMODE = 24576;
constexpr int CW_PEXP = 20480;

constexpr int LDS_BYTES = 147456;
constexpr int MISC_OFF = LDS_BYTES - 256;

__device__ __forceinline__ unsigned f2bf(float f) { unsigned u = __builtin_bit_cast(unsigned, f); return (u + 0x7fffu + ((u >> 16) & 1u)) >> 16; }
__device__ __forceinline__ unsigned pk2(float lo, float hi) { return pg8::cvt_pk_bf16(lo, hi); }
__device__ __forceinline__ float bflo(unsigned w) { return __builtin_bit_cast(float, w << 16); }
__device__ __forceinline__ float bfhi(unsigned w) { return __builtin_bit_cast(float, w & 0xffff0000u); }
__device__ __forceinline__ float wave_sum(float v) {
#pragma unroll
    for (int o = 1; o < 64; o <<= 1) v += __shfl_xor(v, o);
    return v;
}
__device__ __forceinline__ void unpack8(const u32x4 w, float (&f)[8]) { f[0] = bflo(w.x); f[1] = bfhi(w.x); f[2] = bflo(w.y); f[3] = bfhi(w.y); f[4] = bflo(w.z); f[5] = bfhi(w.z); f[6] = bflo(w.w); f[7] = bfhi(w.w); }
__device__ __forceinline__ u32x4 pack8(const float (&f)[8]) { u32x4 w; w.x = pk2(f[0], f[1]); w.y = pk2(f[2], f[3]); w.z = pk2(f[4], f[5]); w.w = pk2(f[6], f[7]); return w; }
__device__ __forceinline__ int rowmap(int b, int j) { return j < LCTX ? b * LCTX + j : 2 * LCTX + b * SEQ + (j - LCTX); }

#define XB_TMO      128
#define XB_XCNT(j)  (256  + 64 * (j))
#define XB_XSUB(j)  (1280 + 64 * (j))
#define XB_XGEN(j)  (2304 + 64 * (j))
#define XB_TOP      3328
#define XB_TOPGEN   3392
#define XCD_BAR_WORDS 3456
#define XB_SPIN_CAP (1u << 18)
__device__ __forceinline__ unsigned xb_ld(unsigned* p)              { return __hip_atomic_load(p, __ATOMIC_RELAXED, __HIP_MEMORY_SCOPE_AGENT); }
__device__ __forceinline__ unsigned xb_add(unsigned* p, unsigned v) { return __hip_atomic_fetch_add(p, v, __ATOMIC_RELAXED, __HIP_MEMORY_SCOPE_AGENT); }
__device__ __forceinline__ unsigned xb_xcc_id() { return (unsigned)__builtin_amdgcn_s_getreg((3 << 11) | 20) & 0xFu; }
#define XB_SPIN(cond, bar) do { unsigned _sp = 0; while (cond) { __builtin_amdgcn_s_sleep(1); \
    if ((++_sp & 255u) == 0u) { if (xb_ld(&(bar)[XB_TMO])) break; if (_sp > XB_SPIN_CAP) { atomicAdd(&(bar)[XB_TMO], 1u); break; } } } } while (0)
struct XcdBarrier { unsigned* bar; unsigned x; volatile LAS unsigned* st; };
__device__ __forceinline__ XcdBarrier xcd_barrier_post(unsigned* bar, volatile LAS unsigned* st) {
    XcdBarrier b; b.bar = bar; b.x = xb_xcc_id(); b.st = st;
    if (threadIdx.x == 0) (void)xb_add(&bar[XB_XCNT(b.x)], 1u);
    return b;
}
__device__ __forceinline__ void xcd_barrier_complete(unsigned* bar, unsigned x, unsigned& nloc, unsigned& nx) {
    const unsigned G = gridDim.x * gridDim.y * gridDim.z;
    unsigned sum, cnt, mine, sp = 0u;
    for (;;) {
        sum = 0u; cnt = 0u; mine = 0u;
#pragma unroll
        for (unsigned j = 0; j < 16; ++j) { const unsigned c = xb_ld(&bar[XB_XCNT(j)]); sum += c; cnt += (c > 0u) ? 1u : 0u; mine = (j == x) ? c : mine; }
        if (sum == G) break;
        __builtin_amdgcn_s_sleep(1);
        if ((++sp & 255u) == 0u) { if (xb_ld(&bar[XB_TMO])) break; if (sp > XB_SPIN_CAP) { atomicAdd(&bar[XB_TMO], 1u); break; } }
    }
    nloc = mine > 0u ? mine : 1u; nx = cnt > 0u ? cnt : 1u;
}
__device__ __forceinline__ void xcd_barrier(const XcdBarrier& b) {
    asm volatile("s_waitcnt vmcnt(0)" ::: "memory");
    __syncthreads();
    if (threadIdx.x == 0) {
        unsigned* bar = b.bar;
        __builtin_amdgcn_s_waitcnt(0);
        unsigned nloc = b.st[0], nx = b.st[1];
        if (nloc == 0u) { xcd_barrier_complete(bar, b.x, nloc, nx); b.st[0] = nloc; b.st[1] = nx; }
        const unsigned old = xb_add(&bar[XB_XSUB(b.x)], 1u);
        const unsigned gen = old / nloc;
        if (old + 1u == (gen + 1u) * nloc) {
            __builtin_amdgcn_fence(__ATOMIC_RELEASE, "agent");
            asm volatile("s_waitcnt vmcnt(0)" ::: "memory");
            const unsigned og = xb_add(&bar[XB_TOP], 1u);
            const unsigned tg = og / nx;
            if (og + 1u == (tg + 1u) * nx) xb_add(&bar[XB_TOPGEN], 1u);
            else XB_SPIN(xb_ld(&bar[XB_TOPGEN]) == tg, bar);
            __builtin_amdgcn_fence(__ATOMIC_ACQUIRE, "agent");
            xb_add(&bar[XB_XGEN(b.x)], 1u);
            asm volatile("s_waitcnt vmcnt(0)" ::: "memory");
        } else {
            XB_SPIN(xb_ld(&bar[XB_XGEN(b.x)]) == gen, bar);
            __builtin_amdgcn_fence(__ATOMIC_ACQUIRE, "agent");
            asm volatile("s_waitcnt vmcnt(0)" ::: "memory");
        }
    }
    __syncthreads();
}

struct Args { const float* in[30]; float* out; unsigned char* ws; int ph_lo, ph_hi; };
typedef const __attribute__((address_space(4))) Args* ArgsP;


__device__ __forceinline__ void xpose_item(const float* __restrict__ W, int ldw, int k0, int n0, bf16* __restrict__ dst0, int ldd, LAS float* scr, int lane) {
    f32x4 v[16];
    const float* src = W + (size_t)(k0 + (lane >> 4)) * ldw + n0 + 4 * (lane & 15);
#pragma unroll
    for (int i = 0; i < 16; ++i) v[i] = __builtin_nontemporal_load((const f32x4*)(src + (size_t)(4 * i) * ldw));
#pragma unroll
    for (int i = 0; i < 16; ++i) { LAS float* s = scr + (4 * i + (lane >> 4)) * 65 + 4 * (lane & 15); s[0] = v[i][0]; s[1] = v[i][1]; s[2] = v[i][2]; s[3] = v[i][3]; }
    asm volatile("s_waitcnt lgkmcnt(0)" ::: "memory");
    const int c = lane & 7;
#pragma unroll
    for (int j = 0; j < 8; ++j) { const int n = (lane >> 3) + 8 * j; const LAS float* s = scr + (8 * c) * 65 + n;
        u32x4 o; o.x = pk2(s[0 * 65], s[1 * 65]); o.y = pk2(s[2 * 65], s[3 * 65]); o.z = pk2(s[4 * 65], s[5 * 65]); o.w = pk2(s[6 * 65], s[7 * 65]);
        __builtin_nontemporal_store(o, (u32x4*)(dst0 + (size_t)n * ldd + k0 + 8 * c)); }
    asm volatile("s_waitcnt lgkmcnt(0)" ::: "memory");
}
__device__ __forceinline__ void xpose_item8(const float* __restrict__ W, int ldw, int k0, int n0, unsigned char* __restrict__ dst0, int ldd, int kofs, float scale, LAS float* scr, int lane) {
    f32x4 v[16];
    const float* src = W + (size_t)(k0 + (lane >> 4)) * ldw + n0 + 4 * (lane & 15);
#pragma unroll
    for (int i = 0; i < 16; ++i) v[i] = __builtin_nontemporal_load((const f32x4*)(src + (size_t)(4 * i) * ldw));
#pragma unroll
    for (int i = 0; i < 16; ++i) { LAS float* s = scr + (4 * i + (lane >> 4)) * 65 + 4 * (lane & 15); s[0] = v[i][0] * scale; s[1] = v[i][1] * scale; s[2] = v[i][2] * scale; s[3] = v[i][3] * scale; }
    asm volatile("s_waitcnt lgkmcnt(0)" ::: "memory");
    const int c = lane & 3;
#pragma unroll
    for (int j = 0; j < 4; ++j) { const int n = (lane >> 2) + 16 * j; const LAS float* s = scr + (16 * c) * 65 + n;
        u32x4 o; o.x = pg8::pk4_fp8(s[0 * 65], s[1 * 65], s[2 * 65], s[3 * 65]); o.y = pg8::pk4_fp8(s[4 * 65], s[5 * 65], s[6 * 65], s[7 * 65]);
        o.z = pg8::pk4_fp8(s[8 * 65], s[9 * 65], s[10 * 65], s[11 * 65]); o.w = pg8::pk4_fp8(s[12 * 65], s[13 * 65], s[14 * 65], s[15 * 65]);
        __builtin_nontemporal_store(o, (u32x4*)(dst0 + (size_t)n * ldd + kofs + 16 * c)); }
    asm volatile("s_waitcnt lgkmcnt(0)" ::: "memory");
}
__device__ __forceinline__ void xpose_item_i8(const float* __restrict__ W, int ldw, int k0, int n0, unsigned char* __restrict__ dst0, int ldd, const float* __restrict__ cs, LAS float* scr, int lane) {
    f32x4 v[16];
    const float* src = W + (size_t)(k0 + (lane >> 4)) * ldw + n0 + 4 * (lane & 15);
#pragma unroll
    for (int i = 0; i < 16; ++i) v[i] = __builtin_nontemporal_load((const f32x4*)(src + (size_t)(4 * i) * ldw));
#pragma unroll
    for (int i = 0; i < 16; ++i) { LAS float* s = scr + (4 * i + (lane >> 4)) * 65 + 4 * (lane & 15); s[0] = v[i][0]; s[1] = v[i][1]; s[2] = v[i][2]; s[3] = v[i][3]; }
    asm volatile("s_waitcnt lgkmcnt(0)" ::: "memory");
    const int c = lane & 3;
#pragma unroll
    for (int j = 0; j < 4; ++j) { const int n = (lane >> 2) + 16 * j; const LAS float* s = scr + (16 * c) * 65 + n; const float d = cs[n], q = d > 1e-30f ? 1.0f / d : 0.f;
        unsigned o[4];
#pragma unroll
        for (int g = 0; g < 4; ++g) { int qi[4];
#pragma unroll
            for (int e = 0; e < 4; ++e) qi[e] = (int)rintf(__builtin_amdgcn_fmed3f(s[(4 * g + e) * 65] * q, -127.f, 127.f));
            o[g] = (unsigned)(qi[0] & 255) | ((unsigned)(qi[1] & 255) << 8) | ((unsigned)(qi[2] & 255) << 16) | ((unsigned)(qi[3] & 255) << 24); }
        __builtin_nontemporal_store((u32x4){o[0], o[1], o[2], o[3]}, (u32x4*)(dst0 + (size_t)n * ldd + k0 + 16 * c)); }
    asm volatile("s_waitcnt lgkmcnt(0)" ::: "memory");
}
__device__ __forceinline__ void xpose_mat8(const float* W, int K, int N, unsigned char* dst, bool ilv, int ilv_off, float scale, int item, LAS float* scr, int lane) {
    const int ntn = N >> 6, kb = item / ntn, nb = item - kb * ntn, k0 = kb * 64, n0 = nb * 64;
    const int drow = ilv ? ((n0 >> 7) * 256 + (n0 & 127) + ilv_off) : n0;
    xpose_item8(W, N, k0, n0, dst + ((size_t)((drow >> 8) * (K >> 7) + (k0 >> 7)) * 256 + (drow & 255)) * 128, 128, k0 & 127, scale, scr, lane);
}
__device__ __forceinline__ void xpose_mat(const float* W, int K, int N, bf16* dst, bool ilv, int ilv_off, int item, LAS float* scr, int lane) {
    const int ntn = N >> 6, kb = item / ntn, nb = item - kb * ntn, k0 = kb * 64, n0 = nb * 64;
    const int drow = ilv ? ((n0 >> 7) * 256 + (n0 & 127) + ilv_off) : n0;
    xpose_item(W, N, k0, n0, dst + (size_t)drow * K, K, scr, lane);
}
__device__ __forceinline__ float silu_f(float x) { return x / (1.0f + __expf(-x)); }

__device__ __forceinline__ void mod_strips(ArgsP a, LAS unsigned char* lds, int s0, int s1, int stride) {
    const int tid = hide_tid();
    unsigned char* ws = a->ws;
    LAS float* sc = (LAS float*)lds;
    LAS float* red = (LAS float*)(lds + 24576);
    if (s0 >= s1) return;
    for (int i = tid; i < 3 * D; i += NTHR) { const int v = i >> 11, k = i & 2047; const float x = v < 2 ? a->in[1][v * D + k] : a->in[3][k]; sc[i] = silu_f(x); }
    __syncthreads();
    float* MOD = (float*)(ws + WS_MOD);
    for (int s = s0; s < s1; s += stride) {
        const int l = s / 192, col0 = (s - l * 192) * 64, cg = tid & 15, kg = tid >> 4;
        const float* W = a->in[4] + (size_t)l * D * 12288 + col0 + 4 * cg;
        f32x4 acc0 = {0.f, 0.f, 0.f, 0.f}, acc1 = acc0, acc2 = acc0;
#pragma unroll 8
        for (int kk = 0; kk < 64; ++kk) { const int k = kg + 32 * kk; const f32x4 w = __builtin_nontemporal_load((const f32x4*)(W + (size_t)k * 12288));
            acc0 += w * sc[k]; acc1 += w * sc[2048 + k]; acc2 += w * sc[4096 + k]; }
#pragma unroll
        for (int j = 0; j < 4; ++j) { red[(kg * 3 + 0) * 64 + 4 * cg + j] = acc0[j]; red[(kg * 3 + 1) * 64 + 4 * cg + j] = acc1[j]; red[(kg * 3 + 2) * 64 + 4 * cg + j] = acc2[j]; }
        __syncthreads();
        if (tid < 192) { const int v = tid >> 6, c = tid & 63; float sum = 0.f;
#pragma unroll 8
            for (int g = 0; g < 32; ++g) sum += red[(g * 3 + v) * 64 + c];
            MOD[(l * 3 + v) * 12288 + col0 + c] = sum + a->in[5][l * 12288 + col0 + c]; }
        __syncthreads();
    }
}
constexpr int MOE_STRIPS = 2 * NEXP * (DFFE / 64);
__device__ __forceinline__ void moe_colscale_item(ArgsP a, int s, int lane) {
    unsigned char* ws = a->ws;
    const int ew = s / (DFFE / 64), n0 = (s - ew * (DFFE / 64)) * 64, e = ew >> 1, w = ew & 1;
    const int drow = e * 2 * DFFE + (n0 >> 7) * 256 + (n0 & 127) + w * 128;
    const float* src = a->in[27 + w] + (size_t)e * D * DFFE + (size_t)(32 * (lane >> 4)) * DFFE + n0 + 4 * (lane & 15);
    f32x4 mx = {0.f, 0.f, 0.f, 0.f};
#pragma unroll
    for (int i = 0; i < 16; ++i) { const f32x4 v = *(const f32x4*)(src + (size_t)(128 * i) * DFFE);
        mx[0] = fmaxf(mx[0], fabsf(v[0])); mx[1] = fmaxf(mx[1], fabsf(v[1])); mx[2] = fmaxf(mx[2], fabsf(v[2])); mx[3] = fmaxf(mx[3], fabsf(v[3])); }
#pragma unroll
    for (int j = 0; j < 4; ++j) { mx[j] = fmaxf(mx[j], __shfl_xor(mx[j], 16)); mx[j] = fmaxf(mx[j], __shfl_xor(mx[j], 32)); }
    if (lane < 16) *(f32x4*)((float*)(ws + WS_CSM) + drow + 4 * lane) = mx * (1.9f / 127.0f);
}
constexpr int CV_IN = (D / 64) * (INC / 64), CV_OUT = (D / 64) * (D / 64), CV_F1 = (D / 64) * (DFF / 64), CV_F2 = (DFF / 64) * (D / 64);
constexpr int CVA_N = MOE_STRIPS + CV_OUT, CVB_N = CV_F2 + CV_OUT;
constexpr int I8_STRIPS = 2 * (DFF / 32);
__device__ __forceinline__ void conv_a_item(ArgsP a, int it, LAS float* scr, int lane) {
    unsigned char* ws = a->ws;
    if (it < MOE_STRIPS) { moe_colscale_item(a, it, lane); return; } it -= MOE_STRIPS;
    xpose_mat(a->in[9], D, D, (bf16*)(ws + WS_WOUT), false, 0, it, scr, lane);
}
__device__ __forceinline__ void conv_b_item(ArgsP a, int it, LAS float* scr, int lane) {
    unsigned char* ws = a->ws;
    if (it < CV_F2) { xpose_mat8(a->in[25], DFF, D, ws + WS_WF2, false, 0, pg8::S_W2, it, scr, lane); return; } it -= CV_F2;
    xpose_mat(a->in[9] + (size_t)D * D, D, D, (bf16*)(ws + WS_WOUT) + (size_t)D * D, false, 0, it, scr, lane);
}
constexpr int WIN_STRIPS = INC / 32;
__device__ __forceinline__ void win_strip(ArgsP a, LAS unsigned char* lds, int l, int s);
__device__ __forceinline__ void phase_prologue(ArgsP a, LAS unsigned char* lds) {
    const int tid = hide_tid(), lane = tid & 63, wave = tid >> 6, G = gridDim.x;
    unsigned char* ws = a->ws;
    const int nmod = G > 192 ? 192 : G;
    if ((int)blockIdx.x < nmod) mod_strips(a, lds, (int)blockIdx.x, 192, nmod);
    __syncthreads();
    if (G > nmod) { for (int s = (int)blockIdx.x - nmod; s >= 0 && s < WIN_STRIPS; s += G - nmod) win_strip(a, lds, 0, s); }
    else for (int s = (int)blockIdx.x; s < WIN_STRIPS; s += G) win_strip(a, lds, 0, s);
}
template <bool SAMPLE>
__device__ __forceinline__ void i8_strip_core(const float* __restrict__ W0, int ldw, unsigned char* __restrict__ dst0, float* __restrict__ cs0, LAS unsigned char* lds) {
    const int tid = hide_tid(), lane = tid & 63, wave = tid >> 6;
    LAS float* scr = (LAS float*)(lds + wave * 16640);
    LAS float* cmax = (LAS float*)(lds + 8 * 16640);
    LAS float* csc = cmax + 512;
    const float* src = W0 + (size_t)(lane >> 4) * ldw + 4 * (lane & 15);
    f32x4 mx = {0.f, 0.f, 0.f, 0.f};
    for (int t = 0; t < (SAMPLE ? 1 : 4); ++t) { const int k0 = (wave + 8 * t) * 64;
#pragma unroll
        for (int i = 0; i < 16; ++i) { const f32x4 v = *(const f32x4*)(src + (size_t)(k0 + 4 * i) * ldw);
            mx[0] = fmaxf(mx[0], fabsf(v[0])); mx[1] = fmaxf(mx[1], fabsf(v[1])); mx[2] = fmaxf(mx[2], fabsf(v[2])); mx[3] = fmaxf(mx[3], fabsf(v[3])); } }
#pragma unroll
    for (int j = 0; j < 4; ++j) { mx[j] = fmaxf(mx[j], __shfl_xor(mx[j], 16)); mx[j] = fmaxf(mx[j], __shfl_xor(mx[j], 32)); }
    if (lane < 16) { cmax[wave * 64 + 4 * lane + 0] = mx[0]; cmax[wave * 64 + 4 * lane + 1] = mx[1]; cmax[wave * 64 + 4 * lane + 2] = mx[2]; cmax[wave * 64 + 4 * lane + 3] = mx[3]; }
    __syncthreads();
    if (tid < 64) { float m = 0.f;
#pragma unroll
        for (int q = 0; q < 8; ++q) m = fmaxf(m, cmax[q * 64 + tid]);
        if (SAMPLE) m *= 1.6f;
        csc[tid] = m > 1e-30f ? 127.0f / m : 0.f;
        cs0[tid] = m * (1.0f / 127.0f); }
    __syncthreads();
    f32x4 v[16], vn[16];
#pragma unroll
    for (int i = 0; i < 16; ++i) v[i] = __builtin_nontemporal_load((const f32x4*)(src + (size_t)(wave * 64 + 4 * i) * ldw));
#pragma unroll
    for (int t = 0; t < 4; ++t) { const int k0 = (wave + 8 * t) * 64;
        if (t < 3) {
#pragma unroll
            for (int i = 0; i < 16; ++i) vn[i] = __builtin_nontemporal_load((const f32x4*)(src + (size_t)(k0 + 512 + 4 * i) * ldw)); }
#pragma unroll
        for (int i = 0; i < 16; ++i) { LAS float* p = scr + (4 * i + (lane >> 4)) * 65 + 4 * (lane & 15); p[0] = v[i][0]; p[1] = v[i][1]; p[2] = v[i][2]; p[3] = v[i][3]; }
        asm volatile("s_waitcnt lgkmcnt(0)" ::: "memory");
        const int c = lane & 3;
#pragma unroll
        for (int j = 0; j < 4; ++j) { const int n = (lane >> 2) + 16 * j; const LAS float* p = scr + (16 * c) * 65 + n; const float q = csc[n];
            unsigned o[4];
#pragma unroll
            for (int g = 0; g < 4; ++g) { int qi[4];
#pragma unroll
                for (int e = 0; e < 4; ++e) qi[e] = (int)rintf(__builtin_amdgcn_fmed3f(p[(4 * g + e) * 65] * q, -127.f, 127.f));
                o[g] = (unsigned)(qi[0] & 255) | ((unsigned)(qi[1] & 255) << 8) | ((unsigned)(qi[2] & 255) << 16) | ((unsigned)(qi[3] & 255) << 24); }
            __builtin_nontemporal_store((u32x4){o[0], o[1], o[2], o[3]}, (u32x4*)(dst0 + (size_t)n * D + k0 + 16 * c)); }
        asm volatile("s_waitcnt lgkmcnt(0)" ::: "memory");
        if (t < 3) {
#pragma unroll
            for (int i = 0; i < 16; ++i) v[i] = vn[i]; }
    }
    __syncthreads();
}
__device__ __forceinline__ void i8_strip32(const float* __restrict__ W0, int ldw, unsigned char* __restrict__ dst0, float* __restrict__ cs0, LAS unsigned char* lds) {
    const int tid = hide_tid(), lane = tid & 63, wave = tid >> 6, wq = lane >> 3, wl = lane & 7;
    LAS unsigned* scr = (LAS unsigned*)(lds + wave * 16640);
    LAS float* cmax = (LAS float*)(lds + 8 * 16640);
    const float* src = W0 + (size_t)(wave * 256 + 4 * wq) * ldw + 4 * wl;
    f32x4 v[2][4][4];
#pragma unroll
    for (int t = 0; t < 2; ++t)
#pragma unroll
        for (int i = 0; i < 4; ++i)
#pragma unroll
            for (int r = 0; r < 4; ++r) v[t][i][r] = __builtin_nontemporal_load((const f32x4*)(src + (size_t)(128 * t + 32 * i + r) * ldw));
    f32x4 mx = {0.f, 0.f, 0.f, 0.f};
#pragma unroll
    for (int t = 0; t < 2; ++t)
#pragma unroll
        for (int i = 0; i < 4; ++i)
#pragma unroll
            for (int r = 0; r < 4; ++r)
#pragma unroll
                for (int e = 0; e < 4; ++e) mx[e] = fmaxf(mx[e], fabsf(v[t][i][r][e]));
#pragma unroll
    for (int e = 0; e < 4; ++e) { mx[e] = fmaxf(mx[e], __shfl_xor(mx[e], 8)); mx[e] = fmaxf(mx[e], __shfl_xor(mx[e], 16)); mx[e] = fmaxf(mx[e], __shfl_xor(mx[e], 32)); }
    if (wq == 0) { cmax[wave * 32 + 4 * wl + 0] = mx[0]; cmax[wave * 32 + 4 * wl + 1] = mx[1]; cmax[wave * 32 + 4 * wl + 2] = mx[2]; cmax[wave * 32 + 4 * wl + 3] = mx[3]; }
    __syncthreads();
    f32x4 q;
#pragma unroll
    for (int e = 0; e < 4; ++e) { float m = 0.f;
#pragma unroll
        for (int w = 0; w < 8; ++w) m = fmaxf(m, cmax[w * 32 + 4 * wl + e]);
        q[e] = m > 1e-30f ? 127.0f / m : 0.f;
        if (wave == 0 && wq == 0) cs0[4 * wl + e] = m * (1.0f / 127.0f); }
#pragma unroll
    for (int t = 0; t < 2; ++t) {
#pragma unroll
        for (int i = 0; i < 4; ++i)
#pragma unroll
            for (int e = 0; e < 4; ++e) { unsigned o = 0u;
#pragma unroll
                for (int r = 0; r < 4; ++r) o = __builtin_amdgcn_cvt_pk_u8_f32(__builtin_rintf(__builtin_amdgcn_fmed3f(v[t][i][r][e] * q[e], -127.f, 127.f)) + 128.0f, r, o);
                scr[(4 * wl + e) * 33 + 8 * i + wq] = o ^ 0x80808080u; }
        asm volatile("s_waitcnt lgkmcnt(0)" ::: "memory");
        const int c = lane & 7;
#pragma unroll
        for (int j = 0; j < 4; ++j) { const int n = (lane >> 3) + 8 * j; const LAS unsigned* s = scr + n * 33 + 4 * c;
            __builtin_nontemporal_store((u32x4){s[0], s[1], s[2], s[3]}, (u32x4*)(dst0 + (size_t)n * D + wave * 256 + 128 * t + 16 * c)); }
        asm volatile("s_waitcnt lgkmcnt(0)" ::: "memory");
    }
    __syncthreads();
}
__device__ __forceinline__ void i8_strip(ArgsP a, LAS unsigned char* lds, int s) {
    unsigned char* ws = a->ws;
    const int w = s / (DFF / 32), n0 = (s - w * (DFF / 32)) * 32;
    const int drow = (n0 >> 7) * 256 + (n0 & 127) + w * 128;
    i8_strip32(a->in[23 + w] + n0, DFF, ws + WS_WF13 + (size_t)drow * D, (float*)(ws + WS_CS) + drow, lds);
}
__device__ __forceinline__ void win_strip(ArgsP a, LAS unsigned char* lds, int l, int s) {
    unsigned char* ws = a->ws; const int n0 = s * 32;
    i8_strip32(a->in[8] + (size_t)l * D * INC + n0, INC, ws + WS_WIN + ((size_t)l * INC + n0) * D, (float*)(ws + WS_CSIN) + l * INC + n0, lds);
}
__device__ __forceinline__ void deferred_a(ArgsP a, LAS unsigned char* lds, int e, int nel) {
    const int tid = hide_tid(), lane = tid & 63, wave = tid >> 6;
    const int q = CVA_N / nel, r = CVA_N % nel, count = q + (e < r ? 1 : 0), first = e * q + (e < r ? e : r);
    LAS float* scr = (LAS float*)(lds + wave * 16640);
    for (int i = wave; i < count; i += NWAVES) conv_a_item(a, first + i, scr, lane);
}
constexpr int MOE_I = (D / 64) * (DFFE / 64);
constexpr int G1_STRIPS = 468;
constexpr int M1_G1 = 3432, M1_AT0 = 35936;
constexpr int G1_QUOTA = 17160;
__device__ __forceinline__ void quota(int seg0, int segn, int G, int c, int& first, int& count) { const int q = (segn + G - 1) / G; const int lo = c * q; first = seg0 + lo; count = lo >= segn ? 0 : (segn - lo < q ? segn - lo : q); }
struct MoeTile { const float* src; unsigned char* dst0; const float* cs; int ldw, ldd, k0; };
template <int which>
__device__ __forceinline__ MoeTile moe_tile(ArgsP a, int it, int lane) {
    unsigned char* ws = a->ws; MoeTile t;
    if (which == 0) { const int ew = it / MOE_I, r = it - ew * MOE_I, e = ew >> 1, w = ew & 1;
        const int ntn = DFFE >> 5, kb = r / ntn, nb = r - kb * ntn, k0 = kb * 128, n0 = nb * 32, drow = e * 2 * DFFE + (n0 >> 7) * 256 + (n0 & 127) + w * 128;
        t.ldw = DFFE; t.ldd = D; t.k0 = k0; t.src = a->in[27 + w] + (size_t)e * D * DFFE + (size_t)(k0 + 4 * (lane >> 3)) * DFFE + n0 + 4 * (lane & 7);
        t.dst0 = ws + WS_WM13 + (size_t)drow * D; t.cs = (const float*)(ws + WS_CSM) + drow + 4 * (lane & 7); }
    else { const int e = it / MOE_I, r = it - e * MOE_I, ntn = D >> 5, kb = r / ntn, nb = r - kb * ntn, k0 = kb * 128, n0 = nb * 32;
        t.ldw = D; t.ldd = 128; t.k0 = 0; t.src = a->in[29] + (size_t)e * DFFE * D + (size_t)(k0 + 4 * (lane >> 3)) * D + n0 + 4 * (lane & 7);
        t.dst0 = ws + WS_WM2 + ((size_t)((e * (D >> 8) + (n0 >> 8)) * (DFFE >> 7) + (k0 >> 7)) * 256 + (n0 & 255)) * 128; t.cs = nullptr; }
    return t;
}
template <int which>
__device__ __forceinline__ void moe_convert_t(ArgsP a, LAS unsigned char* lds, int first, int count) {
    const int tid = hide_tid(), lane = tid & 63, wave = tid >> 6;
    LAS unsigned* scr = (LAS unsigned*)(lds + wave * 16640);
    int k = wave; if (k >= count) return;
    MoeTile t0 = moe_tile<which>(a, first + k, lane), t1 = t0, t2 = t0;
    f32x4 v0[4][4], v1[4][4], v2[4][4];
#define MC_LOAD(vv, tt) do { _Pragma("unroll") for (int i = 0; i < 4; ++i) _Pragma("unroll") for (int r = 0; r < 4; ++r) vv[i][r] = __builtin_nontemporal_load((const f32x4*)(tt.src + (size_t)(32 * i + r) * tt.ldw)); } while (0)
    MC_LOAD(v0, t0);
    if (k + NWAVES < count) { t1 = moe_tile<which>(a, first + k + NWAVES, lane); MC_LOAD(v1, t1); }
    for (; k < count; k += NWAVES) {
        if (k + 2 * NWAVES < count) { t2 = moe_tile<which>(a, first + k + 2 * NWAVES, lane); MC_LOAD(v2, t2); }
        f32x4 q = {pg8::S_W2, pg8::S_W2, pg8::S_W2, pg8::S_W2};
        if (which == 0) { const f32x4 d = *(const f32x4*)t0.cs;
#pragma unroll
            for (int e = 0; e < 4; ++e) q[e] = d[e] > 1e-30f ? __builtin_amdgcn_rcpf(d[e]) : 0.f; }
        const int wq = lane >> 3, wl = lane & 7;
#pragma unroll
        for (int i = 0; i < 4; ++i)
#pragma unroll
            for (int e = 0; e < 4; ++e) { unsigned o;
                if (which == 0) { o = 0u;
#pragma unroll
                    for (int r = 0; r < 4; ++r) o = __builtin_amdgcn_cvt_pk_u8_f32(__builtin_rintf(__builtin_amdgcn_fmed3f(v0[i][r][e] * q[e], -127.f, 127.f)) + 128.0f, r, o);
                    o ^= 0x80808080u; }
                else o = pg8::pk4_fp8(v0[i][0][e] * q[e], v0[i][1][e] * q[e], v0[i][2][e] * q[e], v0[i][3][e] * q[e]);
                scr[(4 * wl + e) * 33 + 8 * i + wq] = o; }
        asm volatile("s_waitcnt lgkmcnt(0)" ::: "memory");
        const int c = lane & 7;
#pragma unroll
        for (int j = 0; j < 4; ++j) { const int n = (lane >> 3) + 8 * j; const LAS unsigned* s = scr + n * 33 + 4 * c;
            __builtin_nontemporal_store((u32x4){s[0], s[1], s[2], s[3]}, (u32x4*)(t0.dst0 + (size_t)n * t0.ldd + t0.k0 + 16 * c)); }
        asm volatile("s_waitcnt lgkmcnt(0)" ::: "memory");
        t0 = t1; t1 = t2;
#pragma unroll
        for (int i = 0; i < 4; ++i)
#pragma unroll
            for (int r = 0; r < 4; ++r) { v0[i][r] = v1[i][r]; v1[i][r] = v2[i][r]; }
    }
#undef MC_LOAD
}
__device__ __forceinline__ void moe_convert(ArgsP a, LAS unsigned char* lds, int which, int first, int count) { if (which == 0) moe_convert_t<0>(a, lds, first, count); else moe_convert_t<1>(a, lds, first, count); }
__device__ __forceinline__ void at_convert(ArgsP a, LAS unsigned char* lds, int l) {
    const int G = gridDim.x, c = (int)blockIdx.x; int f, n;
    if (l == 0) {
        mod_strips(a, lds, 192 + c, 384, G);
        __syncthreads();
        { const int NS = I8_STRIPS + WIN_STRIPS, nfree = G > 192 ? G - 192 : 0, hi = 3 * nfree < NS ? 3 * nfree : NS;
          if (c >= 192) { for (int j = 0; j < 3; ++j) { const int s = 3 * (c - 192) + j; if (s < hi) { if (s < I8_STRIPS) i8_strip(a, lds, s); else win_strip(a, lds, 1, s - I8_STRIPS); } } }
          else if (G == 256) {
              for (int k = 0; k < 2; ++k) { const int s = k == 0 ? hi + c : hi + 192 + (c - 80); if (k == 0 || c >= 80) { if (s < I8_STRIPS) i8_strip(a, lds, s); else if (s < NS) win_strip(a, lds, 1, s - I8_STRIPS); } } }
          else { const int nw = G > 192 ? 192 : G; for (int s = hi + c; s < NS; s += nw) { if (s < I8_STRIPS) i8_strip(a, lds, s); else win_strip(a, lds, 1, s - I8_STRIPS); } } }
        { const int tid = hide_tid(), lane = tid & 63, wave = tid >> 6; LAS float* scr = (LAS float*)(lds + wave * 16640);
          quota(0, CVB_N, G, c, f, n); for (int i = wave; i < n; i += NWAVES) conv_b_item(a, f + i, scr, lane); }
        if (G == 256) {
            const int cr = c < 32 ? 1 : c < 80 ? 12 : c < 192 ? 0 : 12, pre = c < 32 ? c : c < 80 ? 32 + (c - 32) * 12 : c < 192 ? 608 : 608 + (c - 192) * 12;
            moe_convert(a, lds, 0, M1_G1 + 135 * c + pre, 135 + cr); }
        else { quota(M1_G1, M1_AT0, G, c, f, n); moe_convert(a, lds, 0, f, n); }
    } else {
        quota(M1_G1 + M1_AT0, 2 * NEXP * MOE_I - M1_G1 - M1_AT0, G, c, f, n); moe_convert(a, lds, 0, f, n);
        quota(0, NEXP * MOE_I, G, c, f, n); moe_convert(a, lds, 1, f, n);
    }
}
__device__ __forceinline__ void quota_bal_hi(int seg0, int n, int G, int c, int& first, int& count) { const int q = n / G, r = n % G, x = c - (G - r); count = q + (x >= 0 ? 1 : 0); first = seg0 + c * q + (x > 0 ? x : 0); }
__device__ __forceinline__ void quota_bal(int seg0, int n, int G, int c, int& first, int& count) { const int q = n / G, r = n % G; count = q + (c < r ? 1 : 0); first = seg0 + c * q + (c < r ? c : r); }

template <int SRC, bool ROUTER, int NSLAB, int OUT  >
__device__ __forceinline__ void phase_norm(ArgsP a, int l, int row_lo, const float* gvec, int ch_sh, int ch_sc, LAS unsigned char* lds = nullptr) {
    const int tid = hide_tid(), lane = tid & 63, wave = tid >> 6, G = gridDim.x;
    unsigned char* ws = a->ws;
    bf16* XW = (bf16*)(ws + WS_XW); bf16* HB = (bf16*)(ws + WS_HB);
    const float* MODL = (const float*)(ws + WS_MOD) + l * 3 * 12288;
    const int lane0 = lane;
    if (ROUTER) {
        LAS f32x4* RT = (LAS f32x4*)lds;
#pragma unroll
        for (int m = 0; m < 8; ++m) { const int id = tid + NTHR * m, ln = id & 63, h = (id >> 6) & 1, j = (id >> 7) & 3, q = id >> 9;
            RT[id] = *(const f32x4*)(a->in[26] + (size_t)(8 * (ln + 64 * j) + q) * NEXP + 4 * h); }
        __syncthreads();
    }
    for (int ridx = row_lo + blockIdx.x * NWAVES + wave; ridx < MROWS; ridx += G * NWAVES) {
        int row = ridx; if (NSLAB > 0) { row = ridx + (MROWS - 1024); if (row >= MROWS) row -= MROWS; }
        int lane = lane0; asm volatile("" : "+v"(lane));
        const bool isctx = row < 2 * LCTX;
        const int v = isctx ? 2 : ((row - 2 * LCTX) >> 12);
        float x[4][8];
        if (SRC == 0 || (SRC == 2 && isctx)) {
            const float* src = isctx ? a->in[2] + (size_t)row * D : a->in[0] + (size_t)(row - 2 * LCTX) * D;
#pragma unroll
            for (int j = 0; j < 4; ++j) { const f32x4 p = *(const f32x4*)(src + 8 * (lane + 64 * j)), q = *(const f32x4*)(src + 8 * (lane + 64 * j) + 4);
#pragma unroll
                for (int e = 0; e < 4; ++e) { x[j][e] = p[e]; x[j][4 + e] = q[e]; } }
        } else {
#pragma unroll
            for (int j = 0; j < 4; ++j) unpack8(*(const u32x4*)(XW + (size_t)row * D + 8 * (lane + 64 * j)), x[j]);
        }
        if (NSLAB > 0 && isctx) {
#pragma unroll
            for (int j = 0; j < 4; ++j) {
                const int c = 8 * (lane + 64 * j);
                const float* sl = (const float*)(ws + WS_SLAB) + (size_t)((((row >> 8) * 8 + (c >> 8)) * NSLAB)) * 65536 + (size_t)(row & 255) * 256 + (c & 255);
                for (int s = 0; s < NSLAB; ++s) { const f32x4 p = *(const f32x4*)(sl + (size_t)s * 65536), q = *(const f32x4*)(sl + (size_t)s * 65536 + 4);
#pragma unroll
                    for (int e = 0; e < 4; ++e) { x[j][e] += p[e]; x[j][4 + e] += q[e]; } }
                *(u32x4*)(XW + (size_t)row * D + c) = pack8(x[j]); }
        }
        float ss = 0.f;
#pragma unroll
        for (int j = 0; j < 4; ++j)
#pragma unroll
            for (int e = 0; e < 8; ++e) ss += x[j][e] * x[j][e];
        ss = wave_sum(ss);
        const float r = __builtin_amdgcn_rsqf(ss * (1.0f / D) + EPS);
        const float* sh = MODL + v * 12288 + ch_sh * 2048; const float* sc = MODL + v * 12288 + ch_sc * 2048;
        float lg[8];
        if (ROUTER) {
#pragma unroll
            for (int e = 0; e < 8; ++e) lg[e] = 0.f;
        }
#pragma unroll
        for (int j = 0; j < 4; ++j) {
            const int c = 8 * (lane + 64 * j);
            float h[8];
#pragma unroll
            for (int hf = 0; hf < 2; ++hf) { const f32x4 g = *(const f32x4*)(gvec + c + 4 * hf), s1 = *(const f32x4*)(sc + c + 4 * hf), s0 = *(const f32x4*)(sh + c + 4 * hf);
#pragma unroll
                for (int e = 0; e < 4; ++e) h[4 * hf + e] = (x[j][4 * hf + e] * r) * g[e] * (s1[e] + 1.0f) + s0[e]; }
            if (OUT == 1) { u32x2 o; o.x = pg8::pk4_fp8(h[0] * pg8::S_H, h[1] * pg8::S_H, h[2] * pg8::S_H, h[3] * pg8::S_H); o.y = pg8::pk4_fp8(h[4] * pg8::S_H, h[5] * pg8::S_H, h[6] * pg8::S_H, h[7] * pg8::S_H);
                *(u32x2*)((unsigned char*)HB + (size_t)row * D + c) = o; }
            else if (OUT == 0) *(u32x4*)(HB + (size_t)row * D + c) = pack8(h);
            if (OUT == 2 || ROUTER) {
#pragma unroll
                for (int e = 0; e < 8; ++e) x[j][e] = h[e]; }
        }
        if (OUT == 2) {
            float am = 0.f;
#pragma unroll
            for (int j = 0; j < 4; ++j)
#pragma unroll
                for (int e = 0; e < 8; ++e) am = fmaxf(am, fabsf(x[j][e]));
#pragma unroll
            for (int o = 1; o < 64; o <<= 1) am = fmaxf(am, __shfl_xor(am, o));
            const float qs = am > 1e-30f ? 127.0f / am : 0.f;
            if (lane == 0) ((float*)(ws + WS_RS))[row] = am * (1.0f / 127.0f);
#pragma unroll
            for (int j = 0; j < 4; ++j) { unsigned w[2];
#pragma unroll
                for (int hf = 0; hf < 2; ++hf) { const int q0 = (int)rintf(x[j][4 * hf + 0] * qs), q1 = (int)rintf(x[j][4 * hf + 1] * qs), q2 = (int)rintf(x[j][4 * hf + 2] * qs), q3 = (int)rintf(x[j][4 * hf + 3] * qs);
                    w[hf] = (unsigned)(q0 & 255) | ((unsigned)(q1 & 255) << 8) | ((unsigned)(q2 & 255) << 16) | ((unsigned)(q3 & 255) << 24); }
                *(u32x2*)((unsigned char*)HB + (size_t)row * D + 8 * (lane + 64 * j)) = (u32x2){w[0], w[1]}; }
        }
        if (ROUTER) {
#pragma unroll
            for (int j = 0; j < 4; ++j) {
                const LAS f32x4* RT = (const LAS f32x4*)lds;
#pragma unroll
                for (int q = 0; q < 8; ++q) { const f32x4 w0 = RT[((q * 4 + j) * 2 + 0) * 64 + lane], w1 = RT[((q * 4 + j) * 2 + 1) * 64 + lane];
                    lg[0] += x[j][q] * w0[0]; lg[1] += x[j][q] * w0[1]; lg[2] += x[j][q] * w0[2]; lg[3] += x[j][q] * w0[3];
                    lg[4] += x[j][q] * w1[0]; lg[5] += x[j][q] * w1[1]; lg[6] += x[j][q] * w1[2]; lg[7] += x[j][q] * w1[3]; }
                asm volatile("" ::: "memory");
            }
        }
        if (ROUTER) {
#pragma unroll
            for (int e = 0; e < 8; ++e) lg[e] = wave_sum(lg[e]);
            int e1 = 0; float v1 = lg[0];
#pragma unroll
            for (int e = 1; e < 8; ++e) if (lg[e] > v1) { v1 = lg[e]; e1 = e; }
            int e2 = -1; float v2 = -3.0e38f;
#pragma unroll
            for (int e = 0; e < 8; ++e) if (e != e1 && lg[e] > v2) { v2 = lg[e]; e2 = e; }
            if (lane == 0) {
                unsigned* cnt = (unsigned*)(ws + WS_CTL) + CW_CNT;
                const int p1 = (int)atomicAdd(cnt + 64 * e1, 1u), p2 = (int)atomicAdd(cnt + 64 * e2, 1u);
                const float g2 = 1.0f / (1.0f + __expf(v1 - v2)), g1 = 1.0f - g2;
                int* tk = (int*)(ws + WS_TOK) + (size_t)(row - 2 * LCTX) * 8;
                tk[0] = e1; tk[1] = e2; tk[2] = p1; tk[3] = p2; ((float*)tk)[4] = g1; ((float*)tk)[5] = g2;
            }
        }
    }
}

__device__ __forceinline__ void rope_angles(int pos, bool latent, int quarter_lane_i0  , bool colhalf, float expo_scale, float (&cs)[8], float (&sn)[8]) {
    const float p = latent ? (float)(colhalf ? (pos & 63) : (pos >> 6)) : 0.f;
#pragma unroll
    for (int e = 0; e < 8; ++e) {
        const float inv = __builtin_amdgcn_exp2f(-(float)(quarter_lane_i0 + e) * expo_scale);
        float rev = p * inv * 0.15915494309189535f; rev -= rintf(rev);
        cs[e] = latent ? __builtin_amdgcn_cosf(rev) : 1.f; sn[e] = latent ? __builtin_amdgcn_sinf(rev) : 0.f;
    }
}
__device__ __forceinline__ void phase_postproj(ArgsP a, int l, LAS unsigned char* lds) {
    const int tid = hide_tid(), lane = tid & 63, wave = tid >> 6, G = gridDim.x;
    unsigned char* ws = a->ws;
    bf16* PROJ = (bf16*)(ws + WS_PROJ); bf16* MIX = (bf16*)(ws + WS_MIX);
    const float LOG2_THETA = 13.287712379549449f;
    float gAq[8], gAk[8], gCq[8], gCk[8], cwv[3][8], gbv[8];
#pragma unroll
    for (int e = 0; e < 8; ++e) { gAq[e] = a->in[10][l * 64 + 8 * (lane & 7) + e]; gAk[e] = a->in[11][l * 64 + 8 * (lane & 7) + e]; gCq[e] = a->in[19][l * 128 + 8 * (lane & 15) + e]; gCk[e] = a->in[20][l * 128 + 8 * (lane & 15) + e];
        cwv[0][e] = a->in[17][l * 3 * 512 + 8 * lane + e]; cwv[1][e] = a->in[17][l * 3 * 512 + 512 + 8 * lane + e]; cwv[2][e] = a->in[17][l * 3 * 512 + 1024 + 8 * lane + e]; gbv[e] = a->in[18][l * 512 + 8 * lane + e]; }
    for (int row = blockIdx.x * NWAVES + wave; row < MROWS; row += G * NWAVES) {
        const bool latent = row >= 2 * LCTX;
        const int pos = latent ? ((row - 2 * LCTX) & (SEQ - 1)) : (row & (LCTX - 1));
        const int seglen = latent ? SEQ : LCTX;
        bf16* pr = PROJ + (size_t)row * INC;
        const u32x4 zero4 = {0u, 0u, 0u, 0u};
        u32x4 wA[2], wC[3], bC0 = zero4, bX0 = zero4, bC1, bX1, bC2 = zero4, bX2 = zero4, bB;
#pragma unroll
        for (int i = 0; i < 2; ++i) wA[i] = *(const u32x4*)(pr + (lane + 64 * i) * 8);
#pragma unroll
        for (int i = 0; i < 3; ++i) { const int chunk = lane + 64 * i; wC[i] = *(const u32x4*)(pr + C_CQ + (chunk < 160 ? chunk : 0) * 8); }
        bC1 = *(const u32x4*)(pr + C_BC + 8 * lane); bX1 = *(const u32x4*)(pr + C_BX + 8 * lane); bB = *(const u32x4*)(pr + C_BB + 8 * lane);
        if (pos > 0) { bC0 = *(const u32x4*)(pr - INC + C_BC + 8 * lane); bX0 = *(const u32x4*)(pr - INC + C_BX + 8 * lane); }
        if (pos < seglen - 1) { bC2 = *(const u32x4*)(pr + INC + C_BC + 8 * lane); bX2 = *(const u32x4*)(pr + INC + C_BX + 8 * lane); }
        {
            const int l8 = lane & 7;
            float cs[8], sn[8];
            rope_angles(pos, latent, 8 * (l8 & 1), l8 >= 4, 2.0f * LOG2_THETA / 32.0f, cs, sn);
            const bool minus = (l8 & 2) == 0;
#pragma unroll
            for (int i = 0; i < 2; ++i) {
                const int chunk = lane + 64 * i, vec = chunk >> 3; const bool isq = vec < 8;
                float f[8]; unpack8(wA[i], f);
                float ss = 0.f;
#pragma unroll
                for (int e = 0; e < 8; ++e) ss += f[e] * f[e];
                ss += __shfl_xor(ss, 1); ss += __shfl_xor(ss, 2); ss += __shfl_xor(ss, 4);
                const float r = __builtin_amdgcn_rsqf(ss * (1.0f / 64.0f) + EPS);
                const float qs = isq ? 0.125f * 1.4426950408889634f : 1.0f;
                float y[8], o[8];
#pragma unroll
                for (int e = 0; e < 8; ++e) y[e] = f[e] * r * (isq ? gAq[e] : gAk[e]);
#pragma unroll
                for (int e = 0; e < 8; ++e) { const float p = __shfl_xor(y[e], 2); o[e] = (y[e] * cs[e] + (minus ? -p : p) * sn[e]) * qs; }
                *(u32x4*)(pr + chunk * 8) = pack8(o);
            }
        }
        {
            const int l16 = lane & 15;
            float cs[8], sn[8];
            rope_angles(pos, latent, 8 * (l16 & 3), l16 >= 8, 2.0f * LOG2_THETA / 64.0f, cs, sn);
            const bool minus = (l16 & 4) == 0;
#pragma unroll
            for (int i = 0; i < 3; ++i) {
                const int chunk = lane + 64 * i; const bool act = chunk < 160; const int vec = chunk >> 4; const bool isq = vec < 8;
                bf16* p8 = pr + C_CQ + (act ? chunk : 0) * 8;
                float f[8]; unpack8(wC[i], f);
                float ss = 0.f;
#pragma unroll
                for (int e = 0; e < 8; ++e) ss += f[e] * f[e];
                ss += __shfl_xor(ss, 1); ss += __shfl_xor(ss, 2); ss += __shfl_xor(ss, 4); ss += __shfl_xor(ss, 8);
                const float r = __builtin_amdgcn_rsqf(ss * (1.0f / 128.0f) + EPS);
                const float qs = isq ? 0.08838834764831845f * 1.4426950408889634f : 1.0f;
                float y[8], o[8];
#pragma unroll
                for (int e = 0; e < 8; ++e) y[e] = f[e] * r * (isq ? gCq[e] : gCk[e]);
#pragma unroll
                for (int e = 0; e < 8; ++e) { const float p = __shfl_xor(y[e], 4); o[e] = (y[e] * cs[e] + (minus ? -p : p) * sn[e]) * qs; }
                if (act) *(u32x4*)p8 = pack8(o);
            }
        }
        {
            const int c0 = 8 * lane;
            float u0[8], u1[8], u2[8], fb[8], t0[8], t1[8];
            unpack8(bC1, t0); unpack8(bX1, t1);
#pragma unroll
            for (int e = 0; e < 8; ++e) u1[e] = t0[e] * t1[e];
            unpack8(bC0, t0); unpack8(bX0, t1);
#pragma unroll
            for (int e = 0; e < 8; ++e) u0[e] = t0[e] * t1[e];
            unpack8(bC2, t0); unpack8(bX2, t1);
#pragma unroll
            for (int e = 0; e < 8; ++e) u2[e] = t0[e] * t1[e];
            unpack8(bB, fb);
            float vv[8], ss = 0.f;
#pragma unroll
            for (int e = 0; e < 8; ++e) { vv[e] = fb[e] * (u0[e] * cwv[0][e] + u1[e] * cwv[1][e] + u2[e] * cwv[2][e]); ss += vv[e] * vv[e]; }
            ss = wave_sum(ss);
            const float r = __builtin_amdgcn_rsqf(ss * (1.0f / 512.0f) + EPS);
#pragma unroll
            for (int e = 0; e < 8; ++e) vv[e] = vv[e] * r * gbv[e];
            *(u32x4*)(MIX + (size_t)row * MIXW + 512 + c0) = pack8(vv);
        }
    }
    __syncthreads();
    {
        LAS unsigned short* tl = (LAS unsigned short*)lds;
        bf16* VTA = (bf16*)(ws + WS_VTA); bf16* VTC = (bf16*)(ws + WS_VTC);
        u32x4 wv[2];
#define VT_LOAD(itx) do { const int _hs = (itx) % 6, _q = (itx) / 6, _jt = _q % 68, _b = _q / 68; const int _col = _hs < 4 ? C_AV + _hs * 128 : C_CV + (_hs - 4) * 128; const int _r0 = rowmap(_b, _jt * 64); \
            _Pragma("unroll") for (int _i = 0; _i < 2; ++_i) { const int _idx = tid + 512 * _i; wv[_i] = *(const u32x4*)(PROJ + (size_t)(_r0 + (_idx >> 4)) * INC + _col + 8 * (_idx & 15)); } } while (0)
        const int it0 = G > 64 ? ((int)blockIdx.x + G - 64) % G : (int)blockIdx.x;
        if (it0 < NB * 68 * 6) VT_LOAD(it0);
        for (int it = it0; it < NB * 68 * 6; it += G) {
            const int hs = it % 6, q = it / 6, jt = q % 68, b = q / 68, j0 = jt * 64;
#pragma unroll
            for (int i = 0; i < 2; ++i) { const int idx = tid + 512 * i, key = idx >> 4, ch = idx & 15;
                *(LAS u32x4*)(tl + key * 136 + 8 * ch) = wv[i]; }
            if (it + G < NB * 68 * 6) VT_LOAD(it + G);
            __syncthreads();
            bf16* dst = hs < 4 ? VTA + (size_t)((b * 4 + hs) * 128) * NKEY : VTC + (size_t)((b * 2 + hs - 4) * 128) * NKEY;
#pragma unroll
            for (int i = 0; i < 2; ++i) { const int idx = tid + 512 * i, dv = idx >> 3, kc = idx & 7;
                unsigned short e[8];
#pragma unroll
                for (int k = 0; k < 8; ++k) { const int q = 8 * kc + k, key = (q & ~12) | ((q & 4) << 1) | ((q & 8) >> 1); e[k] = tl[key * 136 + dv]; }
                u32x4 o; o.x = e[0] | ((unsigned)e[1] << 16); o.y = e[2] | ((unsigned)e[3] << 16); o.z = e[4] | ((unsigned)e[5] << 16); o.w = e[6] | ((unsigned)e[7] << 16);
                *(u32x4*)(dst + (size_t)dv * NKEY + j0 + 8 * kc) = o; }
            __syncthreads();
        }
    }
}

constexpr int KT_STRIDE = 272, VT_STRIDE = 144, KT_BYTES = 64 * KT_STRIDE, VT_BYTES = 128 * VT_STRIDE, ATT_STAGE = KT_BYTES + VT_BYTES;
struct TileSched { int n, nloc, blk0; };
__device__ __forceinline__ int ts_j0(const TileSched& ts, int t) { return t < ts.nloc ? LCTX + (ts.blk0 + (t >> 1)) * 128 + (t & 1) * 64 : (t - ts.nloc) * 64; }

template <int DK, bool WINDOW>
__device__ __forceinline__ void attn_core(LAS unsigned char* lds, const bf16* __restrict__ proj, const bf16* __restrict__ vt, int b, int qrow_wave, int qcol, int ktile_col, int kwave_off, int qpos_wave,
                                          const TileSched ts, f32x16 (&O)[4], float& m_out, float& l_out) {
    const int tid = hide_tid(), lane = tid & 63, r = lane & 31, hh = lane >> 5;
    bf16x8 Qf[DK / 16];
    { const bf16* qp = proj + (size_t)(qrow_wave + r) * INC + qcol + 8 * hh;
#pragma unroll
      for (int ks = 0; ks < DK / 16; ++ks) Qf[ks] = *(const bf16x8*)(qp + 16 * ks); }
#pragma unroll
    for (int blk = 0; blk < 4; ++blk)
#pragma unroll
        for (int i = 0; i < 16; ++i) O[blk][i] = 0.f;
    float m = -__builtin_inff(), lsum = 0.f;
    const int qpos = qpos_wave + r;
    u32x4 kreg[2], vreg[2];
#define kkey (tid >> 4)
#define kch (tid & 15)
#define vdv (tid >> 3)
#define vch (tid & 7)
    LAS unsigned char* const kbuf = lds; LAS unsigned char* const vbuf = lds + 2 * KT_BYTES;
#define ATT_ISSUE_K(t) do { const int _r0 = rowmap(b, ts_j0(ts, (t))); \
        _Pragma("unroll") for (int _i = 0; _i < 2; ++_i) kreg[_i] = *(const u32x4*)(proj + (size_t)(_r0 + kkey + 32 * _i) * INC + ktile_col + 8 * kch); } while (0)
#define ATT_ISSUE_V(t) do { const int _j0 = ts_j0(ts, (t)); \
        _Pragma("unroll") for (int _i = 0; _i < 2; ++_i) vreg[_i] = *(const u32x4*)(vt + (size_t)(vdv + 64 * _i) * NKEY + _j0 + 8 * vch); } while (0)
#define ATT_COMMIT_K(buf) do { LAS unsigned char* _kt = kbuf + (buf) * KT_BYTES; \
        _Pragma("unroll") for (int _i = 0; _i < 2; ++_i) *(LAS u32x4*)(_kt + (kkey + 32 * _i) * KT_STRIDE + kch * 16) = kreg[_i]; } while (0)
#define ATT_COMMIT_V(buf) do { LAS unsigned char* _vl = vbuf + (buf) * VT_BYTES; \
        _Pragma("unroll") for (int _i = 0; _i < 2; ++_i) *(LAS u32x4*)(_vl + (vdv + 64 * _i) * VT_STRIDE + vch * 16) = vreg[_i]; } while (0)
#define ATT_QK(S, buf) do { const LAS unsigned char* _kt = kbuf + (buf) * KT_BYTES; \
        _Pragma("unroll") for (int kb = 0; kb < 2; ++kb) { _Pragma("unroll") for (int i = 0; i < 16; ++i) S[kb][i] = 0.f; \
            _Pragma("unroll") for (int ks = 0; ks < DK / 16; ++ks) { const bf16x8 ka = *(const LAS bf16x8*)(_kt + (32 * kb + r) * KT_STRIDE + (kwave_off + 16 * ks + 8 * hh) * 2); \
                S[kb] = __builtin_amdgcn_mfma_f32_32x32x16_bf16(ka, Qf[ks], S[kb], 0, 0, 0); } } } while (0)
#define ATT_SOFTMAX(S, tt, Pf, alpha) do { \
        if (WINDOW && (tt) < ts.nloc) { const int kpos0 = (ts.blk0 + ((tt) >> 1)) * 128 + ((tt) & 1) * 64; \
            _Pragma("unroll") for (int kb = 0; kb < 2; ++kb) _Pragma("unroll") for (int i = 0; i < 16; ++i) { const int d = kpos0 + 32 * kb + (i & 3) + 8 * (i >> 2) + 4 * hh - qpos; \
                if (d > 128 || d < -128) S[kb][i] = -__builtin_inff(); } } \
        float mx = S[0][0]; \
        _Pragma("unroll") for (int kb = 0; kb < 2; ++kb) _Pragma("unroll") for (int i = 0; i < 16; ++i) mx = fmaxf(mx, S[kb][i]); \
        mx = fmaxf(mx, __shfl_xor(mx, 32)); \
        alpha = 1.0f; \
        if (mx > m + 8.0f) { const float mo = m; m = mx; alpha = __builtin_amdgcn_exp2f(mo - mx); }     \
        const float muse = (m == -__builtin_inff()) ? 0.f : m; \
        float ps = 0.f; \
        _Pragma("unroll") for (int kb = 0; kb < 2; ++kb) _Pragma("unroll") for (int i = 0; i < 16; ++i) { const float p = __builtin_amdgcn_exp2f(S[kb][i] - muse); S[kb][i] = p; ps += p; } \
        lsum = lsum * alpha + ps; \
        _Pragma("unroll") for (int kb = 0; kb < 2; ++kb) _Pragma("unroll") for (int s = 0; s < 2; ++s) { u32x4 w; w.x = pk2(S[kb][8 * s + 0], S[kb][8 * s + 1]); w.y = pk2(S[kb][8 * s + 2], S[kb][8 * s + 3]); \
            w.z = pk2(S[kb][8 * s + 4], S[kb][8 * s + 5]); w.w = pk2(S[kb][8 * s + 6], S[kb][8 * s + 7]); Pf[kb][s] = __builtin_bit_cast(bf16x8, w); } } while (0)
#define ATT_RESCALE(alpha) do { if (__any(alpha != 1.0f)) { _Pragma("unroll") for (int blk = 0; blk < 4; ++blk) _Pragma("unroll") for (int i = 0; i < 16; ++i) O[blk][i] *= alpha; } } while (0)

    ATT_ISSUE_K(0); ATT_ISSUE_V(0); ATT_COMMIT_K(0); ATT_COMMIT_V(0);
    if (ts.n > 1) { ATT_ISSUE_K(1); ATT_COMMIT_K(1); }
    __syncthreads();
    bf16x8 Pf[2][2];
    { f32x16 S[2]; float alpha; ATT_QK(S, 0); ATT_SOFTMAX(S, 0, Pf, alpha); (void)alpha; }
    __syncthreads();
    for (int t = 0; t < ts.n; ++t) {
        const bool has1 = t + 1 < ts.n, has2 = t + 2 < ts.n;
        if (has2) ATT_ISSUE_K(t + 2);
        if (has1) ATT_ISSUE_V(t + 1);
        f32x16 S[2];
        if (has1) ATT_QK(S, (t + 1) & 1);
        { const LAS unsigned char* vl = vbuf + (t & 1) * VT_BYTES;
#pragma unroll
          for (int blk = 0; blk < 4; ++blk)
#pragma unroll
            for (int kb = 0; kb < 2; ++kb)
#pragma unroll
                for (int s = 0; s < 2; ++s) { const bf16x8 va = *(const LAS bf16x8*)(vl + (32 * blk + r) * VT_STRIDE + (32 * kb + 16 * s + 8 * hh) * 2);
                    O[blk] = __builtin_amdgcn_mfma_f32_32x32x16_bf16(va, Pf[kb][s], O[blk], 0, 0, 0); } }
        if (has1) { float alpha; ATT_SOFTMAX(S, t + 1, Pf, alpha); ATT_RESCALE(alpha); }
        if (has2) ATT_COMMIT_K(t & 1);
        if (has1) ATT_COMMIT_V((t + 1) & 1);
        __syncthreads();
    }
#undef ATT_ISSUE_K
#undef ATT_ISSUE_V
#undef ATT_COMMIT_K
#undef ATT_COMMIT_V
#undef ATT_QK
#undef ATT_SOFTMAX
#undef ATT_RESCALE
#undef kkey
#undef kch
#undef vdv
#undef vch
    m_out = m; l_out = lsum + __shfl_xor(lsum, 32);
}

__device__ __forceinline__ void phase_attention(ArgsP a, int l, LAS unsigned char* lds, int cv_slot) {
    const int tid = hide_tid(), lane = tid & 63, wave = __builtin_amdgcn_readfirstlane(tid >> 6), G = gridDim.x;
    unsigned char* ws = a->ws;
    const bf16* PROJ = (const bf16*)(ws + WS_PROJ); bf16* MIX = (bf16*)(ws + WS_MIX); float* SSQ = (float*)(ws + WS_SSQ);
    const bf16* VTA = (const bf16*)(ws + WS_VTA); const bf16* VTC = (const bf16*)(ws + WS_VTC);
    const int nctx = (l == 0) ? 16 : 0, total = 512 + 2 * nctx;
    const float lam_init = (l == 0) ? 0.2f : 0.35550906f;
    float lam;
    { const float q1 = a->in[12][l * 64 + lane], k1 = a->in[13][l * 64 + lane], q2 = a->in[14][l * 64 + lane], k2 = a->in[15][l * 64 + lane];
      const float d1 = wave_sum(q1 * k1), d2 = wave_sum(q2 * k2); lam = __expf(d1) - __expf(d2) + lam_init; }
    const int nunits = (int)blockIdx.x < total ? (total - (int)blockIdx.x + G - 1) / G : 0, slotpos = cv_slot < nunits ? cv_slot : nunits;
    for (int st = 0; st <= nunits; ++st) {
        if (st == slotpos) { __syncthreads(); at_convert(a, lds, l); __syncthreads(); }
        if (st == nunits) break;
        const int w = (int)blockIdx.x + st * G;
        const bool isA = (w < 256) || (w >= 512 && w < 512 + nctx);
        const bool isctx = w >= 512;
        if (isA) {
            int b, h, qb;
            if (!isctx) { const int bh = w & 7; b = bh >> 2; h = bh & 3; qb = w >> 3; } else { const int q = w - 512; b = q >> 3; h = (q >> 1) & 3; qb = q & 1; }
            const int comp = wave >> 2, rg = wave & 3;
            const int qrow0 = isctx ? b * LCTX + qb * 128 : 2 * LCTX + b * SEQ + qb * 128;
            TileSched ts; ts.nloc = 0; ts.blk0 = 0; ts.n = isctx ? 4 : 68;
            f32x16 O[4]; float m, ls;
            attn_core<64, false>(lds, PROJ, VTA + (size_t)((b * 4 + h) * 128) * NKEY, b, qrow0 + rg * 32, C_AQ + h * 128 + comp * 64, C_AK + h * 128, comp * 64, 0, ts, O, m, ls);
            const float inv = 1.0f / ls;
            const int lz = hide_tid() & 63, r = lz & 31, hh = lz >> 5, lane = lz;
            LAS float* ex = (LAS float*)lds;
            if (comp == 1) {
#pragma unroll
                for (int blk = 0; blk < 4; ++blk)
#pragma unroll
                    for (int i = 0; i < 16; ++i) ex[(rg * 64 + blk * 16 + i) * 64 + lane] = O[blk][i] * inv;
            }
            __syncthreads();
            if (comp == 0) {
                float ss = 0.f;
#pragma unroll
                for (int blk = 0; blk < 4; ++blk)
#pragma unroll
                    for (int i = 0; i < 16; ++i) { const float o = O[blk][i] * inv - lam * ex[(rg * 64 + blk * 16 + i) * 64 + lane]; O[blk][i] = o; ss += o * o; }
                ss += __shfl_xor(ss, 32);
                const float rn = __builtin_amdgcn_rsqf(ss * (1.0f / 128.0f) + EPS) * (1.0f - lam_init);
                const float* sg = a->in[16] + l * 128;
                bf16* orow = MIX + (size_t)(qrow0 + rg * 32 + r) * MIXW + h * 128;
#pragma unroll
                for (int blk = 0; blk < 4; ++blk)
#pragma unroll
                    for (int g4 = 0; g4 < 4; ++g4) { const int dv = 32 * blk + 8 * g4 + 4 * hh; const f32x4 gg = *(const f32x4*)(sg + dv);
                        u32x2 o; o.x = pk2(O[blk][4 * g4 + 0] * rn * gg[0], O[blk][4 * g4 + 1] * rn * gg[1]); o.y = pk2(O[blk][4 * g4 + 2] * rn * gg[2], O[blk][4 * g4 + 3] * rn * gg[3]);
                        *(u32x2*)(orow + dv) = o; }
            }
            __syncthreads();
        } else {
            int b, kvh, hp, qb;
            if (!isctx) { const int q = w - 256, cb = q & 7; b = cb >> 2; kvh = (cb >> 1) & 1; hp = cb & 1; qb = q >> 3; }
            else { const int q = w - 512 - nctx; b = q >> 3; kvh = (q >> 2) & 1; hp = (q >> 1) & 1; qb = q & 1; }
            const int head = kvh * 4 + hp * 2 + (wave >> 2), rg = wave & 3;
            const int qrow0 = isctx ? b * LCTX + qb * 128 : 2 * LCTX + b * SEQ + qb * 128;
            TileSched ts;
            if (isctx) { ts.nloc = 0; ts.blk0 = 0; ts.n = 4; }
            else { const int lo = qb > 0 ? qb - 1 : 0, hi = qb < 31 ? qb + 1 : 31; ts.blk0 = lo; ts.nloc = 2 * (hi - lo + 1); ts.n = ts.nloc + 4; }
            f32x16 O[4]; float m, ls;
            attn_core<128, true>(lds, PROJ, VTC + (size_t)((b * 2 + kvh) * 128) * NKEY, b, qrow0 + rg * 32, C_CQ + head * 128, C_CK + kvh * 128, 0, qb * 128 + rg * 32, ts, O, m, ls);
            const int lz = hide_tid() & 63, r = lz & 31, hh = lz >> 5;
            const float sink = a->in[21][l * 8 + head] * 1.4426950408889634f;
            const float inv = 1.0f / (ls + __builtin_amdgcn_exp2f(sink - m));
            float ss = 0.f;
            bf16* orow = MIX + (size_t)(qrow0 + rg * 32 + r) * MIXW + 1024 + head * 128;
#pragma unroll
            for (int blk = 0; blk < 4; ++blk)
#pragma unroll
                for (int g4 = 0; g4 < 4; ++g4) { const int dv = 32 * blk + 8 * g4 + 4 * hh;
                    const float o0 = O[blk][4 * g4 + 0] * inv, o1 = O[blk][4 * g4 + 1] * inv, o2 = O[blk][4 * g4 + 2] * inv, o3 = O[blk][4 * g4 + 3] * inv;
                    ss += o0 * o0 + o1 * o1 + o2 * o2 + o3 * o3;
                    const f32x4 gc = *(const f32x4*)(a->in[22] + l * 1024 + head * 128 + dv);
                    u32x2 o; o.x = pk2(o0 * gc[0], o1 * gc[1]); o.y = pk2(o2 * gc[2], o3 * gc[3]); *(u32x2*)(orow + dv) = o; }
            ss += __shfl_xor(ss, 32);
            if (hh == 0) SSQ[(size_t)(qrow0 + rg * 32 + r) * 8 + head] = ss;
        }
    }
}

__device__ __forceinline__ void phase_normc(ArgsP a, int l) {
    const int tid = hide_tid(), lane = tid & 63, wave = tid >> 6, G = gridDim.x;
    unsigned char* ws = a->ws; bf16* MIX = (bf16*)(ws + WS_MIX); const float* SSQ = (const float*)(ws + WS_SSQ);
    const int row_lo = (l == 0) ? 0 : 2 * LCTX;
    for (int row = row_lo + blockIdx.x * NWAVES + wave; row < MROWS; row += G * NWAVES) {
        const f32x4 s0 = *(const f32x4*)(SSQ + (size_t)row * 8), s1 = *(const f32x4*)(SSQ + (size_t)row * 8 + 4);
        const float ss = (s0[0] + s0[1]) + (s0[2] + s0[3]) + (s1[0] + s1[1]) + (s1[2] + s1[3]);
        const float rn = __builtin_amdgcn_rsqf(ss * (1.0f / 1024.0f) + EPS);
#pragma unroll
        for (int i = 0; i < 2; ++i) { const int c = 8 * (lane + 64 * i); bf16* p = MIX + (size_t)row * MIXW + 1024 + c;
            float f[8]; unpack8(*(const u32x4*)p, f); const float* g = a->in[22] + l * 1024 + c;
#pragma unroll
            for (int e = 0; e < 8; ++e) f[e] = f[e] * rn * g[e];
            *(u32x4*)p = pack8(f); }
    }
}

__device__ __forceinline__ int moe_offsets(const unsigned* cnt, int (&off)[NEXP], int (&cn)[NEXP]) {
    int o = 0;
#pragma unroll
    for (int e = 0; e < NEXP; ++e) { cn[e] = (int)cnt[64 * e]; off[e] = o; o += (cn[e] + 255) & ~255; }
    return o >> 8;
}
__device__ __forceinline__ void phase_gather(ArgsP a) {
    const int tid = hide_tid(), lane = tid & 63, wave = tid >> 6, G = gridDim.x;
    unsigned char* ws = a->ws;
    const unsigned* cnt = (const unsigned*)(ws + WS_CTL) + CW_CNT;
    int off[NEXP], cn[NEXP]; const int npan = moe_offsets(cnt, off, cn);
    if (blockIdx.x == 0 && tid == 0) { int* pe = (int*)(ws + WS_CTL) + CW_PEXP; pe[96] = npan;
#pragma unroll
        for (int e = 0; e < NEXP; ++e) { const int p0 = off[e] >> 8, np = (cn[e] + 255) >> 8; for (int p = 0; p < np; ++p) pe[p0 + p] = e; } }
    if (blockIdx.x == 0) { int NF, R, SK; pg8::moe_tail_params(npan, D / 256, G, NF, R, SK); pg8::StaticOrder so; so.init(npan, D / 256, G, 0, DFFE / 128);
        if (tid < R) { pg8::Unit u; so.map(NF + tid, u); ((int*)(ws + WS_CTL) + CW_TMODE)[u.pm * 8 + u.pn] = tid + 1; } }
    const unsigned char* HB = ws + WS_HB; unsigned char* HP = ws + WS_HPERM;
    const int gw = blockIdx.x * NWAVES + wave, NGW = G * NWAVES;
    for (int t = gw; t < NB * SEQ; t += NGW) {
        int* tk = (int*)(ws + WS_TOK) + (size_t)t * 8;
        const int e1 = tk[0], e2 = tk[1], p1 = tk[2], p2 = tk[3];
        int s1 = 0, s2 = 0;
#pragma unroll
        for (int e = 0; e < NEXP; ++e) { if (e == e1) s1 = off[e] + p1; if (e == e2) s2 = off[e] + p2; }
        if (lane == 0) { tk[6] = s1; tk[7] = s2; const float rs = ((const float*)(ws + WS_RS))[2 * LCTX + t]; ((float*)(ws + WS_RSS))[s1] = rs; ((float*)(ws + WS_RSS))[s2] = rs; }
        const u32x4* src = (const u32x4*)(HB + (size_t)(2 * LCTX + t) * D);
        u32x4* d1 = (u32x4*)(HP + (size_t)s1 * D); u32x4* d2 = (u32x4*)(HP + (size_t)s2 * D);
#pragma unroll
        for (int i = 0; i < 2; ++i) { const u32x4 v = src[lane + 64 * i]; d1[lane + 64 * i] = v; d2[lane + 64 * i] = v; }
    }
#pragma unroll
    for (int e = 0; e < NEXP; ++e) { const int npad = ((cn[e] + 255) & ~255) - cn[e];
        for (int p = gw; p < npad; p += NGW) { u32x4* d = (u32x4*)(HP + (size_t)(off[e] + cn[e] + p) * D);
#pragma unroll
            for (int i = 0; i < 2; ++i) d[lane + 64 * i] = (u32x4){0u, 0u, 0u, 0u};
            if (lane == 0) ((float*)(ws + WS_RSS))[off[e] + cn[e] + p] = 0.f; } }
}
__device__ __forceinline__ void slab_sum(const float* slab, int mode, int SK, int slot, int c, float (&y)[8]) {
#pragma unroll
    for (int e = 0; e < 8; ++e) y[e] = 0.f;
    for (int s = 0; s < SK; ++s) { const float* p = slab + (size_t)((mode - 1) * SK + s) * 65536 + (slot & 255) * 256 + (c & 255);
        const f32x4 a0 = *(const f32x4*)p, a1 = *(const f32x4*)(p + 4);
#pragma unroll
        for (int e = 0; e < 4; ++e) { y[e] += a0[e]; y[4 + e] += a1[e]; } }
}
__device__ __forceinline__ void phase_combine(ArgsP a, int l) {
    const int tid = hide_tid(), lane = tid & 63, wave = tid >> 6, G = gridDim.x;
    unsigned char* ws = a->ws;
    const bf16* XW = (const bf16*)(ws + WS_XW); const bf16* YS = (const bf16*)(ws + WS_YS); const float* slab = (const float*)(ws + WS_SLAB);
    const float* MODL = (const float*)(ws + WS_MOD) + l * 3 * 12288;
    const int* tmode = (const int*)(ws + WS_CTL) + CW_TMODE;
    int NF, R, SK; pg8::moe_tail_params(((const int*)(ws + WS_CTL) + CW_PEXP)[96], D / 256, G, NF, R, SK);
    for (int t = blockIdx.x * NWAVES + wave; t < NB * SEQ; t += G * NWAVES) {
        const int* tk = (const int*)(ws + WS_TOK) + (size_t)t * 8;
        const float g1 = ((const float*)tk)[4], g2 = ((const float*)tk)[5]; const int s1 = tk[6], s2 = tk[7];
        const float* gf = MODL + (t >> 12) * 12288 + 5 * 2048;
        const bf16* xr = XW + (size_t)(2 * LCTX + t) * D; float* orow = a->out + (size_t)t * D;
        int m1[4], m2[4];
#pragma unroll
        for (int i = 0; i < 4; ++i) { const int ct = (lane + 64 * i) >> 5; m1[i] = tmode[(s1 >> 8) * 8 + ct]; m2[i] = tmode[(s2 >> 8) * 8 + ct]; }
        u32x4 w1[4], w2[4], wx[4]; f32x4 ga[4], gb[4];
#pragma unroll
        for (int i = 0; i < 4; ++i) { const int c = 8 * (lane + 64 * i);
            w1[i] = (u32x4){0u, 0u, 0u, 0u}; w2[i] = (u32x4){0u, 0u, 0u, 0u};
            if (m1[i] == 0) w1[i] = *(const u32x4*)(YS + (size_t)s1 * D + c);
            if (m2[i] == 0) w2[i] = *(const u32x4*)(YS + (size_t)s2 * D + c);
            wx[i] = *(const u32x4*)(xr + c); ga[i] = *(const f32x4*)(gf + c); gb[i] = *(const f32x4*)(gf + c + 4); }
#pragma unroll
        for (int i = 0; i < 4; ++i) { const int c = 8 * (lane + 64 * i);
            float y1[8], y2[8], xv[8];
            if (m1[i] == 0) unpack8(w1[i], y1); else slab_sum(slab, m1[i], SK, s1, c, y1);
            if (m2[i] == 0) unpack8(w2[i], y2); else slab_sum(slab, m2[i], SK, s2, c, y2);
            unpack8(wx[i], xv);
            f32x4 o0, o1;
#pragma unroll
            for (int e = 0; e < 4; ++e) { o0[e] = xv[e] + ga[i][e] * (g1 * y1[e] + g2 * y2[e]); o1[e] = xv[4 + e] + gb[i][e] * (g1 * y1[4 + e] + g2 * y2[4 + e]); }
            *(f32x4*)(orow + c) = o0; *(f32x4*)(orow + c + 4) = o1; }
    }
}

constexpr int NPHASE = 21;
__global__ void __launch_bounds__(NTHR, 2) mk_fwd(Args args) {
    extern __shared__ __attribute__((aligned(16))) unsigned char lds_raw[];
    LAS unsigned char* lds = (LAS unsigned char*)lds_raw;
    volatile LAS unsigned* MISC = (volatile LAS unsigned*)(lds + MISC_OFF);
    const int tid = threadIdx.x, G = gridDim.x;
    ArgsP ap = (ArgsP)__builtin_amdgcn_kernarg_segment_ptr();
    unsigned char* ws = ap->ws;
    unsigned* ctl = (unsigned*)(ws + WS_CTL);
    if (tid < 64) MISC[tid] = 0u;
    __syncthreads();
    const int lo = ap->ph_lo, hi = ap->ph_hi;
    XcdBarrier bar; bar.bar = ctl + CW_BAR; bar.x = 0; bar.st = nullptr;
    if (hi - lo > 1) bar = xcd_barrier_post(ctl + CW_BAR, MISC + 8);
#define IN(k) (lo <= (k) && (k) < hi)
#define SEAM(k) do { if (IN(k) && IN((k) + 1)) xcd_barrier(bar); } while (0)
    const float* MOD = (const float*)(ws + WS_MOD);
    bf16* HB = (bf16*)(ws + WS_HB); bf16* PROJ = (bf16*)(ws + WS_PROJ); bf16* MIX = (bf16*)(ws + WS_MIX); bf16* XW = (bf16*)(ws + WS_XW);
    bf16* ACT = (bf16*)(ws + WS_ACT);

    if (IN(0)) phase_prologue(ap, lds);
    SEAM(0);
    { constexpr int l = 0;
        const int pb = (l == 0) ? 1 : 10;
        if (IN(pb + 0)) { if (l == 0) phase_norm<0, false, 0, 2>(ap, 0, 0, ap->in[6], 0, 1); else phase_norm<1, false, 11, 2>(ap, 1, 0, ap->in[6] + D, 0, 1); }
        SEAM(pb + 0);
        if (IN(pb + 1)) { pg8::Gemm g{HB, (const bf16*)(ws + WS_WIN + (size_t)l * INC * D), D / 2}; pg8::RangeOrder<pg8::StaticOrder> S; S.so.init(MROWS / 256, INC / 256, G, (int)blockIdx.x, D / 128);
            pg8::EpiStoreI8 E{PROJ, INC, (const float*)(ws + WS_RS), (const float*)(ws + WS_CSIN) + l * INC};
            S.i0 = 0; S.n = 1 << 30; pg8::gemm_phase<2>(lds, g, S, E);
            { const int rem = S.so.nwg % G; const bool all = rem == 0; const int nel = all ? G : G - rem, e = all ? (int)blockIdx.x : (int)blockIdx.x - rem;
              __syncthreads();
              if (e >= 0) { if (l == 0) deferred_a(ap, lds, e, nel); else { int f, n; quota(0, M1_G1, nel, e, f, n); moe_convert(ap, lds, 0, f, n); } } } }
        SEAM(pb + 1);
        if (IN(pb + 2)) phase_postproj(ap, l, lds);
        SEAM(pb + 2);
        if (IN(pb + 3)) { phase_attention(ap, l, lds, ((int)blockIdx.x >> 3) % 3); __syncthreads(); }
        SEAM(pb + 3);
        if (IN(pb + 5)) { pg8::Gemm g{MIX, (const bf16*)(ws + WS_WOUT) + (size_t)l * D * D, MIXW};
            pg8::EpiResidT<l == 0, true> E{XW, MOD + l * 3 * 12288, 2, (float*)(ws + WS_SLAB), 1.0f};
            pg8::CtxTailOrder S; S.so.init(32, D / 256, G, (int)blockIdx.x, MIXW / 64); S.SK = (l == 0) ? 8 : 0; S.two = 1;
            pg8::gemm_phase<0>(lds, g, S, E); }
        SEAM(pb + 5);
        if (IN(pb + 6)) { if (l == 0) phase_norm<2, false, 8, 2>(ap, 0, 0, ap->in[7], 3, 4); else phase_norm<1, true, 0, 2>(ap, 1, 2 * LCTX, ap->in[7] + D, 3, 4, lds); }
        SEAM(pb + 6);
        if (l == 0) {
            if (IN(8)) { pg8::Gemm g{HB, (const bf16*)(ws + WS_WF13), D / 2}; pg8::RangeOrder<pg8::StaticOrder> S; S.so.init(MROWS / 256, 2 * DFF / 256, G, (int)blockIdx.x, D / 128);
                pg8::EpiSwigluI8 E{(unsigned char*)ACT, -(DFF / 128), (const float*)(ws + WS_RS), (const float*)(ws + WS_CS)};
                S.i0 = 0; S.n = 1 << 30; pg8::gemm_phase<2>(lds, g, S, E); }
            SEAM(8);
            if (IN(9)) { pg8::Gemm g{ACT, (const bf16*)(ws + WS_WF2), DFF / 2}; pg8::CtxTailOrder S; S.so.init(32, D / 256, G, (int)blockIdx.x, DFF / 128); S.SK = 11; S.two = 0;
                pg8::EpiResidT<false, false> E{XW, MOD, 5, (float*)(ws + WS_SLAB), pg8::DS2}; pg8::gemm_phase<1, pg8::EpiResidT<false, false>, pg8::CtxTailOrder, true>(lds, g, S, E); }
            SEAM(9);
        } else {
            if (IN(17)) phase_gather(ap);
            SEAM(17);
            const int* pexp = (const int*)ctl + CW_PEXP;
            if (IN(18)) { const int npan = __builtin_amdgcn_readfirstlane(pexp[96]);
                pg8::Gemm g{(const bf16*)(ws + WS_HPERM), (const bf16*)(ws + WS_WM13), D / 2}; pg8::RangeOrder<pg8::MoeOrder> S; S.so.so.init(npan, 2 * DFFE / 256, G, (int)blockIdx.x, D / 128); S.so.pexp = pexp;
                pg8::EpiSwigluI8 E{(unsigned char*)ACT, -(DFFE / 128), (const float*)(ws + WS_RSS), (const float*)(ws + WS_CSM)};
                S.i0 = 0; S.n = 1 << 30; pg8::gemm_phase<2>(lds, g, S, E); }
            SEAM(18);
            if (IN(19)) { const int npan = __builtin_amdgcn_readfirstlane(pexp[96]);
                pg8::Gemm g{ACT, (const bf16*)(ws + WS_WM2), DFFE / 2}; pg8::MoeTailOrder S; S.so.init(npan, D / 256, G, (int)blockIdx.x, DFFE / 128); S.pexp = pexp; pg8::moe_tail_params(npan, D / 256, G, S.NF, S.R, S.SK);
                pg8::EpiStoreBf16T<false> E{(bf16*)(ws + WS_YS), D, (float*)(ws + WS_SLAB), pg8::DS2}; pg8::gemm_phase<1, pg8::EpiStoreBf16T<false>, pg8::MoeTailOrder, true>(lds, g, S, E); }
            SEAM(19);
            if (IN(20)) phase_combine(ap, 1);
        }
    }
    { constexpr int l = 1;
        const int pb = (l == 0) ? 1 : 10;
        if (IN(pb + 0)) { if (l == 0) phase_norm<0, false, 0, 2>(ap, 0, 0, ap->in[6], 0, 1); else phase_norm<1, false, 11, 2>(ap, 1, 0, ap->in[6] + D, 0, 1); }
        SEAM(pb + 0);
        if (IN(pb + 1)) { pg8::Gemm g{HB, (const bf16*)(ws + WS_WIN + (size_t)l * INC * D), D / 2}; pg8::RangeOrder<pg8::StaticOrder> S; S.so.init(MROWS / 256, INC / 256, G, (int)blockIdx.x, D / 128);
            pg8::EpiStoreI8 E{PROJ, INC, (const float*)(ws + WS_RS), (const float*)(ws + WS_CSIN) + l * INC};
            S.i0 = 0; S.n = 1 << 30; pg8::gemm_phase<2>(lds, g, S, E);
            { const int rem = S.so.nwg % G; const bool all = rem == 0; const int nel = all ? G : G - rem, e = all ? (int)blockIdx.x : (int)blockIdx.x - rem;
              __syncthreads();
              if (e >= 0) { if (l == 0) deferred_a(ap, lds, e, nel); else { int f, n; quota(0, M1_G1, nel, e, f, n); moe_convert(ap, lds, 0, f, n); } } } }
        SEAM(pb + 1);
        if (IN(pb + 2)) phase_postproj(ap, l, lds);
        SEAM(pb + 2);
        if (IN(pb + 3)) { phase_attention(ap, l, lds, ((int)blockIdx.x >> 3) % 3); __syncthreads(); }
        SEAM(pb + 3);
        if (IN(pb + 5)) { pg8::Gemm g{MIX, (const bf16*)(ws + WS_WOUT) + (size_t)l * D * D, MIXW};
            pg8::EpiResidT<l == 0, true> E{XW, MOD + l * 3 * 12288, 2, (float*)(ws + WS_SLAB), 1.0f};
            pg8::CtxTailOrder S; S.so.init(32, D / 256, G, (int)blockIdx.x, MIXW / 64); S.SK = (l == 0) ? 8 : 0; S.two = 1;
            pg8::gemm_phase<0>(lds, g, S, E); }
        SEAM(pb + 5);
        if (IN(pb + 6)) { if (l == 0) phase_norm<2, false, 8, 2>(ap, 0, 0, ap->in[7], 3, 4); else phase_norm<1, true, 0, 2>(ap, 1, 2 * LCTX, ap->in[7] + D, 3, 4, lds); }
        SEAM(pb + 6);
        if (l == 0) {
            if (IN(8)) { pg8::Gemm g{HB, (const bf16*)(ws + WS_WF13), D / 2}; pg8::RangeOrder<pg8::StaticOrder> S; S.so.init(MROWS / 256, 2 * DFF / 256, G, (int)blockIdx.x, D / 128);
                pg8::EpiSwigluI8 E{(unsigned char*)ACT, -(DFF / 128), (const float*)(ws + WS_RS), (const float*)(ws + WS_CS)};
                S.i0 = 0; S.n = 1 << 30; pg8::gemm_phase<2>(lds, g, S, E); }
            SEAM(8);
            if (IN(9)) { pg8::Gemm g{ACT, (const bf16*)(ws + WS_WF2), DFF / 2}; pg8::CtxTailOrder S; S.so.init(32, D / 256, G, (int)blockIdx.x, DFF / 128); S.SK = 11; S.two = 0;
                pg8::EpiResidT<false, false> E{XW, MOD, 5, (float*)(ws + WS_SLAB), pg8::DS2}; pg8::gemm_phase<1, pg8::EpiResidT<false, false>, pg8::CtxTailOrder, true>(lds, g, S, E); }
            SEAM(9);
        } else {
            if (IN(17)) phase_gather(ap);
            SEAM(17);
            const int* pexp = (const int*)ctl + CW_PEXP;
            if (IN(18)) { const int npan = __builtin_amdgcn_readfirstlane(pexp[96]);
                pg8::Gemm g{(const bf16*)(ws + WS_HPERM), (const bf16*)(ws + WS_WM13), D / 2}; pg8::RangeOrder<pg8::MoeOrder> S; S.so.so.init(npan, 2 * DFFE / 256, G, (int)blockIdx.x, D / 128); S.so.pexp = pexp;
                pg8::EpiSwigluI8 E{(unsigned char*)ACT, -(DFFE / 128), (const float*)(ws + WS_RSS), (const float*)(ws + WS_CSM)};
                S.i0 = 0; S.n = 1 << 30; pg8::gemm_phase<2>(lds, g, S, E); }
            SEAM(18);
            if (IN(19)) { const int npan = __builtin_amdgcn_readfirstlane(pexp[96]);
                pg8::Gemm g{ACT, (const bf16*)(ws + WS_WM2), DFFE / 2}; pg8::MoeTailOrder S; S.so.init(npan, D / 256, G, (int)blockIdx.x, DFFE / 128); S.pexp = pexp; pg8::moe_tail_params(npan, D / 256, G, S.NF, S.R, S.SK);
                pg8::EpiStoreBf16T<false> E{(bf16*)(ws + WS_YS), D, (float*)(ws + WS_SLAB), pg8::DS2}; pg8::gemm_phase<1, pg8::EpiStoreBf16T<false>, pg8::MoeTailOrder, true>(lds, g, S, E); }
            SEAM(19);
            if (IN(20)) phase_combine(ap, 1);
        }
    }
#undef IN
#undef SEAM
}

extern "C" void kernel_launch(void* const* d_in, const int* in_sizes, int n_in, void* d_out, int out_size, void* d_ws, size_t ws_size, hipStream_t stream) {
    static int grid = 0;
    if (grid == 0) {
        if (n_in != 30 || out_size != NB * SEQ * D || ws_size < WS_END) { fprintf(stderr, "kernel_launch: unexpected shapes (n_in %d out %d ws %zu need %zu)\n", n_in, out_size, ws_size, (size_t)WS_END); grid = -1; return; }
        int dev = 0, cus = 0, per_cu = 0;
        if (hipGetDevice(&dev) != hipSuccess || hipDeviceGetAttribute(&cus, hipDeviceAttributeMultiprocessorCount, dev) != hipSuccess) { grid = -1; return; }
        if (hipFuncSetAttribute((const void*)mk_fwd, hipFuncAttributeMaxDynamicSharedMemorySize, LDS_BYTES) != hipSuccess) { fprintf(stderr, "kernel_launch: hipFuncSetAttribute failed\n"); grid = -1; return; }
        if (hipOccupancyMaxActiveBlocksPerMultiprocessor(&per_cu, (const void*)mk_fwd, NTHR, LDS_BYTES) != hipSuccess || per_cu < 1) { fprintf(stderr, "kernel_launch: occupancy query says %d\n", per_cu); grid = -1; return; }
        (void)hipGetLastError();
        grid = cus;
    }
    if (grid < 0) return;
    (void)hipMemsetAsync((char*)d_ws + WS_CTL, 0, CTL_ZERO_BYTES, stream);
    Args a{};
    for (int i = 0; i < 30; ++i) a.in[i] = (const float*)d_in[i];
    a.out = (float*)d_out; a.ws = (unsigned char*)d_ws;
#if MK_N_LAUNCHES == 1
    a.ph_lo = 0; a.ph_hi = NPHASE;
    hipLaunchKernelGGL(mk_fwd, dim3(grid), dim3(NTHR), LDS_BYTES, stream, a);
#else
    for (int p = 0; p < NPHASE; ++p) { a.ph_lo = p; a.ph_hi = p + 1; hipLaunchKernelGGL(mk_fwd, dim3(grid), dim3(NTHR), LDS_BYTES, stream, a); }
#endif
}
```

```cpp
#include <hip/hip_runtime.h>
#include <cstdio>
#include <cstdint>

#ifndef MK_N_LAUNCHES
#define MK_N_LAUNCHES 1
#endif

#define GAS __attribute__((address_space(1)))
#define LAS __attribute__((address_space(3)))
typedef unsigned short bf16;
typedef short bf16x8 __attribute__((ext_vector_type(8)));
typedef float f32x4 __attribute__((ext_vector_type(4)));
typedef float f32x16 __attribute__((ext_vector_type(16)));
typedef unsigned u32x4 __attribute__((ext_vector_type(4)));
typedef unsigned u32x2 __attribute__((ext_vector_type(2)));

typedef const float* const __attribute__((address_space(4)))* KArgP;
__device__ __forceinline__ unsigned char* karg_ws() { return (unsigned char*)((const void* const __attribute__((address_space(4)))*)__builtin_amdgcn_kernarg_segment_ptr())[31]; }
__device__ __forceinline__ const float* karg_in(int i) { return ((KArgP)__builtin_amdgcn_kernarg_segment_ptr())[i]; }
__device__ __forceinline__ int hide_tid() { int t = threadIdx.x; asm volatile("" : "+v"(t)); return t; }
namespace pg8 {
#define PG8_LAS __attribute__((address_space(3)))
typedef unsigned short bf16_t;
constexpr int BM = 256, BK = 64, HALF = 128, HTB = HALF * BK * 2, STAGE_BYTES = 8 * HTB, NXCD = 8, WGM = 8;

__host__ __device__ __forceinline__ int lds_byte(int r, int c) { const int st = (r >> 4) * 2 + (c >> 5), rr = r & 15, cc = c & 31, ob = rr * 64 + cc * 2; return st * 1024 + (ob ^ (((ob >> 9) & 1) << 5)); }
__host__ __device__ __forceinline__ void stage_rc(int b, int& R, int& C) { const int st = b / 1024, sb = b % 1024, swz = sb ^ (((sb >> 9) & 1) << 5); R = (st >> 1) * 16 + swz / 64; C = (st & 1) * 32 + (swz % 64) / 2; }
__host__ __device__ __forceinline__ int perm32(int rho) { const int n = rho >> 4, i = rho & 15; return 8 * (i >> 2) + 4 * n + (i & 3); }

struct Unit { int pm, pn, pb, kt0, nk, split, tslot, keep, cpart; };
struct Gemm { const bf16_t* A; const bf16_t* Bt; int K; };

struct StaticOrder {
    int nM, nN, nwg, G, c, nkfull;
    __device__ void init(int nM_, int nN_, int G_, int c_, int nk_) { nM = nM_; nN = nN_; nwg = nM * nN; G = G_; c = c_; nkfull = nk_; }
    __device__ void map(int L, Unit& u) const {
        int wgid = L; { const int q = nwg / NXCD, r = nwg % NXCD, xcd = wgid % NXCD, off = wgid / NXCD; wgid = (xcd < r ? xcd * (q + 1) : r * (q + 1) + (xcd - r) * q) + off; }
        const int nig = WGM * nN, gid = wgid / nig, fm = gid * WGM, gsz = (nM - fm) < WGM ? (nM - fm) : WGM;
        u.pm = fm + ((wgid % nig) % gsz); u.pn = (wgid % nig) / gsz; u.pb = u.pn; u.kt0 = 0; u.nk = nkfull; u.split = 0; u.tslot = 0; u.keep = 0; u.cpart = 0;
    }
    __device__ bool next(int i, Unit& u) const { const long L = (long)i * G + c; if (L >= nwg) return false; map((int)L, u); return true; }
};
struct CtxTailOrder {
    StaticOrder so; int SK, two;
    __device__ bool next(int i, Unit& u) const {
        const int L = i * so.G + so.c;
        if (L < so.nwg) { so.map(L, u); u.pm += 2; u.keep = two ? 1 : 0; return true; }
        const int s = L - so.nwg; if (s >= 16 * SK) return false;
        const int tu = s / SK, ks = s - tu * SK;
        u.pm = tu >> 3; u.pn = tu & 7; u.pb = u.pn; u.nk = so.nkfull / SK; u.kt0 = ks * u.nk; u.split = 1; u.tslot = s; u.keep = 0; u.cpart = (two && u.kt0 >= so.nkfull / 2) ? 1 : 0; return true;
    }
};
struct MoeOrder {
    StaticOrder so; const int* pexp;
    __device__ bool next(int i, Unit& u) const { if (!so.next(i, u)) return false; u.pb = __builtin_amdgcn_readfirstlane(pexp[u.pm]) * so.nN + u.pn; return true; }
};
struct MoeTailOrder {
    StaticOrder so; const int* pexp; int NF, R, SK;
    __device__ bool next(int i, Unit& u) const {
        const int L = i * so.G + so.c;
        if (L < NF) { so.map(L, u); }
        else { const int s = L - NF; if (s >= R * SK) return false; const int tu = s / SK, ks = s - tu * SK;
            so.map(NF + tu, u); u.nk = so.nkfull / SK; u.kt0 = ks * u.nk; u.split = 1; u.tslot = s; }
        u.pb = __builtin_amdgcn_readfirstlane(pexp[u.pm]) * so.nN + u.pn; return true;
    }
};
template <class Base> struct RangeOrder {
    Base so; int i0, n;
    __device__ bool next(int i, Unit& u) const { return i < n && so.next(i0 + i, u); }
};
__device__ __forceinline__ void moe_tail_params(int npan, int nN, int G, int& NF, int& R, int& SK) {
    const int total = npan * nN; NF = (total / G) * G; R = total - NF;
    SK = 1; if (R > 0) { if (R * 7 <= G) SK = 7; else if (R * 4 <= G) SK = 4; else if (R * 2 <= G) SK = 2; }
}

typedef int v8i32 __attribute__((ext_vector_type(8)));
typedef int v4i32 __attribute__((ext_vector_type(4)));
__device__ __forceinline__ v8i32 cat8(const bf16x8 lo, const bf16x8 hi) { const v4i32 a = __builtin_bit_cast(v4i32, lo), b = __builtin_bit_cast(v4i32, hi); return (v8i32){a[0], a[1], a[2], a[3], b[0], b[1], b[2], b[3]}; }
__device__ __forceinline__ unsigned pk4_fp8(float a, float b, float c, float d) {
    a = __builtin_amdgcn_fmed3f(a, -448.f, 448.f); b = __builtin_amdgcn_fmed3f(b, -448.f, 448.f); c = __builtin_amdgcn_fmed3f(c, -448.f, 448.f); d = __builtin_amdgcn_fmed3f(d, -448.f, 448.f);
    int p = __builtin_amdgcn_cvt_pk_fp8_f32(a, b, 0, false); p = __builtin_amdgcn_cvt_pk_fp8_f32(c, d, p, true); return (unsigned)p; }
constexpr float S_H = 16.f, S_W13 = 512.f, S_ACT = 8.f, S_W2 = 1024.f, DS1 = 1.0f / (16.f * 512.f), DS2 = 1.0f / (8.f * 1024.f);
__device__ __forceinline__ unsigned cvt_pk_bf16(float lo, float hi) { unsigned r; asm volatile("v_cvt_pk_bf16_f32 %0, %1, %2" : "=v"(r) : "v"(lo), "v"(hi)); return r; }

__device__ __forceinline__ void slab_store(float* slab, const f32x4 (&acc)[2][2][4][2], const f32x4 (&gv)[2][2], const Unit& u, int wr, int wc, int fr, int fq) {
    float* P = slab + (size_t)u.tslot * 65536 + (wr * 64 + fr) * 256 + wc * 32 + 4 * fq;
#pragma unroll
    for (int ai = 0; ai < 2; ++ai)
#pragma unroll
        for (int m = 0; m < 4; ++m)
#pragma unroll
            for (int bj = 0; bj < 2; ++bj)
#pragma unroll
                for (int n = 0; n < 2; ++n) *(f32x4*)(P + (ai * HALF + m * 16) * 256 + bj * HALF + n * 16) = gv[bj][n] * acc[ai][bj][m][n];
}
template <bool P> struct EpiStoreBf16T {
    static constexpr bool PERM = P;
    bf16_t* O; int ldc; float* slab; float ds;
    __device__ __forceinline__ void operator()(const f32x4 (&acc)[2][2][4][2], const Unit& u, int wr, int wc, int fr, int fq) const {
        if (!P && u.split) { const f32x4 one = {ds, ds, ds, ds}; const f32x4 gv[2][2] = {{one, one}, {one, one}}; slab_store(slab, acc, gv, u, wr, wc, fr, fq); return; }
        const int row0 = u.pm * BM + wr * 64 + fr, col0 = u.pn * BM + wc * 32 + (P ? 8 * fq : 4 * fq);
#pragma unroll
        for (int ai = 0; ai < 2; ++ai)
#pragma unroll
            for (int m = 0; m < 4; ++m) { bf16_t* rowp = O + (size_t)(row0 + ai * HALF + m * 16) * ldc + col0;
#pragma unroll
                for (int bj = 0; bj < 2; ++bj) { const f32x4 v0 = acc[ai][bj][m][0] * ds, v1 = acc[ai][bj][m][1] * ds;
                    if (P) { u32x4 w; w.x = cvt_pk_bf16(v0[0], v0[1]); w.y = cvt_pk_bf16(v0[2], v0[3]); w.z = cvt_pk_bf16(v1[0], v1[1]); w.w = cvt_pk_bf16(v1[2], v1[3]);
                        *(u32x4*)(rowp + bj * HALF) = w; }
                    else { u32x2 w0, w1; w0.x = cvt_pk_bf16(v0[0], v0[1]); w0.y = cvt_pk_bf16(v0[2], v0[3]); w1.x = cvt_pk_bf16(v1[0], v1[1]); w1.y = cvt_pk_bf16(v1[2], v1[3]);
                        *(u32x2*)(rowp + bj * HALF) = w0; *(u32x2*)(rowp + bj * HALF + 16) = w1; } } }
    }
};
typedef EpiStoreBf16T<true> EpiStoreBf16;
__device__ __forceinline__ float silu_mul(float a, float b) { return a * __builtin_amdgcn_rcpf(1.0f + __builtin_amdgcn_exp2f(-1.4426950408889634f * a)) * b; }
struct EpiSwiglu {
    static constexpr bool PERM = true;
    bf16_t* O; int ldc;
    __device__ __forceinline__ void operator()(const f32x4 (&acc)[2][2][4][2], const Unit& u, int wr, int wc, int fr, int fq) const {
        const int row0 = u.pm * BM + wr * 64 + fr, col0 = u.pn * HALF + wc * 32 + 8 * fq;
#pragma unroll
        for (int ai = 0; ai < 2; ++ai)
#pragma unroll
            for (int m = 0; m < 4; ++m) { bf16_t* rowp = O + (size_t)(row0 + ai * HALF + m * 16) * ldc + col0;
                const f32x4 a0 = acc[ai][0][m][0], a1 = acc[ai][0][m][1], b0 = acc[ai][1][m][0], b1 = acc[ai][1][m][1];
                u32x4 w; w.x = cvt_pk_bf16(silu_mul(a0[0], b0[0]), silu_mul(a0[1], b0[1])); w.y = cvt_pk_bf16(silu_mul(a0[2], b0[2]), silu_mul(a0[3], b0[3]));
                w.z = cvt_pk_bf16(silu_mul(a1[0], b1[0]), silu_mul(a1[1], b1[1])); w.w = cvt_pk_bf16(silu_mul(a1[2], b1[2]), silu_mul(a1[3], b1[3]));
                *(u32x4*)rowp = w; }
    }
};
template <bool IN8> struct EpiSwiglu8T {
    static constexpr bool PERM = true;
    unsigned char* O; int ldc;
    __device__ __forceinline__ void operator()(const f32x4 (&acc)[2][2][4][2], const Unit& u, int wr, int wc, int fr, int fq) const {
        const int row0 = u.pm * BM + wr * 64 + fr, col0 = u.pn * HALF + wc * 32 + 8 * fq;
#pragma unroll
        for (int ai = 0; ai < 2; ++ai)
#pragma unroll
            for (int m = 0; m < 4; ++m) { unsigned char* rowp = O + (size_t)(row0 + ai * HALF + m * 16) * ldc + col0;
                const float da = IN8 ? DS1 : 1.0f, db = IN8 ? DS1 * S_ACT : S_ACT;
                const f32x4 a0 = acc[ai][0][m][0] * da, a1 = acc[ai][0][m][1] * da, b0 = acc[ai][1][m][0] * db, b1 = acc[ai][1][m][1] * db;
                u32x2 w; w.x = pk4_fp8(silu_mul(a0[0], b0[0]), silu_mul(a0[1], b0[1]), silu_mul(a0[2], b0[2]), silu_mul(a0[3], b0[3]));
                w.y = pk4_fp8(silu_mul(a1[0], b1[0]), silu_mul(a1[1], b1[1]), silu_mul(a1[2], b1[2]), silu_mul(a1[3], b1[3]));
                *(u32x2*)rowp = w; }
    }
};
typedef EpiSwiglu8T<true> EpiSwiglu8;
struct EpiSwigluI8 {
    static constexpr bool PERM = true, SCALES = true;
    unsigned char* O; int ldc; const float* rs; const float* cs;
    __device__ __forceinline__ void stage_scales(PG8_LAS unsigned char* slot, const Unit& u, int tid) const {
        const float* src = tid < 256 ? rs + u.pm * BM + tid : cs + u.pb * BM + (tid - 256);
        __builtin_amdgcn_global_load_lds((const unsigned*)src, (PG8_LAS unsigned*)(slot + (tid >> 6) * 256), 4, 0, 0);
    }
    __device__ __forceinline__ void operator()(const f32x4 (&acc)[2][2][4][2], const Unit& u, int wr, int wc, int fr, int fq, const PG8_LAS unsigned char* slot) const {
        const int row0 = u.pm * BM + wr * 64 + fr, col0 = u.pn * HALF + wc * 32 + 8 * fq;
        const PG8_LAS float* rsl = (const PG8_LAS float*)slot + wr * 64 + fr;
        const PG8_LAS float* csp = (const PG8_LAS float*)slot + 256 + wc * 32 + 8 * fq;
        const float L2E = 1.4426950408889634f;
        const f32x4 ka0 = *(const PG8_LAS f32x4*)csp * -L2E, ka1 = *(const PG8_LAS f32x4*)(csp + 4) * -L2E, kb0 = *(const PG8_LAS f32x4*)(csp + HALF) * (-S_ACT / L2E), kb1 = *(const PG8_LAS f32x4*)(csp + HALF + 4) * (-S_ACT / L2E);
#pragma unroll
        for (int ai = 0; ai < 2; ++ai)
#pragma unroll
            for (int m = 0; m < 4; ++m) { const int row = row0 + ai * HALF + m * 16; const float r = rsl[ai * HALF + m * 16];
                unsigned char* rowp = ldc < 0 ? O + ((size_t)(u.pm * (-ldc) + u.pn) * BM + (row - u.pm * BM)) * 128 + (col0 - u.pn * HALF) : O + (size_t)row * ldc + col0;
                const f32x4 fa0 = __builtin_convertvector(__builtin_bit_cast(v4i32, acc[ai][0][m][0]), f32x4), fa1 = __builtin_convertvector(__builtin_bit_cast(v4i32, acc[ai][0][m][1]), f32x4);
                const f32x4 fb0 = __builtin_convertvector(__builtin_bit_cast(v4i32, acc[ai][1][m][0]), f32x4), fb1 = __builtin_convertvector(__builtin_bit_cast(v4i32, acc[ai][1][m][1]), f32x4);
                const f32x4 a0 = (fa0 * r) * ka0, a1 = (fa1 * r) * ka1, b0 = (fb0 * r) * kb0, b1 = (fb1 * r) * kb1;
                f32x4 e0, e1;
#pragma unroll
                for (int j = 0; j < 4; ++j) { e0[j] = __builtin_amdgcn_exp2f(a0[j]); e1[j] = __builtin_amdgcn_exp2f(a1[j]); }
                e0 = e0 + 1.0f; e1 = e1 + 1.0f;
#pragma unroll
                for (int j = 0; j < 4; ++j) { e0[j] = __builtin_amdgcn_rcpf(e0[j]); e1[j] = __builtin_amdgcn_rcpf(e1[j]); }
                const f32x4 v0 = (a0 * b0) * e0, v1 = (a1 * b1) * e1;
                u32x2 w; w.x = pk4_fp8(v0[0], v0[1], v0[2], v0[3]); w.y = pk4_fp8(v1[0], v1[1], v1[2], v1[3]);
                *(u32x2*)rowp = w; }
    }
};
struct EpiStoreI8 {
    static constexpr bool PERM = true, SCALES = true;
    bf16_t* O; int ldc; const float* rs; const float* cs;
    __device__ __forceinline__ void stage_scales(PG8_LAS unsigned char* slot, const Unit& u, int tid) const {
        const float* src = tid < 256 ? rs + u.pm * BM + tid : cs + u.pb * BM + (tid - 256);
        __builtin_amdgcn_global_load_lds((const unsigned*)src, (PG8_LAS unsigned*)(slot + (tid >> 6) * 256), 4, 0, 0);
    }
    __device__ __forceinline__ void operator()(const f32x4 (&acc)[2][2][4][2], const Unit& u, int wr, int wc, int fr, int fq, const PG8_LAS unsigned char* slot) const {
        const int row0 = u.pm * BM + wr * 64 + fr, col0 = u.pn * BM + wc * 32 + 8 * fq;
        const PG8_LAS float* rsl = (const PG8_LAS float*)slot + wr * 64 + fr;
        const PG8_LAS float* csp = (const PG8_LAS float*)slot + 256 + wc * 32 + 8 * fq;
        f32x4 c[2][2];
#pragma unroll
        for (int bj = 0; bj < 2; ++bj)
#pragma unroll
            for (int n = 0; n < 2; ++n) c[bj][n] = *(const PG8_LAS f32x4*)(csp + bj * HALF + 4 * n);
#pragma unroll
        for (int ai = 0; ai < 2; ++ai)
#pragma unroll
            for (int m = 0; m < 4; ++m) { const float r = rsl[ai * HALF + m * 16]; bf16_t* rowp = O + (size_t)(row0 + ai * HALF + m * 16) * ldc + col0;
#pragma unroll
                for (int bj = 0; bj < 2; ++bj) {
                    const f32x4 v0 = (__builtin_convertvector(__builtin_bit_cast(v4i32, acc[ai][bj][m][0]), f32x4) * r) * c[bj][0], v1 = (__builtin_convertvector(__builtin_bit_cast(v4i32, acc[ai][bj][m][1]), f32x4) * r) * c[bj][1];
                    u32x4 w; w.x = cvt_pk_bf16(v0[0], v0[1]); w.y = cvt_pk_bf16(v0[2], v0[3]); w.z = cvt_pk_bf16(v1[0], v1[1]); w.w = cvt_pk_bf16(v1[2], v1[3]);
                    *(u32x4*)(rowp + bj * HALF) = w; } }
    }
};
template <class E> struct has_mid { template <class T> static constexpr bool f(decltype(T::MID)*) { return T::MID; } template <class T> static constexpr bool f(...) { return false; } static constexpr bool value = f<E>(nullptr); };
template <class E> struct has_scales { template <class T> static constexpr bool f(decltype(T::SCALES)*) { return T::SCALES; } template <class T> static constexpr bool f(...) { return false; } static constexpr bool value = f<E>(nullptr); };
constexpr int SCALE_SLOT_OFF = STAGE_BYTES, SCALE_SLOT_BYTES = 2048;
constexpr size_t SSQ_OFF = (size_t)3 << 20;
template <bool FIRST, bool MIDC> struct EpiResidT {
    static constexpr bool PERM = false, MID = MIDC;
    bf16_t* X; const float* modl; int chunk; float* slab; float ds;
    __device__ __forceinline__ float rowfac(int row) const { const float* ssq = (const float*)(karg_ws() + SSQ_OFF);
        const f32x4 s0 = *(const f32x4*)(ssq + (size_t)row * 8), s1 = *(const f32x4*)(ssq + (size_t)row * 8 + 4);
        return __builtin_amdgcn_rsqf(((s0[0] + s0[1]) + (s0[2] + s0[3]) + (s1[0] + s1[1]) + (s1[2] + s1[3])) * (1.0f / 1024.0f) + 1e-6f); }
    __device__ __forceinline__ void mid(f32x4 (&acc)[2][2][4][2], const Unit& u, int wr, int wc, int fr, int fq) const {
        const int row0 = u.pm * BM + wr * 64 + fr;
#pragma unroll
        for (int ai = 0; ai < 2; ++ai)
#pragma unroll
            for (int m = 0; m < 4; ++m) { const float r = rowfac(row0 + ai * HALF + m * 16);
#pragma unroll
                for (int bj = 0; bj < 2; ++bj)
#pragma unroll
                    for (int n = 0; n < 2; ++n) acc[ai][bj][m][n] = acc[ai][bj][m][n] * r;
                asm volatile("" ::: "memory"); }
    }
    __device__ __forceinline__ void operator()(const f32x4 (&acc)[2][2][4][2], const Unit& u, int wr, int wc, int fr, int fq) const {
        const int pmg = u.pm, v = pmg < 2 ? 2 : ((pmg - 2) >> 4);
        const float* gate = modl + v * 12288 + chunk * 2048;
        const int row0 = pmg * BM + wr * 64 + fr, col0 = u.pn * BM + wc * 32 + 4 * fq;
        f32x4 gv[2][2];
#pragma unroll
        for (int bj = 0; bj < 2; ++bj)
#pragma unroll
            for (int n = 0; n < 2; ++n) gv[bj][n] = *(const f32x4*)(gate + col0 + bj * HALF + n * 16) * ds;
        if (u.split) {
            float* P = slab + (size_t)u.tslot * 65536 + (wr * 64 + fr) * 256 + wc * 32 + 4 * fq;
#pragma unroll
            for (int ai = 0; ai < 2; ++ai)
#pragma unroll
                for (int m = 0; m < 4; ++m) { const float r = (MIDC && u.cpart) ? rowfac(row0 + ai * HALF + m * 16) : 1.0f;
#pragma unroll
                    for (int bj = 0; bj < 2; ++bj)
#pragma unroll
                        for (int n = 0; n < 2; ++n) *(f32x4*)(P + (ai * HALF + m * 16) * 256 + bj * HALF + n * 16) = gv[bj][n] * acc[ai][bj][m][n] * r;
                    asm volatile("" ::: "memory"); }
            return; }
        const float* xin = FIRST ? (pmg < 2 ? karg_in(2) : karg_in(0) - (size_t)512 * 2048) : nullptr;
#pragma unroll
        for (int ai = 0; ai < 2; ++ai)
#pragma unroll
            for (int m = 0; m < 4; ++m) { const size_t ro = (size_t)(row0 + ai * HALF + m * 16) * 2048 + col0;
#pragma unroll
                for (int bj = 0; bj < 2; ++bj)
#pragma unroll
                    for (int n = 0; n < 2; ++n) { const size_t o = ro + bj * HALF + n * 16; f32x4 b;
                        if (FIRST) b = *(const f32x4*)(xin + o);
                        else { const u32x2 w = *(const u32x2*)(X + o); b = (f32x4){__builtin_bit_cast(float, w.x << 16), __builtin_bit_cast(float, w.x & 0xffff0000u), __builtin_bit_cast(float, w.y << 16), __builtin_bit_cast(float, w.y & 0xffff0000u)}; }
                        b = b + gv[bj][n] * acc[ai][bj][m][n];
                        u32x2 w2; w2.x = cvt_pk_bf16(b[0], b[1]); w2.y = cvt_pk_bf16(b[2], b[3]); *(u32x2*)(X + o) = w2; } }
    }
};

template <int MODE  , class Epi, class Sched, bool BLK = false>
__device__ __forceinline__ void gemm_phase(PG8_LAS unsigned char* lds, const Gemm g, const Sched& S, const Epi& E) {
    const int tid = hide_tid(), wid = __builtin_amdgcn_readfirstlane(tid >> 6), lane = tid & 63, wr = wid >> 2, wc = wid & 3, fr = lane & 15, fq = lane >> 4;
    const int K = g.K;
    unsigned voffA[2], voffB[2];
#pragma unroll
    for (int i = 0; i < 2; ++i) { int R, C; stage_rc(tid * 16 + i * 8192, R, C); const int Rb = Epi::PERM ? ((R & ~31) + perm32(R & 31)) : R;
        voffA[i] = BLK ? (unsigned)(R * 64 + C) * 2u : (unsigned)(R * K + C) * 2u; voffB[i] = BLK ? (unsigned)(Rb * 64 + C) * 2u : (unsigned)(Rb * K + C) * 2u; }
    const size_t kstep = BLK ? (size_t)(BM * BK * 2) : (size_t)(BK * 2);
    const size_t hstep = BLK ? (size_t)(HALF * BK * 2) : (size_t)HALF * K * 2;
    const size_t tstep = (size_t)BM * K * 2;
    const unsigned ldsw = (unsigned)wid * 1024u;
    const int aoff = lds_byte(wr * 64 + fr, fq * 8), boff = lds_byte(wc * 32 + fr, fq * 8);
#define PG8_SA(b, h) (((b) * 2 + (h)) * HTB)
#define PG8_SB(b, h) ((4 + (b) * 2 + (h)) * HTB)
#define PG8_STAGE(bufoff, gbase, voff) do { _Pragma("unroll") for (int _i = 0; _i < 2; ++_i) { unsigned _o = (voff)[_i]; asm volatile("" : "+v"(_o)); \
        __builtin_amdgcn_global_load_lds((const unsigned*)((const char*)(gbase) + _o), (PG8_LAS unsigned*)(lds + (bufoff) + ldsw + _i * 8192), 16, 0, 0); } } while (0)
#define PG8_LDA(dst, b, h) do { _Pragma("unroll") for (int m = 0; m < 4; ++m) _Pragma("unroll") for (int k = 0; k < 2; ++k) dst[m][k] = *(const PG8_LAS bf16x8*)(lds + PG8_SA(b, h) + aoff + m * 2048 + k * 1024); } while (0)
#define PG8_LDB(dst, b, h) do { _Pragma("unroll") for (int n = 0; n < 2; ++n) _Pragma("unroll") for (int k = 0; k < 2; ++k) dst[n][k] = *(const PG8_LAS bf16x8*)(lds + PG8_SB(b, h) + boff + n * 2048 + k * 1024); } while (0)
#define PG8_MMA(ai, bj, At, Bt) do { __builtin_amdgcn_s_setprio(1); _Pragma("unroll") for (int m = 0; m < 4; ++m) _Pragma("unroll") for (int n = 0; n < 2; ++n) { \
        if constexpr (MODE == 1) { acc[ai][bj][m][n] = __builtin_amdgcn_mfma_scale_f32_16x16x128_f8f6f4(cat8(Bt[n][0], Bt[n][1]), cat8(At[m][0], At[m][1]), acc[ai][bj][m][n], 0, 0, 0, 0, 0, 0); } \
        else if constexpr (MODE == 2) { _Pragma("unroll") for (int k = 0; k < 2; ++k) acc[ai][bj][m][n] = __builtin_bit_cast(f32x4, __builtin_amdgcn_mfma_i32_16x16x64_i8(__builtin_bit_cast(v4i32, Bt[n][k]), __builtin_bit_cast(v4i32, At[m][k]), __builtin_bit_cast(v4i32, acc[ai][bj][m][n]), 0, 0, 0)); } \
        else { _Pragma("unroll") for (int k = 0; k < 2; ++k) acc[ai][bj][m][n] = __builtin_amdgcn_mfma_f32_16x16x32_bf16(Bt[n][k], At[m][k], acc[ai][bj][m][n], 0, 0, 0); } } \
        __builtin_amdgcn_s_setprio(0); } while (0)
#define PG8_WAIT_V(n) asm volatile("s_waitcnt vmcnt(" #n ")" ::: "memory")
#define PG8_WAIT_L(n) asm volatile("s_waitcnt lgkmcnt(" #n ")" ::: "memory")
#define PG8_BAR __builtin_amdgcn_s_barrier()
#define PG8_SCHED __builtin_amdgcn_sched_barrier(0)
    Unit cur, nxt; int ui = 0;
    if (!S.next(0, cur)) return;
    f32x4 acc[2][2][4][2];
#pragma unroll
    for (int a = 0; a < 2; ++a)
#pragma unroll
        for (int b = 0; b < 2; ++b)
#pragma unroll
            for (int m = 0; m < 4; ++m)
#pragma unroll
                for (int n = 0; n < 2; ++n) acc[a][b][m][n] = (f32x4){0.f, 0.f, 0.f, 0.f};
    bf16x8 At[4][2], B0[2][2], B1[2][2];
    const char* cA = (const char*)g.A + (size_t)cur.pm * tstep + (size_t)cur.kt0 * kstep; const char* cB = (const char*)g.Bt + (size_t)cur.pb * tstep + (size_t)cur.kt0 * kstep;
#define PG8_WOFS(u) ((has_mid<Epi>::value && (u).keep) ? (size_t)((u).nk / 2) * kstep : (size_t)0)
    const char* fA = cA + PG8_WOFS(cur); const char* fB = cB + PG8_WOFS(cur);
    if constexpr (has_scales<Epi>::value) E.stage_scales(lds + SCALE_SLOT_OFF, cur, tid);
    PG8_STAGE(PG8_SB(0, 0), fB, voffB); PG8_STAGE(PG8_SB(0, 1), fB + hstep, voffB); PG8_STAGE(PG8_SA(0, 0), fA, voffA); PG8_STAGE(PG8_SA(0, 1), fA + hstep, voffA);
    if (wr == 1) PG8_BAR;
    PG8_WAIT_V(2); PG8_BAR;
    PG8_STAGE(PG8_SB(1, 0), fB + kstep, voffB); PG8_STAGE(PG8_SA(1, 0), fA + kstep, voffA); PG8_STAGE(PG8_SB(1, 1), fB + hstep + kstep, voffB);
    PG8_WAIT_V(6); PG8_BAR;
    for (;;) {
        const bool has_next = S.next(ui + 1, nxt);
        const char* nA0 = has_next ? (const char*)g.A + (size_t)nxt.pm * tstep + (size_t)nxt.kt0 * kstep : cA; const char* nB0 = has_next ? (const char*)g.Bt + (size_t)nxt.pb * tstep + (size_t)nxt.kt0 * kstep : cB;
        const char* nA = has_next ? nA0 + PG8_WOFS(nxt) : fA; const char* nB = has_next ? nB0 + PG8_WOFS(nxt) : fB;
        const int nt = cur.nk;
        const bool wrapu = has_mid<Epi>::value && cur.keep; const int halfk = nt >> 1;
        for (int t = 0; t < nt; t += 2) {
            const bool last = (t == nt - 2);
#define PG8_KOFF(tt) ((size_t)(wrapu ? ((tt) < halfk ? (tt) + halfk : (tt) - halfk) : (tt)) * kstep)
            const char* a1 = cA + PG8_KOFF(t + 1);
            const char* a2 = last ? nA : cA + PG8_KOFF(t + 2); const char* b2 = last ? nB : cB + PG8_KOFF(t + 2);
            const char* a3 = a2 + kstep; const char* b3 = b2 + kstep;
            if constexpr (has_mid<Epi>::value) { if (wrapu && t == halfk) { const int tz = hide_tid(), wz = __builtin_amdgcn_readfirstlane(tz >> 6), lz = tz & 63; E.mid(acc, cur, wz >> 2, wz & 3, lz & 15, lz >> 4); } }
            if constexpr (has_scales<Epi>::value) { if (last && has_next) E.stage_scales(lds + SCALE_SLOT_OFF + ((ui + 1) & 1) * SCALE_SLOT_BYTES, nxt, tid); }
            PG8_LDB(B0, 0, 0); PG8_LDB(B1, 0, 1); PG8_SCHED; PG8_LDA(At, 0, 0); PG8_STAGE(PG8_SA(1, 1), a1 + hstep, voffA);
            PG8_WAIT_V(8); PG8_WAIT_L(0); PG8_BAR; PG8_MMA(0, 0, At, B0); PG8_MMA(0, 1, At, B1); PG8_BAR; PG8_SCHED;
            PG8_LDA(At, 0, 1); PG8_STAGE(PG8_SB(0, 0), b2, voffB); PG8_STAGE(PG8_SB(0, 1), b2 + hstep, voffB); PG8_STAGE(PG8_SA(0, 0), a2, voffA);
            PG8_WAIT_V(8); PG8_WAIT_L(0); PG8_BAR; PG8_MMA(1, 0, At, B0); PG8_MMA(1, 1, At, B1); PG8_BAR; PG8_SCHED;
            PG8_LDB(B0, 1, 0); PG8_LDB(B1, 1, 1); PG8_SCHED; PG8_LDA(At, 1, 0); PG8_STAGE(PG8_SA(0, 1), a2 + hstep, voffA);
            PG8_WAIT_V(8); PG8_WAIT_L(0); PG8_BAR; PG8_MMA(0, 0, At, B0); PG8_MMA(0, 1, At, B1); PG8_BAR; PG8_SCHED;
            PG8_LDA(At, 1, 1); PG8_STAGE(PG8_SB(1, 0), b3, voffB); PG8_STAGE(PG8_SB(1, 1), b3 + hstep, voffB); PG8_STAGE(PG8_SA(1, 0), a3, voffA);
            PG8_WAIT_V(8); PG8_WAIT_L(0); PG8_BAR; PG8_MMA(1, 0, At, B0); PG8_MMA(1, 1, At, B1); PG8_BAR; PG8_SCHED;
        }
        if (wr == 0) PG8_BAR;
        { const int tz = hide_tid(), wz = __builtin_amdgcn_readfirstlane(tz >> 6), lz = tz & 63;
          if constexpr (has_scales<Epi>::value) E(acc, cur, wz >> 2, wz & 3, lz & 15, lz >> 4, lds + SCALE_SLOT_OFF + (ui & 1) * SCALE_SLOT_BYTES);
          else E(acc, cur, wz >> 2, wz & 3, lz & 15, lz >> 4); }
        if (!has_next) break;
#pragma unroll
        for (int a = 0; a < 2; ++a)
#pragma unroll
            for (int b = 0; b < 2; ++b)
#pragma unroll
                for (int m = 0; m < 4; ++m)
#pragma unroll
                    for (int n = 0; n < 2; ++n) acc[a][b][m][n] = (f32x4){0.f, 0.f, 0.f, 0.f};
        cur = nxt; cA = nA0; cB = nB0; fA = nA; fB = nB; ++ui;
        if (wr == 1) PG8_BAR;
    }
    PG8_WAIT_V(0);
    PG8_BAR;
#undef PG8_SA
#undef PG8_WOFS
#undef PG8_KOFF
#undef PG8_SB
#undef PG8_STAGE
#undef PG8_LDA
#undef PG8_LDB
#undef PG8_MMA
#undef PG8_WAIT_V
#undef PG8_WAIT_L
#undef PG8_BAR
#undef PG8_SCHED
}
}

constexpr int D = 2048, NB = 2, SEQ = 4096, LCTX = 256, NKEY = SEQ + LCTX;
constexpr int MROWS = NB * NKEY;
constexpr int INC = 4608, MIXW = 2048, DFF = 5632, NEXP = 8, DFFE = 7168;
constexpr int C_AQ = 0, C_AK = 512, C_AV = 1024, C_BB = 1536, C_BC = 2048, C_BX = 2560, C_CQ = 3072, C_CK = 4096, C_CV = 4352;
constexpr float EPS = 1e-6f;
constexpr int MAXSLOT = 2 * NB * SEQ + NEXP * 256;
constexpr int NWAVES = 8, NTHR = 512;

constexpr size_t MiB = 1u << 20;
constexpr size_t WS_CTL = 0, CTL_ZERO_BYTES = 128 * 1024;
constexpr size_t WS_MOD = 1 * MiB;
constexpr size_t WS_TOK = 2 * MiB;
constexpr size_t WS_CSM = 2 * MiB + 512 * 1024;
constexpr size_t WS_RSS = 3 * MiB + 576 * 1024;
constexpr size_t WS_RS = 3 * MiB + 512 * 1024;
constexpr size_t WS_CS = 3 * MiB + 768 * 1024;
constexpr size_t WS_CSIN = 3 * MiB + 832 * 1024;
constexpr size_t WS_SSQ = 3 * MiB; static_assert(WS_SSQ == pg8::SSQ_OFF, "SSQ offset");
constexpr size_t WS_WIN = 4 * MiB;
constexpr size_t WS_WOUT = WS_WIN + (size_t)2 * INC * D * 2;
constexpr size_t WS_WF13 = WS_WOUT + (size_t)2 * D * D * 2;
constexpr size_t WS_WF2 = WS_WF13 + (size_t)2 * DFF * D * 2;
constexpr size_t WS_WM13 = WS_WF2 + (size_t)D * DFF * 2;
constexpr size_t WS_WM2 = WS_WM13 + (size_t)NEXP * 2 * DFFE * D * 2;
constexpr size_t WS_XW = WS_WM2 + (size_t)NEXP * D * DFFE * 2;
constexpr size_t WS_HB = WS_XW + (size_t)MROWS * D * 4;
constexpr size_t WS_PROJ = WS_HB + (size_t)MROWS * D * 2;
constexpr size_t WS_VTA = WS_PROJ + (size_t)MROWS * INC * 2;
constexpr size_t WS_VTC = WS_VTA + (size_t)NB * 4 * 128 * NKEY * 2;
constexpr size_t WS_MIX = WS_VTC + (size_t)NB * 2 * 128 * NKEY * 2;
constexpr size_t WS_ACT = WS_MIX + (size_t)MROWS * MIXW * 2;
constexpr size_t WS_HPERM = WS_ACT + (size_t)MAXSLOT * DFFE * 2;
constexpr size_t WS_YS = WS_HPERM + (size_t)MAXSLOT * D * 2;
constexpr size_t WS_SLAB = WS_YS + (size_t)MAXSLOT * D * 2;
constexpr size_t WS_END = WS_SLAB + (size_t)256 * 65536 * 4;
constexpr int CW_BAR = 4096;
constexpr int CW_CNT = 16384;
constexpr int CW_TMODE = 24576;
constexpr int CW_PEXP = 20480;

constexpr int LDS_BYTES = 147456;
constexpr int MISC_OFF = LDS_BYTES - 256;

__device__ __forceinline__ unsigned f2bf(float f) { unsigned u = __builtin_bit_cast(unsigned, f); return (u + 0x7fffu + ((u >> 16) & 1u)) >> 16; }
__device__ __forceinline__ unsigned pk2(float lo, float hi) { return pg8::cvt_pk_bf16(lo, hi); }
__device__ __forceinline__ float bflo(unsigned w) { return __builtin_bit_cast(float, w << 16); }
__device__ __forceinline__ float bfhi(unsigned w) { return __builtin_bit_cast(float, w & 0xffff0000u); }
__device__ __forceinline__ float wave_sum(float v) {
#pragma unroll
    for (int o = 1; o < 64; o <<= 1) v += __shfl_xor(v, o);
    return v;
}
__device__ __forceinline__ void unpack8(const u32x4 w, float (&f)[8]) { f[0] = bflo(w.x); f[1] = bfhi(w.x); f[2] = bflo(w.y); f[3] = bfhi(w.y); f[4] = bflo(w.z); f[5] = bfhi(w.z); f[6] = bflo(w.w); f[7] = bfhi(w.w); }
__device__ __forceinline__ u32x4 pack8(const float (&f)[8]) { u32x4 w; w.x = pk2(f[0], f[1]); w.y = pk2(f[2], f[3]); w.z = pk2(f[4], f[5]); w.w = pk2(f[6], f[7]); return w; }
__device__ __forceinline__ int rowmap(int b, int j) { return j < LCTX ? b * LCTX + j : 2 * LCTX + b * SEQ + (j - LCTX); }

#define XB_TMO      128
#define XB_XCNT(j)  (256  + 64 * (j))
#define XB_XSUB(j)  (1280 + 64 * (j))
#define XB_XGEN(j)  (2304 + 64 * (j))
#define XB_TOP      3328
#define XB_TOPGEN   3392
#define XCD_BAR_WORDS 3456
#define XB_SPIN_CAP (1u << 18)
__device__ __forceinline__ unsigned xb_ld(unsigned* p)              { return __hip_atomic_load(p, __ATOMIC_RELAXED, __HIP_MEMORY_SCOPE_AGENT); }
__device__ __forceinline__ unsigned xb_add(unsigned* p, unsigned v) { return __hip_atomic_fetch_add(p, v, __ATOMIC_RELAXED, __HIP_MEMORY_SCOPE_AGENT); }
__device__ __forceinline__ unsigned xb_xcc_id() { return (unsigned)__builtin_amdgcn_s_getreg((3 << 11) | 20) & 0xFu; }
#define XB_SPIN(cond, bar) do { unsigned _sp = 0; while (cond) { __builtin_amdgcn_s_sleep(1); \
    if ((++_sp & 255u) == 0u) { if (xb_ld(&(bar)[XB_TMO])) break; if (_sp > XB_SPIN_CAP) { atomicAdd(&(bar)[XB_TMO], 1u); break; } } } } while (0)
struct XcdBarrier { unsigned* bar; unsigned x; volatile LAS unsigned* st; };
__device__ __forceinline__ XcdBarrier xcd_barrier_post(unsigned* bar, volatile LAS unsigned* st) {
    XcdBarrier b; b.bar = bar; b.x = xb_xcc_id(); b.st = st;
    if (threadIdx.x == 0) (void)xb_add(&bar[XB_XCNT(b.x)], 1u);
    return b;
}
__device__ __forceinline__ void xcd_barrier_complete(unsigned* bar, unsigned x, unsigned& nloc, unsigned& nx) {
    const unsigned G = gridDim.x * gridDim.y * gridDim.z;
    unsigned sum, cnt, mine, sp = 0u;
    for (;;) {
        sum = 0u; cnt = 0u; mine = 0u;
#pragma unroll
        for (unsigned j = 0; j < 16; ++j) { const unsigned c = xb_ld(&bar[XB_XCNT(j)]); sum += c; cnt += (c > 0u) ? 1u : 0u; mine = (j == x) ? c : mine; }
        if (sum == G) break;
        __builtin_amdgcn_s_sleep(1);
        if ((++sp & 255u) == 0u) { if (xb_ld(&bar[XB_TMO])) break; if (sp > XB_SPIN_CAP) { atomicAdd(&bar[XB_TMO], 1u); break; } }
    }
    nloc = mine > 0u ? mine : 1u; nx = cnt > 0u ? cnt : 1u;
}
__device__ __forceinline__ void xcd_barrier(const XcdBarrier& b) {
    asm volatile("s_waitcnt vmcnt(0)" ::: "memory");
    __syncthreads();
    if (threadIdx.x == 0) {
        unsigned* bar = b.bar;
        __builtin_amdgcn_s_waitcnt(0);
        unsigned nloc = b.st[0], nx = b.st[1];
        if (nloc == 0u) { xcd_barrier_complete(bar, b.x, nloc, nx); b.st[0] = nloc; b.st[1] = nx; }
        const unsigned old = xb_add(&bar[XB_XSUB(b.x)], 1u);
        const unsigned gen = old / nloc;
        if (old + 1u == (gen + 1u) * nloc) {
            __builtin_amdgcn_fence(__ATOMIC_RELEASE, "agent");
            asm volatile("s_waitcnt vmcnt(0)" ::: "memory");
            const unsigned og = xb_add(&bar[XB_TOP], 1u);
            const unsigned tg = og / nx;
            if (og + 1u == (tg + 1u) * nx) xb_add(&bar[XB_TOPGEN], 1u);
            else XB_SPIN(xb_ld(&bar[XB_TOPGEN]) == tg, bar);
            __builtin_amdgcn_fence(__ATOMIC_ACQUIRE, "agent");
            xb_add(&bar[XB_XGEN(b.x)], 1u);
            asm volatile("s_waitcnt vmcnt(0)" ::: "memory");
        } else {
            XB_SPIN(xb_ld(&bar[XB_XGEN(b.x)]) == gen, bar);
            __builtin_amdgcn_fence(__ATOMIC_ACQUIRE, "agent");
            asm volatile("s_waitcnt vmcnt(0)" ::: "memory");
        }
    }
    __syncthreads();
}

struct Args { const float* in[30]; float* out; unsigned char* ws; int ph_lo, ph_hi; };
typedef const __attribute__((address_space(4))) Args* ArgsP;


__device__ __forceinline__ void xpose_item(const float* __restrict__ W, int ldw, int k0, int n0, bf16* __restrict__ dst0, int ldd, LAS float* scr, int lane) {
    f32x4 v[16];
    const float* src = W + (size_t)(k0 + (lane >> 4)) * ldw + n0 + 4 * (lane & 15);
#pragma unroll
    for (int i = 0; i < 16; ++i) v[i] = __builtin_nontemporal_load((const f32x4*)(src + (size_t)(4 * i) * ldw));
#pragma unroll
    for (int i = 0; i < 16; ++i) { LAS float* s = scr + (4 * i + (lane >> 4)) * 65 + 4 * (lane & 15); s[0] = v[i][0]; s[1] = v[i][1]; s[2] = v[i][2]; s[3] = v[i][3]; }
    asm volatile("s_waitcnt lgkmcnt(0)" ::: "memory");
    const int c = lane & 7;
#pragma unroll
    for (int j = 0; j < 8; ++j) { const int n = (lane >> 3) + 8 * j; const LAS float* s = scr + (8 * c) * 65 + n;
        u32x4 o; o.x = pk2(s[0 * 65], s[1 * 65]); o.y = pk2(s[2 * 65], s[3 * 65]); o.z = pk2(s[4 * 65], s[5 * 65]); o.w = pk2(s[6 * 65], s[7 * 65]);
        __builtin_nontemporal_store(o, (u32x4*)(dst0 + (size_t)n * ldd + k0 + 8 * c)); }
    asm volatile("s_waitcnt lgkmcnt(0)" ::: "memory");
}
__device__ __forceinline__ void xpose_item8(const float* __restrict__ W, int ldw, int k0, int n0, unsigned char* __restrict__ dst0, int ldd, int kofs, float scale, LAS float* scr, int lane) {
    f32x4 v[16];
    const float* src = W + (size_t)(k0 + (lane >> 4)) * ldw + n0 + 4 * (lane & 15);
#pragma unroll
    for (int i = 0; i < 16; ++i) v[i] = __builtin_nontemporal_load((const f32x4*)(src + (size_t)(4 * i) * ldw));
#pragma unroll
    for (int i = 0; i < 16; ++i) { LAS float* s = scr + (4 * i + (lane >> 4)) * 65 + 4 * (lane & 15); s[0] = v[i][0] * scale; s[1] = v[i][1] * scale; s[2] = v[i][2] * scale; s[3] = v[i][3] * scale; }
    asm volatile("s_waitcnt lgkmcnt(0)" ::: "memory");
    const int c = lane & 3;
#pragma unroll
    for (int j = 0; j < 4; ++j) { const int n = (lane >> 2) + 16 * j; const LAS float* s = scr + (16 * c) * 65 + n;
        u32x4 o; o.x = pg8::pk4_fp8(s[0 * 65], s[1 * 65], s[2 * 65], s[3 * 65]); o.y = pg8::pk4_fp8(s[4 * 65], s[5 * 65], s[6 * 65], s[7 * 65]);
        o.z = pg8::pk4_fp8(s[8 * 65], s[9 * 65], s[10 * 65], s[11 * 65]); o.w = pg8::pk4_fp8(s[12 * 65], s[13 * 65], s[14 * 65], s[15 * 65]);
        __builtin_nontemporal_store(o, (u32x4*)(dst0 + (size_t)n * ldd + kofs + 16 * c)); }
    asm volatile("s_waitcnt lgkmcnt(0)" ::: "memory");
}
__device__ __forceinline__ void xpose_item_i8(const float* __restrict__ W, int ldw, int k0, int n0, unsigned char* __restrict__ dst0, int ldd, const float* __restrict__ cs, LAS float* scr, int lane) {
    f32x4 v[16];
    const float* src = W + (size_t)(k0 + (lane >> 4)) * ldw + n0 + 4 * (lane & 15);
#pragma unroll
    for (int i = 0; i < 16; ++i) v[i] = __builtin_nontemporal_load((const f32x4*)(src + (size_t)(4 * i) * ldw));
#pragma unroll
    for (int i = 0; i < 16; ++i) { LAS float* s = scr + (4 * i + (lane >> 4)) * 65 + 4 * (lane & 15); s[0] = v[i][0]; s[1] = v[i][1]; s[2] = v[i][2]; s[3] = v[i][3]; }
    asm volatile("s_waitcnt lgkmcnt(0)" ::: "memory");
    const int c = lane & 3;
#pragma unroll
    for (int j = 0; j < 4; ++j) { const int n = (lane >> 2) + 16 * j; const LAS float* s = scr + (16 * c) * 65 + n; const float d = cs[n], q = d > 1e-30f ? 1.0f / d : 0.f;
        unsigned o[4];
#pragma unroll
        for (int g = 0; g < 4; ++g) { int qi[4];
#pragma unroll
            for (int e = 0; e < 4; ++e) qi[e] = (int)rintf(__builtin_amdgcn_fmed3f(s[(4 * g + e) * 65] * q, -127.f, 127.f));
            o[g] = (unsigned)(qi[0] & 255) | ((unsigned)(qi[1] & 255) << 8) | ((unsigned)(qi[2] & 255) << 16) | ((unsigned)(qi[3] & 255) << 24); }
        __builtin_nontemporal_store((u32x4){o[0], o[1], o[2], o[3]}, (u32x4*)(dst0 + (size_t)n * ldd + k0 + 16 * c)); }
    asm volatile("s_waitcnt lgkmcnt(0)" ::: "memory");
}
__device__ __forceinline__ void xpose_mat8(const float* W, int K, int N, unsigned char* dst, bool ilv, int ilv_off, float scale, int item, LAS float* scr, int lane) {
    const int ntn = N >> 6, kb = item / ntn, nb = item - kb * ntn, k0 = kb * 64, n0 = nb * 64;
    const int drow = ilv ? ((n0 >> 7) * 256 + (n0 & 127) + ilv_off) : n0;
    xpose_item8(W, N, k0, n0, dst + ((size_t)((drow >> 8) * (K >> 7) + (k0 >> 7)) * 256 + (drow & 255)) * 128, 128, k0 & 127, scale, scr, lane);
}
__device__ __forceinline__ void xpose_mat(const float* W, int K, int N, bf16* dst, bool ilv, int ilv_off, int item, LAS float* scr, int lane) {
    const int ntn = N >> 6, kb = item / ntn, nb = item - kb * ntn, k0 = kb * 64, n0 = nb * 64;
    const int drow = ilv ? ((n0 >> 7) * 256 + (n0 & 127) + ilv_off) : n0;
    xpose_item(W, N, k0, n0, dst + (size_t)drow * K, K, scr, lane);
}
__device__ __forceinline__ float silu_f(float x) { return x / (1.0f + __expf(-x)); }

__device__ __forceinline__ void mod_strips(ArgsP a, LAS unsigned char* lds, int s0, int s1, int stride) {
    const int tid = hide_tid();
    unsigned char* ws = a->ws;
    LAS float* sc = (LAS float*)lds;
    LAS float* red = (LAS float*)(lds + 24576);
    if (s0 >= s1) return;
    for (int i = tid; i < 3 * D; i += NTHR) { const int v = i >> 11, k = i & 2047; const float x = v < 2 ? a->in[1][v * D + k] : a->in[3][k]; sc[i] = silu_f(x); }
    __syncthreads();
    float* MOD = (float*)(ws + WS_MOD);
    for (int s = s0; s < s1; s += stride) {
        const int l = s / 192, col0 = (s - l * 192) * 64, cg = tid & 15, kg = tid >> 4;
        const float* W = a->in[4] + (size_t)l * D * 12288 + col0 + 4 * cg;
        f32x4 acc0 = {0.f, 0.f, 0.f, 0.f}, acc1 = acc0, acc2 = acc0;
#pragma unroll 16
        for (int kk = 0; kk < 64; ++kk) { const int k = kg + 32 * kk; const f32x4 w = __builtin_nontemporal_load((const f32x4*)(W + (size_t)k * 12288));
            acc0 += w * sc[k]; acc1 += w * sc[2048 + k]; acc2 += w * sc[4096 + k]; }
#pragma unroll
        for (int j = 0; j < 4; ++j) { red[(kg * 3 + 0) * 64 + 4 * cg + j] = acc0[j]; red[(kg * 3 + 1) * 64 + 4 * cg + j] = acc1[j]; red[(kg * 3 + 2) * 64 + 4 * cg + j] = acc2[j]; }
        __syncthreads();
        if (tid < 192) { const int v = tid >> 6, c = tid & 63; float sum = 0.f;
#pragma unroll 8
            for (int g = 0; g < 32; ++g) sum += red[(g * 3 + v) * 64 + c];
            MOD[(l * 3 + v) * 12288 + col0 + c] = sum + a->in[5][l * 12288 + col0 + c]; }
        __syncthreads();
    }
}
constexpr int MOE_STRIPS = 2 * NEXP * (DFFE / 64);
__device__ __forceinline__ void moe_colscale_item(ArgsP a, int s, int lane) {
    unsigned char* ws = a->ws;
    const int ew = s / (DFFE / 64), n0 = (s - ew * (DFFE / 64)) * 64, e = ew >> 1, w = ew & 1;
    const int drow = e * 2 * DFFE + (n0 >> 7) * 256 + (n0 & 127) + w * 128;
    const float* src = a->in[27 + w] + (size_t)e * D * DFFE + (size_t)(32 * (lane >> 4)) * DFFE + n0 + 4 * (lane & 15);
    f32x4 mx = {0.f, 0.f, 0.f, 0.f};
#pragma unroll
    for (int i = 0; i < 16; ++i) { const f32x4 v = *(const f32x4*)(src + (size_t)(128 * i) * DFFE);
        mx[0] = fmaxf(mx[0], fabsf(v[0])); mx[1] = fmaxf(mx[1], fabsf(v[1])); mx[2] = fmaxf(mx[2], fabsf(v[2])); mx[3] = fmaxf(mx[3], fabsf(v[3])); }
#pragma unroll
    for (int j = 0; j < 4; ++j) { mx[j] = fmaxf(mx[j], __shfl_xor(mx[j], 16)); mx[j] = fmaxf(mx[j], __shfl_xor(mx[j], 32)); }
    if (lane < 16) *(f32x4*)((float*)(ws + WS_CSM) + drow + 4 * lane) = mx * (1.9f / 127.0f);
}
constexpr int CV_IN = (D / 64) * (INC / 64), CV_OUT = (D / 64) * (D / 64), CV_F1 = (D / 64) * (DFF / 64), CV_F2 = (DFF / 64) * (D / 64);
constexpr int CVA_N = MOE_STRIPS + CV_OUT, CVB_N = CV_F2 + CV_OUT;
constexpr int I8_STRIPS = 2 * (DFF / 32);
__device__ __forceinline__ void conv_a_item(ArgsP a, int it, LAS float* scr, int lane) {
    unsigned char* ws = a->ws;
    if (it < MOE_STRIPS) { moe_colscale_item(a, it, lane); return; } it -= MOE_STRIPS;
    xpose_mat(a->in[9], D, D, (bf16*)(ws + WS_WOUT), false, 0, it, scr, lane);
}
__device__ __forceinline__ void conv_b_item(ArgsP a, int it, LAS float* scr, int lane) {
    unsigned char* ws = a->ws;
    if (it < CV_F2) { xpose_mat8(a->in[25], DFF, D, ws + WS_WF2, false, 0, pg8::S_W2, it, scr, lane); return; } it -= CV_F2;
    xpose_mat(a->in[9] + (size_t)D * D, D, D, (bf16*)(ws + WS_WOUT) + (size_t)D * D, false, 0, it, scr, lane);
}
constexpr int WIN_STRIPS = INC / 32;
__device__ __forceinline__ void win_strip(ArgsP a, LAS unsigned char* lds, int l, int s);
__device__ __forceinline__ void phase_prologue(ArgsP a, LAS unsigned char* lds) {
    const int tid = hide_tid(), lane = tid & 63, wave = tid >> 6, G = gridDim.x;
    unsigned char* ws = a->ws;
    const int nmod = G > 192 ? 192 : G;
    if ((int)blockIdx.x < nmod) mod_strips(a, lds, (int)blockIdx.x, 192, nmod);
    __syncthreads();
    if (G > nmod) { for (int s = (int)blockIdx.x - nmod; s >= 0 && s < WIN_STRIPS; s += G - nmod) win_strip(a, lds, 0, s); }
    else for (int s = (int)blockIdx.x; s < WIN_STRIPS; s += G) win_strip(a, lds, 0, s);
}
template <bool SAMPLE>
__device__ __forceinline__ void i8_strip_core(const float* __restrict__ W0, int ldw, unsigned char* __restrict__ dst0, float* __restrict__ cs0, LAS unsigned char* lds) {
    const int tid = hide_tid(), lane = tid & 63, wave = tid >> 6;
    LAS float* scr = (LAS float*)(lds + wave * 16640);
    LAS float* cmax = (LAS float*)(lds + 8 * 16640);
    LAS float* csc = cmax + 512;
    const float* src = W0 + (size_t)(lane >> 4) * ldw + 4 * (lane & 15);
    f32x4 mx = {0.f, 0.f, 0.f, 0.f};
    for (int t = 0; t < (SAMPLE ? 1 : 4); ++t) { const int k0 = (wave + 8 * t) * 64;
#pragma unroll
        for (int i = 0; i < 16; ++i) { const f32x4 v = *(const f32x4*)(src + (size_t)(k0 + 4 * i) * ldw);
            mx[0] = fmaxf(mx[0], fabsf(v[0])); mx[1] = fmaxf(mx[1], fabsf(v[1])); mx[2] = fmaxf(mx[2], fabsf(v[2])); mx[3] = fmaxf(mx[3], fabsf(v[3])); } }
#pragma unroll
    for (int j = 0; j < 4; ++j) { mx[j] = fmaxf(mx[j], __shfl_xor(mx[j], 16)); mx[j] = fmaxf(mx[j], __shfl_xor(mx[j], 32)); }
    if (lane < 16) { cmax[wave * 64 + 4 * lane + 0] = mx[0]; cmax[wave * 64 + 4 * lane + 1] = mx[1]; cmax[wave * 64 + 4 * lane + 2] = mx[2]; cmax[wave * 64 + 4 * lane + 3] = mx[3]; }
    __syncthreads();
    if (tid < 64) { float m = 0.f;
#pragma unroll
        for (int q = 0; q < 8; ++q) m = fmaxf(m, cmax[q * 64 + tid]);
        if (SAMPLE) m *= 1.6f;
        csc[tid] = m > 1e-30f ? 127.0f / m : 0.f;
        cs0[tid] = m * (1.0f / 127.0f); }
    __syncthreads();
    f32x4 v[16], vn[16];
#pragma unroll
    for (int i = 0; i < 16; ++i) v[i] = __builtin_nontemporal_load((const f32x4*)(src + (size_t)(wave * 64 + 4 * i) * ldw));
#pragma unroll
    for (int t = 0; t < 4; ++t) { const int k0 = (wave + 8 * t) * 64;
        if (t < 3) {
#pragma unroll
            for (int i = 0; i < 16; ++i) vn[i] = __builtin_nontemporal_load((const f32x4*)(src + (size_t)(k0 + 512 + 4 * i) * ldw)); }
#pragma unroll
        for (int i = 0; i < 16; ++i) { LAS float* p = scr + (4 * i + (lane >> 4)) * 65 + 4 * (lane & 15); p[0] = v[i][0]; p[1] = v[i][1]; p[2] = v[i][2]; p[3] = v[i][3]; }
        asm volatile("s_waitcnt lgkmcnt(0)" ::: "memory");
        const int c = lane & 3;
#pragma unroll
        for (int j = 0; j < 4; ++j) { const int n = (lane >> 2) + 16 * j; const LAS float* p = scr + (16 * c) * 65 + n; const float q = csc[n];
            unsigned o[4];
#pragma unroll
            for (int g = 0; g < 4; ++g) { int qi[4];
#pragma unroll
                for (int e = 0; e < 4; ++e) qi[e] = (int)rintf(__builtin_amdgcn_fmed3f(p[(4 * g + e) * 65] * q, -127.f, 127.f));
                o[g] = (unsigned)(qi[0] & 255) | ((unsigned)(qi[1] & 255) << 8) | ((unsigned)(qi[2] & 255) << 16) | ((unsigned)(qi[3] & 255) << 24); }
            __builtin_nontemporal_store((u32x4){o[0], o[1], o[2], o[3]}, (u32x4*)(dst0 + (size_t)n * D + k0 + 16 * c)); }
        asm volatile("s_waitcnt lgkmcnt(0)" ::: "memory");
        if (t < 3) {
#pragma unroll
            for (int i = 0; i < 16; ++i) v[i] = vn[i]; }
    }
    __syncthreads();
}
__device__ __forceinline__ void i8_strip32(const float* __restrict__ W0, int ldw, unsigned char* __restrict__ dst0, float* __restrict__ cs0, LAS unsigned char* lds) {
    const int tid = hide_tid(), lane = tid & 63, wave = tid >> 6, wq = lane >> 3, wl = lane & 7;
    LAS unsigned* scr = (LAS unsigned*)(lds + wave * 16640);
    LAS float* cmax = (LAS float*)(lds + 8 * 16640);
    const float* src = W0 + (size_t)(wave * 256 + 4 * wq) * ldw + 4 * wl;
    f32x4 v[2][4][4];
#pragma unroll
    for (int t = 0; t < 2; ++t)
#pragma unroll
        for (int i = 0; i < 4; ++i)
#pragma unroll
            for (int r = 0; r < 4; ++r) v[t][i][r] = __builtin_nontemporal_load((const f32x4*)(src + (size_t)(128 * t + 32 * i + r) * ldw));
    f32x4 mx = {0.f, 0.f, 0.f, 0.f};
#pragma unroll
    for (int t = 0; t < 2; ++t)
#pragma unroll
        for (int i = 0; i < 4; ++i)
#pragma unroll
            for (int r = 0; r < 4; ++r)
#pragma unroll
                for (int e = 0; e < 4; ++e) mx[e] = fmaxf(mx[e], fabsf(v[t][i][r][e]));
#pragma unroll
    for (int e = 0; e < 4; ++e) { mx[e] = fmaxf(mx[e], __shfl_xor(mx[e], 8)); mx[e] = fmaxf(mx[e], __shfl_xor(mx[e], 16)); mx[e] = fmaxf(mx[e], __shfl_xor(mx[e], 32)); }
    if (wq == 0) { cmax[wave * 32 + 4 * wl + 0] = mx[0]; cmax[wave * 32 + 4 * wl + 1] = mx[1]; cmax[wave * 32 + 4 * wl + 2] = mx[2]; cmax[wave * 32 + 4 * wl + 3] = mx[3]; }
    __syncthreads();
    f32x4 q;
#pragma unroll
    for (int e = 0; e < 4; ++e) { float m = 0.f;
#pragma unroll
        for (int w = 0; w < 8; ++w) m = fmaxf(m, cmax[w * 32 + 4 * wl + e]);
        q[e] = m > 1e-30f ? 127.0f / m : 0.f;
        if (wave == 0 && wq == 0) cs0[4 * wl + e] = m * (1.0f / 127.0f); }
#pragma unroll
    for (int t = 0; t < 2; ++t) {
#pragma unroll
        for (int i = 0; i < 4; ++i)
#pragma unroll
            for (int e = 0; e < 4; ++e) { unsigned o = 0u;
#pragma unroll
                for (int r = 0; r < 4; ++r) o = __builtin_amdgcn_cvt_pk_u8_f32(__builtin_rintf(__builtin_amdgcn_fmed3f(v[t][i][r][e] * q[e], -127.f, 127.f)) + 128.0f, r, o);
                scr[(4 * wl + e) * 33 + 8 * i + wq] = o ^ 0x80808080u; }
        asm volatile("s_waitcnt lgkmcnt(0)" ::: "memory");
        const int c = lane & 7;
#pragma unroll
        for (int j = 0; j < 4; ++j) { const int n = (lane >> 3) + 8 * j; const LAS unsigned* s = scr + n * 33 + 4 * c;
            __builtin_nontemporal_store((u32x4){s[0], s[1], s[2], s[3]}, (u32x4*)(dst0 + (size_t)n * D + wave * 256 + 128 * t + 16 * c)); }
        asm volatile("s_waitcnt lgkmcnt(0)" ::: "memory");
    }
    __syncthreads();
}
__device__ __forceinline__ void i8_strip(ArgsP a, LAS unsigned char* lds, int s) {
    unsigned char* ws = a->ws;
    const int w = s / (DFF / 32), n0 = (s - w * (DFF / 32)) * 32;
    const int drow = (n0 >> 7) * 256 + (n0 & 127) + w * 128;
    i8_strip32(a->in[23 + w] + n0, DFF, ws + WS_WF13 + (size_t)drow * D, (float*)(ws + WS_CS) + drow, lds);
}
__device__ __forceinline__ void win_strip(ArgsP a, LAS unsigned char* lds, int l, int s) {
    unsigned char* ws = a->ws; const int n0 = s * 32;
    i8_strip32(a->in[8] + (size_t)l * D * INC + n0, INC, ws + WS_WIN + ((size_t)l * INC + n0) * D, (float*)(ws + WS_CSIN) + l * INC + n0, lds);
}
__device__ __forceinline__ void deferred_a(ArgsP a, LAS unsigned char* lds, int e, int nel) {
    const int tid = hide_tid(), lane = tid & 63, wave = tid >> 6;
    const int q = CVA_N / nel, r = CVA_N % nel, count = q + (e < r ? 1 : 0), first = e * q + (e < r ? e : r);
    LAS float* scr = (LAS float*)(lds + wave * 16640);
    for (int i = wave; i < count; i += NWAVES) conv_a_item(a, first + i, scr, lane);
}
constexpr int MOE_I = (D / 64) * (DFFE / 64);
constexpr int G1_STRIPS = 468;
constexpr int M1_G1 = 3432, M1_AT0 = 35988;
constexpr int G1_QUOTA = 17160;
__device__ __forceinline__ void quota(int seg0, int segn, int G, int c, int& first, int& count) { const int q = (segn + G - 1) / G; const int lo = c * q; first = seg0 + lo; count = lo >= segn ? 0 : (segn - lo < q ? segn - lo : q); }
struct MoeTile { const float* src; unsigned char* dst0; const float* cs; int ldw, ldd, k0; };
template <int which>
__device__ __forceinline__ MoeTile moe_tile(ArgsP a, int it, int lane) {
    unsigned char* ws = a->ws; MoeTile t;
    if (which == 0) { const int ew = it / MOE_I, r = it - ew * MOE_I, e = ew >> 1, w = ew & 1;
        const int ntn = DFFE >> 5, kb = r / ntn, nb = r - kb * ntn, k0 = kb * 128, n0 = nb * 32, drow = e * 2 * DFFE + (n0 >> 7) * 256 + (n0 & 127) + w * 128;
        t.ldw = DFFE; t.ldd = D; t.k0 = k0; t.src = a->in[27 + w] + (size_t)e * D * DFFE + (size_t)(k0 + 4 * (lane >> 3)) * DFFE + n0 + 4 * (lane & 7);
        t.dst0 = ws + WS_WM13 + (size_t)drow * D; t.cs = (const float*)(ws + WS_CSM) + drow + 4 * (lane & 7); }
    else { const int e = it / MOE_I, r = it - e * MOE_I, ntn = D >> 5, kb = r / ntn, nb = r - kb * ntn, k0 = kb * 128, n0 = nb * 32;
        t.ldw = D; t.ldd = 128; t.k0 = 0; t.src = a->in[29] + (size_t)e * DFFE * D + (size_t)(k0 + 4 * (lane >> 3)) * D + n0 + 4 * (lane & 7);
        t.dst0 = ws + WS_WM2 + ((size_t)((e * (D >> 8) + (n0 >> 8)) * (DFFE >> 7) + (k0 >> 7)) * 256 + (n0 & 255)) * 128; t.cs = nullptr; }
    return t;
}
template <int which>
__device__ __forceinline__ void moe_convert_t(ArgsP a, LAS unsigned char* lds, int first, int count) {
    const int tid = hide_tid(), lane = tid & 63, wave = tid >> 6;
    LAS unsigned* scr = (LAS unsigned*)(lds + wave * 16640);
    int k = wave; if (k >= count) return;
    MoeTile t0 = moe_tile<which>(a, first + k, lane), t1 = t0, t2 = t0;
    f32x4 v0[4][4], v1[4][4], v2[4][4];
#define MC_LOAD(vv, tt) do { _Pragma("unroll") for (int i = 0; i < 4; ++i) _Pragma("unroll") for (int r = 0; r < 4; ++r) vv[i][r] = __builtin_nontemporal_load((const f32x4*)(tt.src + (size_t)(32 * i + r) * tt.ldw)); } while (0)
    MC_LOAD(v0, t0);
    if (k + NWAVES < count) { t1 = moe_tile<which>(a, first + k + NWAVES, lane); MC_LOAD(v1, t1); }
    for (; k < count; k += NWAVES) {
        if (k + 2 * NWAVES < count) { t2 = moe_tile<which>(a, first + k + 2 * NWAVES, lane); MC_LOAD(v2, t2); }
        f32x4 q = {pg8::S_W2, pg8::S_W2, pg8::S_W2, pg8::S_W2};
        if (which == 0) { const f32x4 d = *(const f32x4*)t0.cs;
#pragma unroll
            for (int e = 0; e < 4; ++e) q[e] = d[e] > 1e-30f ? __builtin_amdgcn_rcpf(d[e]) : 0.f; }
        const int wq = lane >> 3, wl = lane & 7;
#pragma unroll
        for (int i = 0; i < 4; ++i)
#pragma unroll
            for (int e = 0; e < 4; ++e) { unsigned o;
                if (which == 0) { o = 0u;
#pragma unroll
                    for (int r = 0; r < 4; ++r) o = __builtin_amdgcn_cvt_pk_u8_f32(__builtin_rintf(__builtin_amdgcn_fmed3f(v0[i][r][e] * q[e], -127.f, 127.f)) + 128.0f, r, o);
                    o ^= 0x80808080u; }
                else o = pg8::pk4_fp8(v0[i][0][e] * q[e], v0[i][1][e] * q[e], v0[i][2][e] * q[e], v0[i][3][e] * q[e]);
                scr[(4 * wl + e) * 33 + 8 * i + wq] = o; }
        asm volatile("s_waitcnt lgkmcnt(0)" ::: "memory");
        const int c = lane & 7;
#pragma unroll
        for (int j = 0; j < 4; ++j) { const int n = (lane >> 3) + 8 * j; const LAS unsigned* s = scr + n * 33 + 4 * c;
            __builtin_nontemporal_store((u32x4){s[0], s[1], s[2], s[3]}, (u32x4*)(t0.dst0 + (size_t)n * t0.ldd + t0.k0 + 16 * c)); }
        asm volatile("s_waitcnt lgkmcnt(0)" ::: "memory");
        t0 = t1; t1 = t2;
#pragma unroll
        for (int i = 0; i < 4; ++i)
#pragma unroll
            for (int r = 0; r < 4; ++r) { v0[i][r] = v1[i][r]; v1[i][r] = v2[i][r]; }
    }
#undef MC_LOAD
}
__device__ __forceinline__ void moe_convert(ArgsP a, LAS unsigned char* lds, int which, int first, int count) { if (which == 0) moe_convert_t<0>(a, lds, first, count); else moe_convert_t<1>(a, lds, first, count); }
__device__ __forceinline__ void at_convert(ArgsP a, LAS unsigned char* lds, int l) {
    const int G = gridDim.x, c = (int)blockIdx.x; int f, n;
    if (l == 0) {
        mod_strips(a, lds, 192 + c, 384, G);
        __syncthreads();
        { const int NS = I8_STRIPS + WIN_STRIPS, nfree = G > 192 ? G - 192 : 0, hi = 3 * nfree < NS ? 3 * nfree : NS;
          if (c >= 192) { for (int j = 0; j < 3; ++j) { const int s = 3 * (c - 192) + j; if (s < hi) { if (s < I8_STRIPS) i8_strip(a, lds, s); else win_strip(a, lds, 1, s - I8_STRIPS); } } }
          else if (G == 256) {
              for (int k = 0; k < 2; ++k) { const int s = k == 0 ? hi + c : hi + 192 + (c - 80); if (k == 0 || c >= 80) { if (s < I8_STRIPS) i8_strip(a, lds, s); else if (s < NS) win_strip(a, lds, 1, s - I8_STRIPS); } } }
          else { const int nw = G > 192 ? 192 : G; for (int s = hi + c; s < NS; s += nw) { if (s < I8_STRIPS) i8_strip(a, lds, s); else win_strip(a, lds, 1, s - I8_STRIPS); } } }
        { const int tid = hide_tid(), lane = tid & 63, wave = tid >> 6; LAS float* scr = (LAS float*)(lds + wave * 16640);
          quota(0, CVB_N, G, c, f, n); for (int i = wave; i < n; i += NWAVES) conv_b_item(a, f + i, scr, lane); }
        __syncthreads();
        quota(M1_G1, M1_AT0, G, c, f, n); moe_convert(a, lds, 0, f, n);
    } else {
        quota(M1_G1 + M1_AT0, 2 * NEXP * MOE_I - M1_G1 - M1_AT0, G, c, f, n); moe_convert(a, lds, 0, f, n);
        __syncthreads();
        quota(0, NEXP * MOE_I, G, c, f, n); moe_convert(a, lds, 1, f, n);
    }
}
__device__ __forceinline__ void quota_bal_hi(int seg0, int n, int G, int c, int& first, int& count) { const int q = n / G, r = n % G, x = c - (G - r); count = q + (x >= 0 ? 1 : 0); first = seg0 + c * q + (x > 0 ? x : 0); }
__device__ __forceinline__ void quota_bal(int seg0, int n, int G, int c, int& first, int& count) { const int q = n / G, r = n % G; count = q + (c < r ? 1 : 0); first = seg0 + c * q + (c < r ? c : r); }

template <int SRC, bool ROUTER, int NSLAB, int OUT  >
__device__ __forceinline__ void phase_norm(ArgsP a, int l, int row_lo, const float* gvec, int ch_sh, int ch_sc, LAS unsigned char* lds = nullptr) {
    const int tid = hide_tid(), lane = tid & 63, wave = tid >> 6, G = gridDim.x;
    unsigned char* ws = a->ws;
    bf16* XW = (bf16*)(ws + WS_XW); bf16* HB = (bf16*)(ws + WS_HB);
    const float* MODL = (const float*)(ws + WS_MOD) + l * 3 * 12288;
    const int lane0 = lane;
    if (ROUTER) {
        LAS f32x4* RT = (LAS f32x4*)lds;
#pragma unroll
        for (int m = 0; m < 8; ++m) { const int id = tid + NTHR * m, ln = id & 63, h = (id >> 6) & 1, j = (id >> 7) & 3, q = id >> 9;
            RT[id] = *(const f32x4*)(a->in[26] + (size_t)(8 * (ln + 64 * j) + q) * NEXP + 4 * h); }
        __syncthreads();
    }
    for (int ridx = row_lo + blockIdx.x * NWAVES + wave; ridx < MROWS; ridx += G * NWAVES) {
        int row = ridx; if (NSLAB > 0) { row = ridx + (MROWS - 1024); if (row >= MROWS) row -= MROWS; }
        int lane = lane0; asm volatile("" : "+v"(lane));
        const bool isctx = row < 2 * LCTX;
        const int v = isctx ? 2 : ((row - 2 * LCTX) >> 12);
        float x[4][8];
        if (SRC == 0 || (SRC == 2 && isctx)) {
            const float* src = isctx ? a->in[2] + (size_t)row * D : a->in[0] + (size_t)(row - 2 * LCTX) * D;
#pragma unroll
            for (int j = 0; j < 4; ++j) { const f32x4 p = *(const f32x4*)(src + 8 * (lane + 64 * j)), q = *(const f32x4*)(src + 8 * (lane + 64 * j) + 4);
#pragma unroll
                for (int e = 0; e < 4; ++e) { x[j][e] = p[e]; x[j][4 + e] = q[e]; } }
        } else {
#pragma unroll
            for (int j = 0; j < 4; ++j) unpack8(*(const u32x4*)(XW + (size_t)row * D + 8 * (lane + 64 * j)), x[j]);
        }
        if (NSLAB > 0 && isctx) {
#pragma unroll
            for (int j = 0; j < 4; ++j) {
                const int c = 8 * (lane + 64 * j);
                const float* sl = (const float*)(ws + WS_SLAB) + (size_t)((((row >> 8) * 8 + (c >> 8)) * NSLAB)) * 65536 + (size_t)(row & 255) * 256 + (c & 255);
                for (int s = 0; s < NSLAB; ++s) { const f32x4 p = *(const f32x4*)(sl + (size_t)s * 65536), q = *(const f32x4*)(sl + (size_t)s * 65536 + 4);
#pragma unroll
                    for (int e = 0; e < 4; ++e) { x[j][e] += p[e]; x[j][4 + e] += q[e]; } }
                *(u32x4*)(XW + (size_t)row * D + c) = pack8(x[j]); }
        }
        float ss = 0.f;
#pragma unroll
        for (int j = 0; j < 4; ++j)
#pragma unroll
            for (int e = 0; e < 8; ++e) ss += x[j][e] * x[j][e];
        ss = wave_sum(ss);
        const float r = __builtin_amdgcn_rsqf(ss * (1.0f / D) + EPS);
        const float* sh = MODL + v * 12288 + ch_sh * 2048; const float* sc = MODL + v * 12288 + ch_sc * 2048;
        float lg[8];
        if (ROUTER) {
#pragma unroll
            for (int e = 0; e < 8; ++e) lg[e] = 0.f;
        }
#pragma unroll
        for (int j = 0; j < 4; ++j) {
            const int c = 8 * (lane + 64 * j);
            float h[8];
#pragma unroll
            for (int hf = 0; hf < 2; ++hf) { const f32x4 g = *(const f32x4*)(gvec + c + 4 * hf), s1 = *(const f32x4*)(sc + c + 4 * hf), s0 = *(const f32x4*)(sh + c + 4 * hf);
#pragma unroll
                for (int e = 0; e < 4; ++e) h[4 * hf + e] = (x[j][4 * hf + e] * r) * g[e] * (s1[e] + 1.0f) + s0[e]; }
            if (OUT == 1) { u32x2 o; o.x = pg8::pk4_fp8(h[0] * pg8::S_H, h[1] * pg8::S_H, h[2] * pg8::S_H, h[3] * pg8::S_H); o.y = pg8::pk4_fp8(h[4] * pg8::S_H, h[5] * pg8::S_H, h[6] * pg8::S_H, h[7] * pg8::S_H);
                *(u32x2*)((unsigned char*)HB + (size_t)row * D + c) = o; }
            else if (OUT == 0) *(u32x4*)(HB + (size_t)row * D + c) = pack8(h);
            if (OUT == 2 || ROUTER) {
#pragma unroll
                for (int e = 0; e < 8; ++e) x[j][e] = h[e]; }
        }
        if (OUT == 2) {
            float am = 0.f;
#pragma unroll
            for (int j = 0; j < 4; ++j)
#pragma unroll
                for (int e = 0; e < 8; ++e) am = fmaxf(am, fabsf(x[j][e]));
#pragma unroll
            for (int o = 1; o < 64; o <<= 1) am = fmaxf(am, __shfl_xor(am, o));
            const float qs = am > 1e-30f ? 127.0f / am : 0.f;
            if (lane == 0) ((float*)(ws + WS_RS))[row] = am * (1.0f / 127.0f);
#pragma unroll
            for (int j = 0; j < 4; ++j) { unsigned w[2];
#pragma unroll
                for (int hf = 0; hf < 2; ++hf) { const int q0 = (int)rintf(x[j][4 * hf + 0] * qs), q1 = (int)rintf(x[j][4 * hf + 1] * qs), q2 = (int)rintf(x[j][4 * hf + 2] * qs), q3 = (int)rintf(x[j][4 * hf + 3] * qs);
                    w[hf] = (unsigned)(q0 & 255) | ((unsigned)(q1 & 255) << 8) | ((unsigned)(q2 & 255) << 16) | ((unsigned)(q3 & 255) << 24); }
                *(u32x2*)((unsigned char*)HB + (size_t)row * D + 8 * (lane + 64 * j)) = (u32x2){w[0], w[1]}; }
        }
        if (ROUTER) {
#pragma unroll
            for (int j = 0; j < 4; ++j) {
                const LAS f32x4* RT = (const LAS f32x4*)lds;
#pragma unroll
                for (int q = 0; q < 8; ++q) { const f32x4 w0 = RT[((q * 4 + j) * 2 + 0) * 64 + lane], w1 = RT[((q * 4 + j) * 2 + 1) * 64 + lane];
                    lg[0] += x[j][q] * w0[0]; lg[1] += x[j][q] * w0[1]; lg[2] += x[j][q] * w0[2]; lg[3] += x[j][q] * w0[3];
                    lg[4] += x[j][q] * w1[0]; lg[5] += x[j][q] * w1[1]; lg[6] += x[j][q] * w1[2]; lg[7] += x[j][q] * w1[3]; }
                asm volatile("" ::: "memory");
            }
        }
        if (ROUTER) {
#pragma unroll
            for (int e = 0; e < 8; ++e) lg[e] = wave_sum(lg[e]);
            int e1 = 0; float v1 = lg[0];
#pragma unroll
            for (int e = 1; e < 8; ++e) if (lg[e] > v1) { v1 = lg[e]; e1 = e; }
            int e2 = -1; float v2 = -3.0e38f;
#pragma unroll
            for (int e = 0; e < 8; ++e) if (e != e1 && lg[e] > v2) { v2 = lg[e]; e2 = e; }
            if (lane == 0) {
                unsigned* cnt = (unsigned*)(ws + WS_CTL) + CW_CNT;
                const int p1 = (int)atomicAdd(cnt + 64 * e1, 1u), p2 = (int)atomicAdd(cnt + 64 * e2, 1u);
                const float g2 = 1.0f / (1.0f + __expf(v1 - v2)), g1 = 1.0f - g2;
                int* tk = (int*)(ws + WS_TOK) + (size_t)(row - 2 * LCTX) * 8;
                tk[0] = e1; tk[1] = e2; tk[2] = p1; tk[3] = p2; ((float*)tk)[4] = g1; ((float*)tk)[5] = g2;
            }
        }
    }
}

__device__ __forceinline__ void rope_angles(int pos, bool latent, int quarter_lane_i0  , bool colhalf, float expo_scale, float (&cs)[8], float (&sn)[8]) {
    const float p = latent ? (float)(colhalf ? (pos & 63) : (pos >> 6)) : 0.f;
#pragma unroll
    for (int e = 0; e < 8; ++e) {
        const float inv = __builtin_amdgcn_exp2f(-(float)(quarter_lane_i0 + e) * expo_scale);
        float rev = p * inv * 0.15915494309189535f; rev -= rintf(rev);
        cs[e] = latent ? __builtin_amdgcn_cosf(rev) : 1.f; sn[e] = latent ? __builtin_amdgcn_sinf(rev) : 0.f;
    }
}
__device__ __forceinline__ void phase_postproj(ArgsP a, int l, LAS unsigned char* lds) {
    const int tid = hide_tid(), lane = tid & 63, wave = tid >> 6, G = gridDim.x;
    unsigned char* ws = a->ws;
    bf16* PROJ = (bf16*)(ws + WS_PROJ); bf16* MIX = (bf16*)(ws + WS_MIX);
    const float LOG2_THETA = 13.287712379549449f;
    float gAq[8], gAk[8], gCq[8], gCk[8], cwv[3][8], gbv[8];
#pragma unroll
    for (int e = 0; e < 8; ++e) { gAq[e] = a->in[10][l * 64 + 8 * (lane & 7) + e]; gAk[e] = a->in[11][l * 64 + 8 * (lane & 7) + e]; gCq[e] = a->in[19][l * 128 + 8 * (lane & 15) + e]; gCk[e] = a->in[20][l * 128 + 8 * (lane & 15) + e];
        cwv[0][e] = a->in[17][l * 3 * 512 + 8 * lane + e]; cwv[1][e] = a->in[17][l * 3 * 512 + 512 + 8 * lane + e]; cwv[2][e] = a->in[17][l * 3 * 512 + 1024 + 8 * lane + e]; gbv[e] = a->in[18][l * 512 + 8 * lane + e]; }
    for (int row = blockIdx.x * NWAVES + wave; row < MROWS; row += G * NWAVES) {
        const bool latent = row >= 2 * LCTX;
        const int pos = latent ? ((row - 2 * LCTX) & (SEQ - 1)) : (row & (LCTX - 1));
        const int seglen = latent ? SEQ : LCTX;
        bf16* pr = PROJ + (size_t)row * INC;
        const u32x4 zero4 = {0u, 0u, 0u, 0u};
        u32x4 wA[2], wC[3], bC0 = zero4, bX0 = zero4, bC1, bX1, bC2 = zero4, bX2 = zero4, bB;
#pragma unroll
        for (int i = 0; i < 2; ++i) wA[i] = *(const u32x4*)(pr + (lane + 64 * i) * 8);
#pragma unroll
        for (int i = 0; i < 3; ++i) { const int chunk = lane + 64 * i; wC[i] = *(const u32x4*)(pr + C_CQ + (chunk < 160 ? chunk : 0) * 8); }
        bC1 = *(const u32x4*)(pr + C_BC + 8 * lane); bX1 = *(const u32x4*)(pr + C_BX + 8 * lane); bB = *(const u32x4*)(pr + C_BB + 8 * lane);
        if (pos > 0) { bC0 = *(const u32x4*)(pr - INC + C_BC + 8 * lane); bX0 = *(const u32x4*)(pr - INC + C_BX + 8 * lane); }
        if (pos < seglen - 1) { bC2 = *(const u32x4*)(pr + INC + C_BC + 8 * lane); bX2 = *(const u32x4*)(pr + INC + C_BX + 8 * lane); }
        {
            const int l8 = lane & 7;
            float cs[8], sn[8];
            rope_angles(pos, latent, 8 * (l8 & 1), l8 >= 4, 2.0f * LOG2_THETA / 32.0f, cs, sn);
            const bool minus = (l8 & 2) == 0;
#pragma unroll
            for (int i = 0; i < 2; ++i) {
                const int chunk = lane + 64 * i, vec = chunk >> 3; const bool isq = vec < 8;
                float f[8]; unpack8(wA[i], f);
                float ss = 0.f;
#pragma unroll
                for (int e = 0; e < 8; ++e) ss += f[e] * f[e];
                ss += __shfl_xor(ss, 1); ss += __shfl_xor(ss, 2); ss += __shfl_xor(ss, 4);
                const float r = __builtin_amdgcn_rsqf(ss * (1.0f / 64.0f) + EPS);
                const float qs = isq ? 0.125f * 1.4426950408889634f : 1.0f;
                float y[8], o[8];
#pragma unroll
                for (int e = 0; e < 8; ++e) y[e] = f[e] * r * (isq ? gAq[e] : gAk[e]);
#pragma unroll
                for (int e = 0; e < 8; ++e) { const float p = __shfl_xor(y[e], 2); o[e] = (y[e] * cs[e] + (minus ? -p : p) * sn[e]) * qs; }
                *(u32x4*)(pr + chunk * 8) = pack8(o);
            }
        }
        {
            const int l16 = lane & 15;
            float cs[8], sn[8];
            rope_angles(pos, latent, 8 * (l16 & 3), l16 >= 8, 2.0f * LOG2_THETA / 64.0f, cs, sn);
            const bool minus = (l16 & 4) == 0;
#pragma unroll
            for (int i = 0; i < 3; ++i) {
                const int chunk = lane + 64 * i; const bool act = chunk < 160; const int vec = chunk >> 4; const bool isq = vec < 8;
                bf16* p8 = pr + C_CQ + (act ? chunk : 0) * 8;
                float f[8]; unpack8(wC[i], f);
                float ss = 0.f;
#pragma unroll
                for (int e = 0; e < 8; ++e) ss += f[e] * f[e];
                ss += __shfl_xor(ss, 1); ss += __shfl_xor(ss, 2); ss += __shfl_xor(ss, 4); ss += __shfl_xor(ss, 8);
                const float r = __builtin_amdgcn_rsqf(ss * (1.0f / 128.0f) + EPS);
                const float qs = isq ? 0.08838834764831845f * 1.4426950408889634f : 1.0f;
                float y[8], o[8];
#pragma unroll
                for (int e = 0; e < 8; ++e) y[e] = f[e] * r * (isq ? gCq[e] : gCk[e]);
#pragma unroll
                for (int e = 0; e < 8; ++e) { const float p = __shfl_xor(y[e], 4); o[e] = (y[e] * cs[e] + (minus ? -p : p) * sn[e]) * qs; }
                if (act) *(u32x4*)p8 = pack8(o);
            }
        }
        {
            const int c0 = 8 * lane;
            float u0[8], u1[8], u2[8], fb[8], t0[8], t1[8];
            unpack8(bC1, t0); unpack8(bX1, t1);
#pragma unroll
            for (int e = 0; e < 8; ++e) u1[e] = t0[e] * t1[e];
            unpack8(bC0, t0); unpack8(bX0, t1);
#pragma unroll
            for (int e = 0; e < 8; ++e) u0[e] = t0[e] * t1[e];
            unpack8(bC2, t0); unpack8(bX2, t1);
#pragma unroll
            for (int e = 0; e < 8; ++e) u2[e] = t0[e] * t1[e];
            unpack8(bB, fb);
            float vv[8], ss = 0.f;
#pragma unroll
            for (int e = 0; e < 8; ++e) { vv[e] = fb[e] * (u0[e] * cwv[0][e] + u1[e] * cwv[1][e] + u2[e] * cwv[2][e]); ss += vv[e] * vv[e]; }
            ss = wave_sum(ss);
            const float r = __builtin_amdgcn_rsqf(ss * (1.0f / 512.0f) + EPS);
#pragma unroll
            for (int e = 0; e < 8; ++e) vv[e] = vv[e] * r * gbv[e];
            *(u32x4*)(MIX + (size_t)row * MIXW + 512 + c0) = pack8(vv);
        }
    }
    __syncthreads();
    {
        LAS unsigned short* tl = (LAS unsigned short*)lds;
        bf16* VTA = (bf16*)(ws + WS_VTA); bf16* VTC = (bf16*)(ws + WS_VTC);
        u32x4 wv[2];
#define VT_LOAD(itx) do { const int _hs = (itx) % 6, _q = (itx) / 6, _jt = _q % 68, _b = _q / 68; const int _col = _hs < 4 ? C_AV + _hs * 128 : C_CV + (_hs - 4) * 128; const int _r0 = rowmap(_b, _jt * 64); \
            _Pragma("unroll") for (int _i = 0; _i < 2; ++_i) { const int _idx = tid + 512 * _i; wv[_i] = *(const u32x4*)(PROJ + (size_t)(_r0 + (_idx >> 4)) * INC + _col + 8 * (_idx & 15)); } } while (0)
        const int it0 = G > 64 ? ((int)blockIdx.x + G - 64) % G : (int)blockIdx.x;
        if (it0 < NB * 68 * 6) VT_LOAD(it0);
        for (int it = it0; it < NB * 68 * 6; it += G) {
            const int hs = it % 6, q = it / 6, jt = q % 68, b = q / 68, j0 = jt * 64;
#pragma unroll
            for (int i = 0; i < 2; ++i) { const int idx = tid + 512 * i, key = idx >> 4, ch = idx & 15;
                *(LAS u32x4*)(tl + key * 136 + 8 * ch) = wv[i]; }
            if (it + G < NB * 68 * 6) VT_LOAD(it + G);
            __syncthreads();
            bf16* dst = hs < 4 ? VTA + (size_t)((b * 4 + hs) * 128) * NKEY : VTC + (size_t)((b * 2 + hs - 4) * 128) * NKEY;
#pragma unroll
            for (int i = 0; i < 2; ++i) { const int idx = tid + 512 * i, dv = idx >> 3, kc = idx & 7;
                unsigned short e[8];
#pragma unroll
                for (int k = 0; k < 8; ++k) { const int q = 8 * kc + k, key = (q & ~12) | ((q & 4) << 1) | ((q & 8) >> 1); e[k] = tl[key * 136 + dv]; }
                u32x4 o; o.x = e[0] | ((unsigned)e[1] << 16); o.y = e[2] | ((unsigned)e[3] << 16); o.z = e[4] | ((unsigned)e[5] << 16); o.w = e[6] | ((unsigned)e[7] << 16);
                *(u32x4*)(dst + (size_t)dv * NKEY + j0 + 8 * kc) = o; }
            __syncthreads();
        }
    }
}

constexpr int KT_STRIDE = 272, VT_STRIDE = 144, KT_BYTES = 64 * KT_STRIDE, VT_BYTES = 128 * VT_STRIDE, ATT_STAGE = KT_BYTES + VT_BYTES;
struct TileSched { int n, nloc, blk0; };
__device__ __forceinline__ int ts_j0(const TileSched& ts, int t) { return t < ts.nloc ? LCTX + (ts.blk0 + (t >> 1)) * 128 + (t & 1) * 64 : (t - ts.nloc) * 64; }

template <int DK, bool WINDOW>
__device__ __forceinline__ void attn_core(LAS unsigned char* lds, const bf16* __restrict__ proj, const bf16* __restrict__ vt, int b, int qrow_wave, int qcol, int ktile_col, int kwave_off, int qpos_wave,
                                          const TileSched ts, f32x16 (&O)[4], float& m_out, float& l_out) {
    const int tid = hide_tid(), lane = tid & 63, r = lane & 31, hh = lane >> 5;
    bf16x8 Qf[DK / 16];
    { const bf16* qp = proj + (size_t)(qrow_wave + r) * INC + qcol + 8 * hh;
#pragma unroll
      for (int ks = 0; ks < DK / 16; ++ks) Qf[ks] = *(const bf16x8*)(qp + 16 * ks); }
#pragma unroll
    for (int blk = 0; blk < 4; ++blk)
#pragma unroll
        for (int i = 0; i < 16; ++i) O[blk][i] = 0.f;
    float m = -__builtin_inff(), lsum = 0.f;
    const int qpos = qpos_wave + r;
    u32x4 kreg[2], vreg[2];
#define kkey (tid >> 4)
#define kch (tid & 15)
#define vdv (tid >> 3)
#define vch (tid & 7)
    LAS unsigned char* const kbuf = lds; LAS unsigned char* const vbuf = lds + 2 * KT_BYTES;
#define ATT_ISSUE_K(t) do { const int _r0 = rowmap(b, ts_j0(ts, (t))); \
        _Pragma("unroll") for (int _i = 0; _i < 2; ++_i) kreg[_i] = *(const u32x4*)(proj + (size_t)(_r0 + kkey + 32 * _i) * INC + ktile_col + 8 * kch); } while (0)
#define ATT_ISSUE_V(t) do { const int _j0 = ts_j0(ts, (t)); \
        _Pragma("unroll") for (int _i = 0; _i < 2; ++_i) vreg[_i] = *(const u32x4*)(vt + (size_t)(vdv + 64 * _i) * NKEY + _j0 + 8 * vch); } while (0)
#define ATT_COMMIT_K(buf) do { LAS unsigned char* _kt = kbuf + (buf) * KT_BYTES; \
        _Pragma("unroll") for (int _i = 0; _i < 2; ++_i) *(LAS u32x4*)(_kt + (kkey + 32 * _i) * KT_STRIDE + kch * 16) = kreg[_i]; } while (0)
#define ATT_COMMIT_V(buf) do { LAS unsigned char* _vl = vbuf + (buf) * VT_BYTES; \
        _Pragma("unroll") for (int _i = 0; _i < 2; ++_i) *(LAS u32x4*)(_vl + (vdv + 64 * _i) * VT_STRIDE + vch * 16) = vreg[_i]; } while (0)
#define ATT_QK(S, buf) do { const LAS unsigned char* _kt = kbuf + (buf) * KT_BYTES; \
        _Pragma("unroll") for (int kb = 0; kb < 2; ++kb) { _Pragma("unroll") for (int i = 0; i < 16; ++i) S[kb][i] = 0.f; \
            _Pragma("unroll") for (int ks = 0; ks < DK / 16; ++ks) { const bf16x8 ka = *(const LAS bf16x8*)(_kt + (32 * kb + r) * KT_STRIDE + (kwave_off + 16 * ks + 8 * hh) * 2); \
                S[kb] = __builtin_amdgcn_mfma_f32_32x32x16_bf16(ka, Qf[ks], S[kb], 0, 0, 0); } } } while (0)
#define ATT_SOFTMAX(S, tt, Pf, alpha) do { \
        if (WINDOW && (tt) < ts.nloc) { const int kpos0 = (ts.blk0 + ((tt) >> 1)) * 128 + ((tt) & 1) * 64; \
            _Pragma("unroll") for (int kb = 0; kb < 2; ++kb) _Pragma("unroll") for (int i = 0; i < 16; ++i) { const int d = kpos0 + 32 * kb + (i & 3) + 8 * (i >> 2) + 4 * hh - qpos; \
                if (d > 128 || d < -128) S[kb][i] = -__builtin_inff(); } } \
        float mx = S[0][0]; \
        _Pragma("unroll") for (int kb = 0; kb < 2; ++kb) _Pragma("unroll") for (int i = 0; i < 16; ++i) mx = fmaxf(mx, S[kb][i]); \
        mx = fmaxf(mx, __shfl_xor(mx, 32)); \
        alpha = 1.0f; \
        if (mx > m + 8.0f) { const float mo = m; m = mx; alpha = __builtin_amdgcn_exp2f(mo - mx); }     \
        const float muse = (m == -__builtin_inff()) ? 0.f : m; \
        float ps = 0.f; \
        _Pragma("unroll") for (int kb = 0; kb < 2; ++kb) _Pragma("unroll") for (int i = 0; i < 16; ++i) { const float p = __builtin_amdgcn_exp2f(S[kb][i] - muse); S[kb][i] = p; ps += p; } \
        lsum = lsum * alpha + ps; \
        _Pragma("unroll") for (int kb = 0; kb < 2; ++kb) _Pragma("unroll") for (int s = 0; s < 2; ++s) { u32x4 w; w.x = pk2(S[kb][8 * s + 0], S[kb][8 * s + 1]); w.y = pk2(S[kb][8 * s + 2], S[kb][8 * s + 3]); \
            w.z = pk2(S[kb][8 * s + 4], S[kb][8 * s + 5]); w.w = pk2(S[kb][8 * s + 6], S[kb][8 * s + 7]); Pf[kb][s] = __builtin_bit_cast(bf16x8, w); } } while (0)
#define ATT_RESCALE(alpha) do { if (__any(alpha != 1.0f)) { _Pragma("unroll") for (int blk = 0; blk < 4; ++blk) _Pragma("unroll") for (int i = 0; i < 16; ++i) O[blk][i] *= alpha; } } while (0)

    ATT_ISSUE_K(0); ATT_ISSUE_V(0);
    { u32x4 k1[2]; const bool h1 = ts.n > 1;
      if (h1) { const int r1 = rowmap(b, ts_j0(ts, 1));
#pragma unroll
          for (int i = 0; i < 2; ++i) k1[i] = *(const u32x4*)(proj + (size_t)(r1 + kkey + 32 * i) * INC + ktile_col + 8 * kch); }
      ATT_COMMIT_K(0); ATT_COMMIT_V(0);
      if (h1) { LAS unsigned char* kt1 = kbuf + KT_BYTES;
#pragma unroll
          for (int i = 0; i < 2; ++i) *(LAS u32x4*)(kt1 + (kkey + 32 * i) * KT_STRIDE + kch * 16) = k1[i]; } }
    __syncthreads();
    bf16x8 Pf[2][2];
    { f32x16 S[2]; float alpha; ATT_QK(S, 0); ATT_SOFTMAX(S, 0, Pf, alpha); (void)alpha; }
    __syncthreads();
    for (int t = 0; t < ts.n; ++t) {
        const bool has1 = t + 1 < ts.n, has2 = t + 2 < ts.n;
        if (has2) ATT_ISSUE_K(t + 2);
        if (has1) ATT_ISSUE_V(t + 1);
        f32x16 S[2];
        if (has1) ATT_QK(S, (t + 1) & 1);
        { const LAS unsigned char* vl = vbuf + (t & 1) * VT_BYTES;
#pragma unroll
          for (int blk = 0; blk < 4; ++blk)
#pragma unroll
            for (int kb = 0; kb < 2; ++kb)
#pragma unroll
                for (int s = 0; s < 2; ++s) { const bf16x8 va = *(const LAS bf16x8*)(vl + (32 * blk + r) * VT_STRIDE + (32 * kb + 16 * s + 8 * hh) * 2);
                    O[blk] = __builtin_amdgcn_mfma_f32_32x32x16_bf16(va, Pf[kb][s], O[blk], 0, 0, 0); } }
        if (has1) { float alpha; ATT_SOFTMAX(S, t + 1, Pf, alpha); ATT_RESCALE(alpha); }
        if (has2) ATT_COMMIT_K(t & 1);
        if (has1) ATT_COMMIT_V((t + 1) & 1);
        __syncthreads();
    }
#undef ATT_ISSUE_K
#undef ATT_ISSUE_V
#undef ATT_COMMIT_K
#undef ATT_COMMIT_V
#undef ATT_QK
#undef ATT_SOFTMAX
#undef ATT_RESCALE
#undef kkey
#undef kch
#undef vdv
#undef vch
    m_out = m; l_out = lsum + __shfl_xor(lsum, 32);
}

__device__ __forceinline__ void phase_attention(ArgsP a, int l, LAS unsigned char* lds, int cv_slot) {
    const int tid = hide_tid(), lane = tid & 63, wave = __builtin_amdgcn_readfirstlane(tid >> 6), G = gridDim.x;
    unsigned char* ws = a->ws;
    const bf16* PROJ = (const bf16*)(ws + WS_PROJ); bf16* MIX = (bf16*)(ws + WS_MIX); float* SSQ = (float*)(ws + WS_SSQ);
    const bf16* VTA = (const bf16*)(ws + WS_VTA); const bf16* VTC = (const bf16*)(ws + WS_VTC);
    const int nctx = (l == 0) ? 16 : 0, total = 512 + 2 * nctx;
    const float lam_init = (l == 0) ? 0.2f : 0.35550906f;
    float lam;
    { const float q1 = a->in[12][l * 64 + lane], k1 = a->in[13][l * 64 + lane], q2 = a->in[14][l * 64 + lane], k2 = a->in[15][l * 64 + lane];
      const float d1 = wave_sum(q1 * k1), d2 = wave_sum(q2 * k2); lam = __expf(d1) - __expf(d2) + lam_init; }
    const int nunits = (int)blockIdx.x < total ? (total - (int)blockIdx.x + G - 1) / G : 0, slotpos = cv_slot < nunits ? cv_slot : nunits;
    for (int st = 0; st <= nunits; ++st) {
        if (st == slotpos) { __syncthreads(); at_convert(a, lds, l); __syncthreads(); }
        if (st == nunits) break;
        const int w = (int)blockIdx.x + st * G;
        const bool isA = (w < 256) || (w >= 512 && w < 512 + nctx);
        const bool isctx = w >= 512;
        if (isA) {
            int b, h, qb;
            if (!isctx) { const int bh = w & 7; b = bh >> 2; h = bh & 3; qb = w >> 3; } else { const int q = w - 512; b = q >> 3; h = (q >> 1) & 3; qb = q & 1; }
            const int comp = wave >> 2, rg = wave & 3;
            const int qrow0 = isctx ? b * LCTX + qb * 128 : 2 * LCTX + b * SEQ + qb * 128;
            TileSched ts; ts.nloc = 0; ts.blk0 = 0; ts.n = isctx ? 4 : 68;
            f32x16 O[4]; float m, ls;
            attn_core<64, false>(lds, PROJ, VTA + (size_t)((b * 4 + h) * 128) * NKEY, b, qrow0 + rg * 32, C_AQ + h * 128 + comp * 64, C_AK + h * 128, comp * 64, 0, ts, O, m, ls);
            const float inv = 1.0f / ls;
            const int lz = hide_tid() & 63, r = lz & 31, hh = lz >> 5, lane = lz;
            LAS float* ex = (LAS float*)lds;
            if (comp == 1) {
#pragma unroll
                for (int blk = 0; blk < 4; ++blk)
#pragma unroll
                    for (int i = 0; i < 16; ++i) ex[(rg * 64 + blk * 16 + i) * 64 + lane] = O[blk][i] * inv;
            }
            __syncthreads();
            if (comp == 0) {
                float ss = 0.f;
#pragma unroll
                for (int blk = 0; blk < 4; ++blk)
#pragma unroll
                    for (int i = 0; i < 16; ++i) { const float o = O[blk][i] * inv - lam * ex[(rg * 64 + blk * 16 + i) * 64 + lane]; O[blk][i] = o; ss += o * o; }
                ss += __shfl_xor(ss, 32);
                const float rn = __builtin_amdgcn_rsqf(ss * (1.0f / 128.0f) + EPS) * (1.0f - lam_init);
                const float* sg = a->in[16] + l * 128;
                bf16* orow = MIX + (size_t)(qrow0 + rg * 32 + r) * MIXW + h * 128;
#pragma unroll
                for (int blk = 0; blk < 4; ++blk)
#pragma unroll
                    for (int g4 = 0; g4 < 4; ++g4) { const int dv = 32 * blk + 8 * g4 + 4 * hh; const f32x4 gg = *(const f32x4*)(sg + dv);
                        u32x2 o; o.x = pk2(O[blk][4 * g4 + 0] * rn * gg[0], O[blk][4 * g4 + 1] * rn * gg[1]); o.y = pk2(O[blk][4 * g4 + 2] * rn * gg[2], O[blk][4 * g4 + 3] * rn * gg[3]);
                        *(u32x2*)(orow + dv) = o; }
            }
            __syncthreads();
        } else {
            int b, kvh, hp, qb;
            if (!isctx) { const int q = w - 256, cb = q & 7; b = cb >> 2; kvh = (cb >> 1) & 1; hp = cb & 1; qb = q >> 3; }
            else { const int q = w - 512 - nctx; b = q >> 3; kvh = (q >> 2) & 1; hp = (q >> 1) & 1; qb = q & 1; }
            const int head = kvh * 4 + hp * 2 + (wave >> 2), rg = wave & 3;
            const int qrow0 = isctx ? b * LCTX + qb * 128 : 2 * LCTX + b * SEQ + qb * 128;
            TileSched ts;
            if (isctx) { ts.nloc = 0; ts.blk0 = 0; ts.n = 4; }
            else { const int lo = qb > 0 ? qb - 1 : 0, hi = qb < 31 ? qb + 1 : 31; ts.blk0 = lo; ts.nloc = 2 * (hi - lo + 1); ts.n = ts.nloc + 4; }
            f32x16 O[4]; float m, ls;
            attn_core<128, true>(lds, PROJ, VTC + (size_t)((b * 2 + kvh) * 128) * NKEY, b, qrow0 + rg * 32, C_CQ + head * 128, C_CK + kvh * 128, 0, qb * 128 + rg * 32, ts, O, m, ls);
            const int lz = hide_tid() & 63, r = lz & 31, hh = lz >> 5;
            const float sink = a->in[21][l * 8 + head] * 1.4426950408889634f;
            const float inv = 1.0f / (ls + __builtin_amdgcn_exp2f(sink - m));
            float ss = 0.f;
            bf16* orow = MIX + (size_t)(qrow0 + rg * 32 + r) * MIXW + 1024 + head * 128;
#pragma unroll
            for (int blk = 0; blk < 4; ++blk)
#pragma unroll
                for (int g4 = 0; g4 < 4; ++g4) { const int dv = 32 * blk + 8 * g4 + 4 * hh;
                    const float o0 = O[blk][4 * g4 + 0] * inv, o1 = O[blk][4 * g4 + 1] * inv, o2 = O[blk][4 * g4 + 2] * inv, o3 = O[blk][4 * g4 + 3] * inv;
                    ss += o0 * o0 + o1 * o1 + o2 * o2 + o3 * o3;
                    const f32x4 gc = *(const f32x4*)(a->in[22] + l * 1024 + head * 128 + dv);
                    u32x2 o; o.x = pk2(o0 * gc[0], o1 * gc[1]); o.y = pk2(o2 * gc[2], o3 * gc[3]); *(u32x2*)(orow + dv) = o; }
            ss += __shfl_xor(ss, 32);
            if (hh == 0) SSQ[(size_t)(qrow0 + rg * 32 + r) * 8 + head] = ss;
        }
    }
}

__device__ __forceinline__ void phase_normc(ArgsP a, int l) {
    const int tid = hide_tid(), lane = tid & 63, wave = tid >> 6, G = gridDim.x;
    unsigned char* ws = a->ws; bf16* MIX = (bf16*)(ws + WS_MIX); const float* SSQ = (const float*)(ws + WS_SSQ);
    const int row_lo = (l == 0) ? 0 : 2 * LCTX;
    for (int row = row_lo + blockIdx.x * NWAVES + wave; row < MROWS; row += G * NWAVES) {
        const f32x4 s0 = *(const f32x4*)(SSQ + (size_t)row * 8), s1 = *(const f32x4*)(SSQ + (size_t)row * 8 + 4);
        const float ss = (s0[0] + s0[1]) + (s0[2] + s0[3]) + (s1[0] + s1[1]) + (s1[2] + s1[3]);
        const float rn = __builtin_amdgcn_rsqf(ss * (1.0f / 1024.0f) + EPS);
#pragma unroll
        for (int i = 0; i < 2; ++i) { const int c = 8 * (lane + 64 * i); bf16* p = MIX + (size_t)row * MIXW + 1024 + c;
            float f[8]; unpack8(*(const u32x4*)p, f); const float* g = a->in[22] + l * 1024 + c;
#pragma unroll
            for (int e = 0; e < 8; ++e) f[e] = f[e] * rn * g[e];
            *(u32x4*)p = pack8(f); }
    }
}

__device__ __forceinline__ int moe_offsets(const unsigned* cnt, int (&off)[NEXP], int (&cn)[NEXP]) {
    int o = 0;
#pragma unroll
    for (int e = 0; e < NEXP; ++e) { cn[e] = (int)cnt[64 * e]; off[e] = o; o += (cn[e] + 255) & ~255; }
    return o >> 8;
}
__device__ __forceinline__ void phase_gather(ArgsP a) {
    const int tid = hide_tid(), lane = tid & 63, wave = tid >> 6, G = gridDim.x;
    unsigned char* ws = a->ws;
    const unsigned* cnt = (const unsigned*)(ws + WS_CTL) + CW_CNT;
    int off[NEXP], cn[NEXP]; const int npan = moe_offsets(cnt, off, cn);
    if (blockIdx.x == 0 && tid == 0) { int* pe = (int*)(ws + WS_CTL) + CW_PEXP; pe[96] = npan;
#pragma unroll
        for (int e = 0; e < NEXP; ++e) { const int p0 = off[e] >> 8, np = (cn[e] + 255) >> 8; for (int p = 0; p < np; ++p) pe[p0 + p] = e; } }
    if (blockIdx.x == 0) { int NF, R, SK; pg8::moe_tail_params(npan, D / 256, G, NF, R, SK); pg8::StaticOrder so; so.init(npan, D / 256, G, 0, DFFE / 128);
        if (tid < R) { pg8::Unit u; so.map(NF + tid, u); ((int*)(ws + WS_CTL) + CW_TMODE)[u.pm * 8 + u.pn] = tid + 1; } }
    const unsigned char* HB = ws + WS_HB; unsigned char* HP = ws + WS_HPERM;
    const int gw = blockIdx.x * NWAVES + wave, NGW = G * NWAVES;
    for (int t = gw; t < NB * SEQ; t += NGW) {
        int* tk = (int*)(ws + WS_TOK) + (size_t)t * 8;
        const int e1 = tk[0], e2 = tk[1], p1 = tk[2], p2 = tk[3];
        int s1 = 0, s2 = 0;
#pragma unroll
        for (int e = 0; e < NEXP; ++e) { if (e == e1) s1 = off[e] + p1; if (e == e2) s2 = off[e] + p2; }
        if (lane == 0) { tk[6] = s1; tk[7] = s2; const float rs = ((const float*)(ws + WS_RS))[2 * LCTX + t]; ((float*)(ws + WS_RSS))[s1] = rs; ((float*)(ws + WS_RSS))[s2] = rs; }
        const u32x4* src = (const u32x4*)(HB + (size_t)(2 * LCTX + t) * D);
        u32x4* d1 = (u32x4*)(HP + (size_t)s1 * D); u32x4* d2 = (u32x4*)(HP + (size_t)s2 * D);
#pragma unroll
        for (int i = 0; i < 2; ++i) { const u32x4 v = src[lane + 64 * i]; d1[lane + 64 * i] = v; d2[lane + 64 * i] = v; }
    }
#pragma unroll
    for (int e = 0; e < NEXP; ++e) { const int npad = ((cn[e] + 255) & ~255) - cn[e];
        for (int p = gw; p < npad; p += NGW) { u32x4* d = (u32x4*)(HP + (size_t)(off[e] + cn[e] + p) * D);
#pragma unroll
            for (int i = 0; i < 2; ++i) d[lane + 64 * i] = (u32x4){0u, 0u, 0u, 0u};
            if (lane == 0) ((float*)(ws + WS_RSS))[off[e] + cn[e] + p] = 0.f; } }
}
__device__ __forceinline__ void slab_sum(const float* slab, int mode, int SK, int slot, int c, float (&y)[8]) {
#pragma unroll
    for (int e = 0; e < 8; ++e) y[e] = 0.f;
    for (int s = 0; s < SK; ++s) { const float* p = slab + (size_t)((mode - 1) * SK + s) * 65536 + (slot & 255) * 256 + (c & 255);
        const f32x4 a0 = *(const f32x4*)p, a1 = *(const f32x4*)(p + 4);
#pragma unroll
        for (int e = 0; e < 4; ++e) { y[e] += a0[e]; y[4 + e] += a1[e]; } }
}
__device__ __forceinline__ void phase_combine(ArgsP a, int l) {
    const int tid = hide_tid(), lane = tid & 63, wave = tid >> 6, G = gridDim.x;
    unsigned char* ws = a->ws;
    const bf16* XW = (const bf16*)(ws + WS_XW); const bf16* YS = (const bf16*)(ws + WS_YS); const float* slab = (const float*)(ws + WS_SLAB);
    const float* MODL = (const float*)(ws + WS_MOD) + l * 3 * 12288;
    const int* tmode = (const int*)(ws + WS_CTL) + CW_TMODE;
    int NF, R, SK; pg8::moe_tail_params(((const int*)(ws + WS_CTL) + CW_PEXP)[96], D / 256, G, NF, R, SK);
    for (int t = blockIdx.x * NWAVES + wave; t < NB * SEQ; t += G * NWAVES) {
        const int* tk = (const int*)(ws + WS_TOK) + (size_t)t * 8;
        const float g1 = ((const float*)tk)[4], g2 = ((const float*)tk)[5]; const int s1 = tk[6], s2 = tk[7];
        const float* gf = MODL + (t >> 12) * 12288 + 5 * 2048;
        const bf16* xr = XW + (size_t)(2 * LCTX + t) * D; float* orow = a->out + (size_t)t * D;
        int m1[4], m2[4];
#pragma unroll
        for (int i = 0; i < 4; ++i) { const int ct = (lane + 64 * i) >> 5; m1[i] = tmode[(s1 >> 8) * 8 + ct]; m2[i] = tmode[(s2 >> 8) * 8 + ct]; }
        u32x4 w1[4], w2[4], wx[4]; f32x4 ga[4], gb[4];
#pragma unroll
        for (int i = 0; i < 4; ++i) { const int c = 8 * (lane + 64 * i);
            w1[i] = (u32x4){0u, 0u, 0u, 0u}; w2[i] = (u32x4){0u, 0u, 0u, 0u};
            if (m1[i] == 0) w1[i] = *(const u32x4*)(YS + (size_t)s1 * D + c);
            if (m2[i] == 0) w2[i] = *(const u32x4*)(YS + (size_t)s2 * D + c);
            wx[i] = *(const u32x4*)(xr + c); ga[i] = *(const f32x4*)(gf + c); gb[i] = *(const f32x4*)(gf + c + 4); }
#pragma unroll
        for (int i = 0; i < 4; ++i) { const int c = 8 * (lane + 64 * i);
            float y1[8], y2[8], xv[8];
            if (m1[i] == 0) unpack8(w1[i], y1); else slab_sum(slab, m1[i], SK, s1, c, y1);
            if (m2[i] == 0) unpack8(w2[i], y2); else slab_sum(slab, m2[i], SK, s2, c, y2);
            unpack8(wx[i], xv);
            f32x4 o0, o1;
#pragma unroll
            for (int e = 0; e < 4; ++e) { o0[e] = xv[e] + ga[i][e] * (g1 * y1[e] + g2 * y2[e]); o1[e] = xv[4 + e] + gb[i][e] * (g1 * y1[4 + e] + g2 * y2[4 + e]); }
            *(f32x4*)(orow + c) = o0; *(f32x4*)(orow + c + 4) = o1; }
    }
}

constexpr int NPHASE = 21;
__global__ void __launch_bounds__(NTHR, 2) mk_fwd(Args args) {
    extern __shared__ __attribute__((aligned(16))) unsigned char lds_raw[];
    LAS unsigned char* lds = (LAS unsigned char*)lds_raw;
    volatile LAS unsigned* MISC = (volatile LAS unsigned*)(lds + MISC_OFF);
    const int tid = threadIdx.x, G = gridDim.x;
    ArgsP ap = (ArgsP)__builtin_amdgcn_kernarg_segment_ptr();
    unsigned char* ws = ap->ws;
    unsigned* ctl = (unsigned*)(ws + WS_CTL);
    if (tid < 64) MISC[tid] = 0u;
    __syncthreads();
    const int lo = ap->ph_lo, hi = ap->ph_hi;
    XcdBarrier bar; bar.bar = ctl + CW_BAR; bar.x = 0; bar.st = nullptr;
    if (hi - lo > 1) bar = xcd_barrier_post(ctl + CW_BAR, MISC + 8);
#define IN(k) (lo <= (k) && (k) < hi)
#define SEAM(k) do { if (IN(k) && IN((k) + 1)) xcd_barrier(bar); } while (0)
    const float* MOD = (const float*)(ws + WS_MOD);
    bf16* HB = (bf16*)(ws + WS_HB); bf16* PROJ = (bf16*)(ws + WS_PROJ); bf16* MIX = (bf16*)(ws + WS_MIX); bf16* XW = (bf16*)(ws + WS_XW);
    bf16* ACT = (bf16*)(ws + WS_ACT);

    if (IN(0)) phase_prologue(ap, lds);
    SEAM(0);
    { constexpr int l = 0;
        const int pb = (l == 0) ? 1 : 10;
        if (IN(pb + 0)) { if (l == 0) phase_norm<0, false, 0, 2>(ap, 0, 0, ap->in[6], 0, 1); else phase_norm<1, false, 11, 2>(ap, 1, 0, ap->in[6] + D, 0, 1); }
        SEAM(pb + 0);
        if (IN(pb + 1)) { pg8::Gemm g{HB, (const bf16*)(ws + WS_WIN + (size_t)l * INC * D), D / 2}; pg8::RangeOrder<pg8::StaticOrder> S; S.so.init(MROWS / 256, INC / 256, G, (int)blockIdx.x, D / 128);
            pg8::EpiStoreI8 E{PROJ, INC, (const float*)(ws + WS_RS), (const float*)(ws + WS_CSIN) + l * INC};
            S.i0 = 0; S.n = 1 << 30; pg8::gemm_phase<2>(lds, g, S, E);
            { const int rem = S.so.nwg % G; const bool all = rem == 0; const int nel = all ? G : G - rem, e = all ? (int)blockIdx.x : (int)blockIdx.x - rem;
              __syncthreads();
              if (e >= 0) { if (l == 0) deferred_a(ap, lds, e, nel); else { int f, n; quota(0, M1_G1, nel, e, f, n); moe_convert(ap, lds, 0, f, n); } } } }
        SEAM(pb + 1);
        if (IN(pb + 2)) phase_postproj(ap, l, lds);
        SEAM(pb + 2);
        if (IN(pb + 3)) { phase_attention(ap, l, lds, ((int)blockIdx.x >> 3) % 3); __syncthreads(); }
        SEAM(pb + 3);
        if (IN(pb + 5)) { pg8::Gemm g{MIX, (const bf16*)(ws + WS_WOUT) + (size_t)l * D * D, MIXW};
            pg8::EpiResidT<l == 0, true> E{XW, MOD + l * 3 * 12288, 2, (float*)(ws + WS_SLAB), 1.0f};
            pg8::CtxTailOrder S; S.so.init(32, D / 256, G, (int)blockIdx.x, MIXW / 64); S.SK = (l == 0) ? 8 : 0; S.two = 1;
            pg8::gemm_phase<0>(lds, g, S, E); }
        SEAM(pb + 5);
        if (IN(pb + 6)) { if (l == 0) phase_norm<2, false, 8, 2>(ap, 0, 0, ap->in[7], 3, 4); else phase_norm<1, true, 0, 2>(ap, 1, 2 * LCTX, ap->in[7] + D, 3, 4, lds); }
        SEAM(pb + 6);
        if (l == 0) {
            if (IN(8)) { pg8::Gemm g{HB, (const bf16*)(ws + WS_WF13), D / 2}; pg8::RangeOrder<pg8::StaticOrder> S; S.so.init(MROWS / 256, 2 * DFF / 256, G, (int)blockIdx.x, D / 128);
                pg8::EpiSwigluI8 E{(unsigned char*)ACT, -(DFF / 128), (const float*)(ws + WS_RS), (const float*)(ws + WS_CS)};
                S.i0 = 0; S.n = 1 << 30; pg8::gemm_phase<2>(lds, g, S, E); }
            SEAM(8);
            if (IN(9)) { pg8::Gemm g{ACT, (const bf16*)(ws + WS_WF2), DFF / 2}; pg8::CtxTailOrder S; S.so.init(32, D / 256, G, (int)blockIdx.x, DFF / 128); S.SK = 11; S.two = 0;
                pg8::EpiResidT<false, false> E{XW, MOD, 5, (float*)(ws + WS_SLAB), pg8::DS2}; pg8::gemm_phase<1, pg8::EpiResidT<false, false>, pg8::CtxTailOrder, true>(lds, g, S, E); }
            SEAM(9);
        } else {
            if (IN(17)) phase_gather(ap);
            SEAM(17);
            const int* pexp = (const int*)ctl + CW_PEXP;
            if (IN(18)) { const int npan = __builtin_amdgcn_readfirstlane(pexp[96]);
                pg8::Gemm g{(const bf16*)(ws + WS_HPERM), (const bf16*)(ws + WS_WM13), D / 2}; pg8::RangeOrder<pg8::MoeOrder> S; S.so.so.init(npan, 2 * DFFE / 256, G, (int)blockIdx.x, D / 128); S.so.pexp = pexp;
                pg8::EpiSwigluI8 E{(unsigned char*)ACT, -(DFFE / 128), (const float*)(ws + WS_RSS), (const float*)(ws + WS_CSM)};
                S.i0 = 0; S.n = 1 << 30; pg8::gemm_phase<2>(lds, g, S, E); }
            SEAM(18);
            if (IN(19)) { const int npan = __builtin_amdgcn_readfirstlane(pexp[96]);
                pg8::Gemm g{ACT, (const bf16*)(ws + WS_WM2), DFFE / 2}; pg8::MoeTailOrder S; S.so.init(npan, D / 256, G, (int)blockIdx.x, DFFE / 128); S.pexp = pexp; pg8::moe_tail_params(npan, D / 256, G, S.NF, S.R, S.SK);
                pg8::EpiStoreBf16T<false> E{(bf16*)(ws + WS_YS), D, (float*)(ws + WS_SLAB), pg8::DS2}; pg8::gemm_phase<1, pg8::EpiStoreBf16T<false>, pg8::MoeTailOrder, true>(lds, g, S, E); }
            SEAM(19);
            if (IN(20)) phase_combine(ap, 1);
        }
    }
    { constexpr int l = 1;
        const int pb = (l == 0) ? 1 : 10;
        if (IN(pb + 0)) { if (l == 0) phase_norm<0, false, 0, 2>(ap, 0, 0, ap->in[6], 0, 1); else phase_norm<1, false, 11, 2>(ap, 1, 0, ap->in[6] + D, 0, 1); }
        SEAM(pb + 0);
        if (IN(pb + 1)) { pg8::Gemm g{HB, (const bf16*)(ws + WS_WIN + (size_t)l * INC * D), D / 2}; pg8::RangeOrder<pg8::StaticOrder> S; S.so.init(MROWS / 256, INC / 256, G, (int)blockIdx.x, D / 128);
            pg8::EpiStoreI8 E{PROJ, INC, (const float*)(ws + WS_RS), (const float*)(ws + WS_CSIN) + l * INC};
            S.i0 = 0; S.n = 1 << 30; pg8::gemm_phase<2>(lds, g, S, E);
            { const int rem = S.so.nwg % G; const bool all = rem == 0; const int nel = all ? G : G - rem, e = all ? (int)blockIdx.x : (int)blockIdx.x - rem;
              __syncthreads();
              if (e >= 0) { if (l == 0) deferred_a(ap, lds, e, nel); else { int f, n; quota(0, M1_G1, nel, e, f, n); moe_convert(ap, lds, 0, f, n); } } } }
        SEAM(pb + 1);
        if (IN(pb + 2)) phase_postproj(ap, l, lds);
        SEAM(pb + 2);
        if (IN(pb + 3)) { phase_attention(ap, l, lds, ((int)blockIdx.x >> 3) % 3); __syncthreads(); }
        SEAM(pb + 3);
        if (IN(pb + 5)) { pg8::Gemm g{MIX, (const bf16*)(ws + WS_WOUT) + (size_t)l * D * D, MIXW};
            pg8::EpiResidT<l == 0, true> E{XW, MOD + l * 3 * 12288, 2, (float*)(ws + WS_SLAB), 1.0f};
            pg8::CtxTailOrder S; S.so.init(32, D / 256, G, (int)blockIdx.x, MIXW / 64); S.SK = (l == 0) ? 8 : 0; S.two = 1;
            pg8::gemm_phase<0>(lds, g, S, E); }
        SEAM(pb + 5);
        if (IN(pb + 6)) { if (l == 0) phase_norm<2, false, 8, 2>(ap, 0, 0, ap->in[7], 3, 4); else phase_norm<1, true, 0, 2>(ap, 1, 2 * LCTX, ap->in[7] + D, 3, 4, lds); }
        SEAM(pb + 6);
        if (l == 0) {
            if (IN(8)) { pg8::Gemm g{HB, (const bf16*)(ws + WS_WF13), D / 2}; pg8::RangeOrder<pg8::StaticOrder> S; S.so.init(MROWS / 256, 2 * DFF / 256, G, (int)blockIdx.x, D / 128);
                pg8::EpiSwigluI8 E{(unsigned char*)ACT, -(DFF / 128), (const float*)(ws + WS_RS), (const float*)(ws + WS_CS)};
                S.i0 = 0; S.n = 1 << 30; pg8::gemm_phase<2>(lds, g, S, E); }
            SEAM(8);
            if (IN(9)) { pg8::Gemm g{ACT, (const bf16*)(ws + WS_WF2), DFF / 2}; pg8::CtxTailOrder S; S.so.init(32, D / 256, G, (int)blockIdx.x, DFF / 128); S.SK = 11; S.two = 0;
                pg8::EpiResidT<false, false> E{XW, MOD, 5, (float*)(ws + WS_SLAB), pg8::DS2}; pg8::gemm_phase<1, pg8::EpiResidT<false, false>, pg8::CtxTailOrder, true>(lds, g, S, E); }
            SEAM(9);
        } else {
            if (IN(17)) phase_gather(ap);
            SEAM(17);
            const int* pexp = (const int*)ctl + CW_PEXP;
            if (IN(18)) { const int npan = __builtin_amdgcn_readfirstlane(pexp[96]);
                pg8::Gemm g{(const bf16*)(ws + WS_HPERM), (const bf16*)(ws + WS_WM13), D / 2}; pg8::RangeOrder<pg8::MoeOrder> S; S.so.so.init(npan, 2 * DFFE / 256, G, (int)blockIdx.x, D / 128); S.so.pexp = pexp;
                pg8::EpiSwigluI8 E{(unsigned char*)ACT, -(DFFE / 128), (const float*)(ws + WS_RSS), (const float*)(ws + WS_CSM)};
                S.i0 = 0; S.n = 1 << 30; pg8::gemm_phase<2>(lds, g, S, E); }
            SEAM(18);
            if (IN(19)) { const int npan = __builtin_amdgcn_readfirstlane(pexp[96]);
                pg8::Gemm g{ACT, (const bf16*)(ws + WS_WM2), DFFE / 2}; pg8::MoeTailOrder S; S.so.init(npan, D / 256, G, (int)blockIdx.x, DFFE / 128); S.pexp = pexp; pg8::moe_tail_params(npan, D / 256, G, S.NF, S.R, S.SK);
                pg8::EpiStoreBf16T<false> E{(bf16*)(ws + WS_YS), D, (float*)(ws + WS_SLAB), pg8::DS2}; pg8::gemm_phase<1, pg8::EpiStoreBf16T<false>, pg8::MoeTailOrder, true>(lds, g, S, E); }
            SEAM(19);
            if (IN(20)) phase_combine(ap, 1);
        }
    }
#undef IN
#undef SEAM
}

extern "C" void kernel_launch(void* const* d_in, const int* in_sizes, int n_in, void* d_out, int out_size, void* d_ws, size_t ws_size, hipStream_t stream) {
    static int grid = 0;
    if (grid == 0) {
        if (n_in != 30 || out_size != NB * SEQ * D || ws_size < WS_END) { fprintf(stderr, "kernel_launch: unexpected shapes (n_in %d out %d ws %zu need %zu)\n", n_in, out_size, ws_size, (size_t)WS_END); grid = -1; return; }
        int dev = 0, cus = 0, per_cu = 0;
        if (hipGetDevice(&dev) != hipSuccess || hipDeviceGetAttribute(&cus, hipDeviceAttributeMultiprocessorCount, dev) != hipSuccess) { grid = -1; return; }
        if (hipFuncSetAttribute((const void*)mk_fwd, hipFuncAttributeMaxDynamicSharedMemorySize, LDS_BYTES) != hipSuccess) { fprintf(stderr, "kernel_launch: hipFuncSetAttribute failed\n"); grid = -1; return; }
        if (hipOccupancyMaxActiveBlocksPerMultiprocessor(&per_cu, (const void*)mk_fwd, NTHR, LDS_BYTES) != hipSuccess || per_cu < 1) { fprintf(stderr, "kernel_launch: occupancy query says %d\n", per_cu); grid = -1; return; }
        (void)hipGetLastError();
        grid = cus;
    }
    if (grid < 0) return;
    (void)hipMemsetAsync((char*)d_ws + WS_CTL, 0, CTL_ZERO_BYTES, stream);
    Args a{};
    for (int i = 0; i < 30; ++i) a.in[i] = (const float*)d_in[i];
    a.out = (float*)d_out; a.ws = (unsigned char*)d_ws;
#if MK_N_LAUNCHES == 1
    a.ph_lo = 0; a.ph_hi = NPHASE;
    hipLaunchKernelGGL(mk_fwd, dim3(grid), dim3(NTHR), LDS_BYTES, stream, a);
#else
    for (int p = 0; p < NPHASE; ++p) { a.ph_lo = p; a.ph_hi = p + 1; hipLaunchKernelGGL(mk_fwd, dim3(grid), dim3(NTHR), LDS_BYTES, stream, a); }
#endif
}
```

```cpp
#include <hip/hip_runtime.h>
#include <cstdio>
#include <cstdint>

#ifndef MK_N_LAUNCHES
#define MK_N_LAUNCHES 1
#endif

#define GAS __attribute__((address_space(1)))
#define LAS __attribute__((address_space(3)))
typedef unsigned short bf16;
typedef short bf16x8 __attribute__((ext_vector_type(8)));
typedef float f32x4 __attribute__((ext_vector_type(4)));
typedef float f32x16 __attribute__((ext_vector_type(16)));
typedef unsigned u32x4 __attribute__((ext_vector_type(4)));
typedef unsigned u32x2 __attribute__((ext_vector_type(2)));

typedef const float* const __attribute__((address_space(4)))* KArgP;
__device__ __forceinline__ unsigned char* karg_ws() { return (unsigned char*)((const void* const __attribute__((address_space(4)))*)__builtin_amdgcn_kernarg_segment_ptr())[31]; }
__device__ __forceinline__ const float* karg_in(int i) { return ((KArgP)__builtin_amdgcn_kernarg_segment_ptr())[i]; }
__device__ __forceinline__ int hide_tid() { int t = threadIdx.x; asm volatile("" : "+v"(t)); return t; }
namespace pg8 {
#define PG8_LAS __attribute__((address_space(3)))
typedef unsigned short bf16_t;
constexpr int BM = 256, BK = 64, HALF = 128, HTB = HALF * BK * 2, STAGE_BYTES = 8 * HTB, NXCD = 8, WGM = 8;

__host__ __device__ __forceinline__ int lds_byte(int r, int c) { const int st = (r >> 4) * 2 + (c >> 5), rr = r & 15, cc = c & 31, ob = rr * 64 + cc * 2; return st * 1024 + (ob ^ (((ob >> 9) & 1) << 5)); }
__host__ __device__ __forceinline__ void stage_rc(int b, int& R, int& C) { const int st = b / 1024, sb = b % 1024, swz = sb ^ (((sb >> 9) & 1) << 5); R = (st >> 1) * 16 + swz / 64; C = (st & 1) * 32 + (swz % 64) / 2; }
__host__ __device__ __forceinline__ int perm32(int rho) { const int n = rho >> 4, i = rho & 15; return 8 * (i >> 2) + 4 * n + (i & 3); }

struct Unit { int pm, pn, pb, kt0, nk, split, tslot, keep, cpart; };
struct Gemm { const bf16_t* A; const bf16_t* Bt; int K; };

struct StaticOrder {
    int nM, nN, nwg, G, c, nkfull;
    __device__ void init(int nM_, int nN_, int G_, int c_, int nk_) { nM = nM_; nN = nN_; nwg = nM * nN; G = G_; c = c_; nkfull = nk_; }
    __device__ void map(int L, Unit& u) const {
        int wgid = L; { const int q = nwg / NXCD, r = nwg % NXCD, xcd = wgid % NXCD, off = wgid / NXCD; wgid = (xcd < r ? xcd * (q + 1) : r * (q + 1) + (xcd - r) * q) + off; }
        const int nig = WGM * nN, gid = wgid / nig, fm = gid * WGM, gsz = (nM - fm) < WGM ? (nM - fm) : WGM;
        u.pm = fm + ((wgid % nig) % gsz); u.pn = (wgid % nig) / gsz; u.pb = u.pn; u.kt0 = 0; u.nk = nkfull; u.split = 0; u.tslot = 0; u.keep = 0; u.cpart = 0;
    }
    __device__ bool next(int i, Unit& u) const { const long L = (long)i * G + c; if (L >= nwg) return false; map((int)L, u); return true; }
};
struct CtxTailOrder {
    StaticOrder so; int SK, two;
    __device__ bool next(int i, Unit& u) const {
        const int L = i * so.G + so.c;
        if (L < so.nwg) { so.map(L, u); u.pm += 2; u.keep = two ? 1 : 0; return true; }
        const int s = L - so.nwg; if (s >= 16 * SK) return false;
        const int tu = s / SK, ks = s - tu * SK;
        u.pm = tu >> 3; u.pn = tu & 7; u.pb = u.pn; u.nk = so.nkfull / SK; u.kt0 = ks * u.nk; u.split = 1; u.tslot = s; u.keep = 0; u.cpart = (two && u.kt0 >= so.nkfull / 2) ? 1 : 0; return true;
    }
};
struct MoeOrder {
    StaticOrder so; const int* pexp;
    __device__ bool next(int i, Unit& u) const { if (!so.next(i, u)) return false; u.pb = __builtin_amdgcn_readfirstlane(pexp[u.pm]) * so.nN + u.pn; return true; }
};
struct MoeTailOrder {
    StaticOrder so; const int* pexp; int NF, R, SK;
    __device__ bool next(int i, Unit& u) const {
        const int L = i * so.G + so.c;
        if (L < NF) { so.map(L, u); }
        else { const int s = L - NF; if (s >= R * SK) return false; const int tu = s / SK, ks = s - tu * SK;
            so.map(NF + tu, u); u.nk = so.nkfull / SK; u.kt0 = ks * u.nk; u.split = 1; u.tslot = s; }
        u.pb = __builtin_amdgcn_readfirstlane(pexp[u.pm]) * so.nN + u.pn; return true;
    }
};
template <class Base> struct RangeOrder {
    Base so; int i0, n;
    __device__ bool next(int i, Unit& u) const { return i < n && so.next(i0 + i, u); }
};
__device__ __forceinline__ void moe_tail_params(int npan, int nN, int G, int& NF, int& R, int& SK) {
    const int total = npan * nN; NF = (total / G) * G; R = total - NF;
    SK = 1; if (R > 0) { if (R * 7 <= G) SK = 7; else if (R * 4 <= G) SK = 4; else if (R * 2 <= G) SK = 2; }
}

typedef int v8i32 __attribute__((ext_vector_type(8)));
typedef int v4i32 __attribute__((ext_vector_type(4)));
__device__ __forceinline__ v8i32 cat8(const bf16x8 lo, const bf16x8 hi) { const v4i32 a = __builtin_bit_cast(v4i32, lo), b = __builtin_bit_cast(v4i32, hi); return (v8i32){a[0], a[1], a[2], a[3], b[0], b[1], b[2], b[3]}; }
__device__ __forceinline__ unsigned pk4_fp8(float a, float b, float c, float d) {
    a = __builtin_amdgcn_fmed3f(a, -448.f, 448.f); b = __builtin_amdgcn_fmed3f(b, -448.f, 448.f); c = __builtin_amdgcn_fmed3f(c, -448.f, 448.f); d = __builtin_amdgcn_fmed3f(d, -448.f, 448.f);
    int p = __builtin_amdgcn_cvt_pk_fp8_f32(a, b, 0, false); p = __builtin_amdgcn_cvt_pk_fp8_f32(c, d, p, true); return (unsigned)p; }
constexpr float S_H = 16.f, S_W13 = 512.f, S_ACT = 8.f, S_W2 = 1024.f, DS1 = 1.0f / (16.f * 512.f), DS2 = 1.0f / (8.f * 1024.f);
__device__ __forceinline__ unsigned cvt_pk_bf16(float lo, float hi) { unsigned r; asm volatile("v_cvt_pk_bf16_f32 %0, %1, %2" : "=v"(r) : "v"(lo), "v"(hi)); return r; }

__device__ __forceinline__ void slab_store(float* slab, const f32x4 (&acc)[2][2][4][2], const f32x4 (&gv)[2][2], const Unit& u, int wr, int wc, int fr, int fq) {
    float* P = slab + (size_t)u.tslot * 65536 + (wr * 64 + fr) * 256 + wc * 32 + 4 * fq;
#pragma unroll
    for (int ai = 0; ai < 2; ++ai)
#pragma unroll
        for (int m = 0; m < 4; ++m)
#pragma unroll
            for (int bj = 0; bj < 2; ++bj)
#pragma unroll
                for (int n = 0; n < 2; ++n) *(f32x4*)(P + (ai * HALF + m * 16) * 256 + bj * HALF + n * 16) = gv[bj][n] * acc[ai][bj][m][n];
}
template <bool P> struct EpiStoreBf16T {
    static constexpr bool PERM = P;
    bf16_t* O; int ldc; float* slab; float ds;
    __device__ __forceinline__ void operator()(const f32x4 (&acc)[2][2][4][2], const Unit& u, int wr, int wc, int fr, int fq) const {
        if (!P && u.split) { const f32x4 one = {ds, ds, ds, ds}; const f32x4 gv[2][2] = {{one, one}, {one, one}}; slab_store(slab, acc, gv, u, wr, wc, fr, fq); return; }
        const int row0 = u.pm * BM + wr * 64 + fr, col0 = u.pn * BM + wc * 32 + (P ? 8 * fq : 4 * fq);
#pragma unroll
        for (int ai = 0; ai < 2; ++ai)
#pragma unroll
            for (int m = 0; m < 4; ++m) { bf16_t* rowp = O + (size_t)(row0 + ai * HALF + m * 16) * ldc + col0;
#pragma unroll
                for (int bj = 0; bj < 2; ++bj) { const f32x4 v0 = acc[ai][bj][m][0] * ds, v1 = acc[ai][bj][m][1] * ds;
                    if (P) { u32x4 w; w.x = cvt_pk_bf16(v0[0], v0[1]); w.y = cvt_pk_bf16(v0[2], v0[3]); w.z = cvt_pk_bf16(v1[0], v1[1]); w.w = cvt_pk_bf16(v1[2], v1[3]);
                        *(u32x4*)(rowp + bj * HALF) = w; }
                    else { u32x2 w0, w1; w0.x = cvt_pk_bf16(v0[0], v0[1]); w0.y = cvt_pk_bf16(v0[2], v0[3]); w1.x = cvt_pk_bf16(v1[0], v1[1]); w1.y = cvt_pk_bf16(v1[2], v1[3]);
                        *(u32x2*)(rowp + bj * HALF) = w0; *(u32x2*)(rowp + bj * HALF + 16) = w1; } } }
    }
};
typedef EpiStoreBf16T<true> EpiStoreBf16;
__device__ __forceinline__ float silu_mul(float a, float b) { return a * __builtin_amdgcn_rcpf(1.0f + __builtin_amdgcn_exp2f(-1.4426950408889634f * a)) * b; }
struct EpiSwiglu {
    static constexpr bool PERM = true;
    bf16_t* O; int ldc;
    __device__ __forceinline__ void operator()(const f32x4 (&acc)[2][2][4][2], const Unit& u, int wr, int wc, int fr, int fq) const {
        const int row0 = u.pm * BM + wr * 64 + fr, col0 = u.pn * HALF + wc * 32 + 8 * fq;
#pragma unroll
        for (int ai = 0; ai < 2; ++ai)
#pragma unroll
            for (int m = 0; m < 4; ++m) { bf16_t* rowp = O + (size_t)(row0 + ai * HALF + m * 16) * ldc + col0;
                const f32x4 a0 = acc[ai][0][m][0], a1 = acc[ai][0][m][1], b0 = acc[ai][1][m][0], b1 = acc[ai][1][m][1];
                u32x4 w; w.x = cvt_pk_bf16(silu_mul(a0[0], b0[0]), silu_mul(a0[1], b0[1])); w.y = cvt_pk_bf16(silu_mul(a0[2], b0[2]), silu_mul(a0[3], b0[3]));
                w.z = cvt_pk_bf16(silu_mul(a1[0], b1[0]), silu_mul(a1[1], b1[1])); w.w = cvt_pk_bf16(silu_mul(a1[2], b1[2]), silu_mul(a1[3], b1[3]));
                *(u32x4*)rowp = w; }
    }
};
template <bool IN8> struct EpiSwiglu8T {
    static constexpr bool PERM = true;
    unsigned char* O; int ldc;
    __device__ __forceinline__ void operator()(const f32x4 (&acc)[2][2][4][2], const Unit& u, int wr, int wc, int fr, int fq) const {
        const int row0 = u.pm * BM + wr * 64 + fr, col0 = u.pn * HALF + wc * 32 + 8 * fq;
#pragma unroll
        for (int ai = 0; ai < 2; ++ai)
#pragma unroll
            for (int m = 0; m < 4; ++m) { unsigned char* rowp = O + (size_t)(row0 + ai * HALF + m * 16) * ldc + col0;
                const float da = IN8 ? DS1 : 1.0f, db = IN8 ? DS1 * S_ACT : S_ACT;
                const f32x4 a0 = acc[ai][0][m][0] * da, a1 = acc[ai][0][m][1] * da, b0 = acc[ai][1][m][0] * db, b1 = acc[ai][1][m][1] * db;
                u32x2 w; w.x = pk4_fp8(silu_mul(a0[0], b0[0]), silu_mul(a0[1], b0[1]), silu_mul(a0[2], b0[2]), silu_mul(a0[3], b0[3]));
                w.y = pk4_fp8(silu_mul(a1[0], b1[0]), silu_mul(a1[1], b1[1]), silu_mul(a1[2], b1[2]), silu_mul(a1[3], b1[3]));
                *(u32x2*)rowp = w; }
    }
};
typedef EpiSwiglu8T<true> EpiSwiglu8;
struct EpiSwigluI8 {
    static constexpr bool PERM = true, SCALES = true;
    unsigned char* O; int ldc; const float* rs; const float* cs;
    __device__ __forceinline__ void stage_scales(PG8_LAS unsigned char* slot, const Unit& u, int tid) const {
        const float* src = tid < 256 ? rs + u.pm * BM + tid : cs + u.pb * BM + (tid - 256);
        __builtin_amdgcn_global_load_lds((const unsigned*)src, (PG8_LAS unsigned*)(slot + (tid >> 6) * 256), 4, 0, 0);
    }
    __device__ __forceinline__ void operator()(const f32x4 (&acc)[2][2][4][2], const Unit& u, int wr, int wc, int fr, int fq, const PG8_LAS unsigned char* slot) const {
        const int row0 = u.pm * BM + wr * 64 + fr, col0 = u.pn * HALF + wc * 32 + 8 * fq;
        const PG8_LAS float* rsl = (const PG8_LAS float*)slot + wr * 64 + fr;
        const PG8_LAS float* csp = (const PG8_LAS float*)slot + 256 + wc * 32 + 8 * fq;
        const float L2E = 1.4426950408889634f;
        const f32x4 ka0 = *(const PG8_LAS f32x4*)csp * -L2E, ka1 = *(const PG8_LAS f32x4*)(csp + 4) * -L2E, kb0 = *(const PG8_LAS f32x4*)(csp + HALF) * (-S_ACT / L2E), kb1 = *(const PG8_LAS f32x4*)(csp + HALF + 4) * (-S_ACT / L2E);
#pragma unroll
        for (int ai = 0; ai < 2; ++ai)
#pragma unroll
            for (int m = 0; m < 4; ++m) { const int row = row0 + ai * HALF + m * 16; const float r = rsl[ai * HALF + m * 16];
                unsigned char* rowp = ldc < 0 ? O + ((size_t)(u.pm * (-ldc) + u.pn) * BM + (row - u.pm * BM)) * 128 + (col0 - u.pn * HALF) : O + (size_t)row * ldc + col0;
                const f32x4 fa0 = __builtin_convertvector(__builtin_bit_cast(v4i32, acc[ai][0][m][0]), f32x4), fa1 = __builtin_convertvector(__builtin_bit_cast(v4i32, acc[ai][0][m][1]), f32x4);
                const f32x4 fb0 = __builtin_convertvector(__builtin_bit_cast(v4i32, acc[ai][1][m][0]), f32x4), fb1 = __builtin_convertvector(__builtin_bit_cast(v4i32, acc[ai][1][m][1]), f32x4);
                const f32x4 a0 = (fa0 * r) * ka0, a1 = (fa1 * r) * ka1, b0 = (fb0 * r) * kb0, b1 = (fb1 * r) * kb1;
                f32x4 e0, e1;
#pragma unroll
                for (int j = 0; j < 4; ++j) { e0[j] = __builtin_amdgcn_exp2f(a0[j]); e1[j] = __builtin_amdgcn_exp2f(a1[j]); }
                e0 = e0 + 1.0f; e1 = e1 + 1.0f;
#pragma unroll
                for (int j = 0; j < 4; ++j) { e0[j] = __builtin_amdgcn_rcpf(e0[j]); e1[j] = __builtin_amdgcn_rcpf(e1[j]); }
                const f32x4 v0 = (a0 * b0) * e0, v1 = (a1 * b1) * e1;
                u32x2 w; w.x = pk4_fp8(v0[0], v0[1], v0[2], v0[3]); w.y = pk4_fp8(v1[0], v1[1], v1[2], v1[3]);
                *(u32x2*)rowp = w; }
    }
};
struct EpiStoreI8 {
    static constexpr bool PERM = true, SCALES = true;
    bf16_t* O; int ldc; const float* rs; const float* cs;
    __device__ __forceinline__ void stage_scales(PG8_LAS unsigned char* slot, const Unit& u, int tid) const {
        const float* src = tid < 256 ? rs + u.pm * BM + tid : cs + u.pb * BM + (tid - 256);
        __builtin_amdgcn_global_load_lds((const unsigned*)src, (PG8_LAS unsigned*)(slot + (tid >> 6) * 256), 4, 0, 0);
    }
    __device__ __forceinline__ void operator()(const f32x4 (&acc)[2][2][4][2], const Unit& u, int wr, int wc, int fr, int fq, const PG8_LAS unsigned char* slot) const {
        const int row0 = u.pm * BM + wr * 64 + fr, col0 = u.pn * BM + wc * 32 + 8 * fq;
        const PG8_LAS float* rsl = (const PG8_LAS float*)slot + wr * 64 + fr;
        const PG8_LAS float* csp = (const PG8_LAS float*)slot + 256 + wc * 32 + 8 * fq;
        f32x4 c[2][2];
#pragma unroll
        for (int bj = 0; bj < 2; ++bj)
#pragma unroll
            for (int n = 0; n < 2; ++n) c[bj][n] = *(const PG8_LAS f32x4*)(csp + bj * HALF + 4 * n);
#pragma unroll
        for (int ai = 0; ai < 2; ++ai)
#pragma unroll
            for (int m = 0; m < 4; ++m) { const float r = rsl[ai * HALF + m * 16]; bf16_t* rowp = O + (size_t)(row0 + ai * HALF + m * 16) * ldc + col0;
#pragma unroll
                for (int bj = 0; bj < 2; ++bj) {
                    const f32x4 v0 = (__builtin_convertvector(__builtin_bit_cast(v4i32, acc[ai][bj][m][0]), f32x4) * r) * c[bj][0], v1 = (__builtin_convertvector(__builtin_bit_cast(v4i32, acc[ai][bj][m][1]), f32x4) * r) * c[bj][1];
                    u32x4 w; w.x = cvt_pk_bf16(v0[0], v0[1]); w.y = cvt_pk_bf16(v0[2], v0[3]); w.z = cvt_pk_bf16(v1[0], v1[1]); w.w = cvt_pk_bf16(v1[2], v1[3]);
                    *(u32x4*)(rowp + bj * HALF) = w; } }
    }
};
template <class E> struct has_mid { template <class T> static constexpr bool f(decltype(T::MID)*) { return T::MID; } template <class T> static constexpr bool f(...) { return false; } static constexpr bool value = f<E>(nullptr); };
template <class E> struct has_scales { template <class T> static constexpr bool f(decltype(T::SCALES)*) { return T::SCALES; } template <class T> static constexpr bool f(...) { return false; } static constexpr bool value = f<E>(nullptr); };
constexpr int SCALE_SLOT_OFF = STAGE_BYTES, SCALE_SLOT_BYTES = 2048;
constexpr size_t SSQ_OFF = (size_t)3 << 20;
template <bool FIRST, bool MIDC> struct EpiResidT {
    static constexpr bool PERM = false, MID = MIDC;
    bf16_t* X; const float* modl; int chunk; float* slab; float ds;
    __device__ __forceinline__ float rowfac(int row) const { const float* ssq = (const float*)(karg_ws() + SSQ_OFF);
        const f32x4 s0 = *(const f32x4*)(ssq + (size_t)row * 8), s1 = *(const f32x4*)(ssq + (size_t)row * 8 + 4);
        return __builtin_amdgcn_rsqf(((s0[0] + s0[1]) + (s0[2] + s0[3]) + (s1[0] + s1[1]) + (s1[2] + s1[3])) * (1.0f / 1024.0f) + 1e-6f); }
    __device__ __forceinline__ void mid(f32x4 (&acc)[2][2][4][2], const Unit& u, int wr, int wc, int fr, int fq) const {
        const int row0 = u.pm * BM + wr * 64 + fr;
#pragma unroll
        for (int ai = 0; ai < 2; ++ai)
#pragma unroll
            for (int m = 0; m < 4; ++m) { const float r = rowfac(row0 + ai * HALF + m * 16);
#pragma unroll
                for (int bj = 0; bj < 2; ++bj)
#pragma unroll
                    for (int n = 0; n < 2; ++n) acc[ai][bj][m][n] = acc[ai][bj][m][n] * r;
                asm volatile("" ::: "memory"); }
    }
    __device__ __forceinline__ void operator()(const f32x4 (&acc)[2][2][4][2], const Unit& u, int wr, int wc, int fr, int fq) const {
        const int pmg = u.pm, v = pmg < 2 ? 2 : ((pmg - 2) >> 4);
        const float* gate = modl + v * 12288 + chunk * 2048;
        const int row0 = pmg * BM + wr * 64 + fr, col0 = u.pn * BM + wc * 32 + 4 * fq;
        f32x4 gv[2][2];
#pragma unroll
        for (int bj = 0; bj < 2; ++bj)
#pragma unroll
            for (int n = 0; n < 2; ++n) gv[bj][n] = *(const f32x4*)(gate + col0 + bj * HALF + n * 16) * ds;
        if (u.split) {
            float* P = slab + (size_t)u.tslot * 65536 + (wr * 64 + fr) * 256 + wc * 32 + 4 * fq;
#pragma unroll
            for (int ai = 0; ai < 2; ++ai)
#pragma unroll
                for (int m = 0; m < 4; ++m) { const float r = (MIDC && u.cpart) ? rowfac(row0 + ai * HALF + m * 16) : 1.0f;
#pragma unroll
                    for (int bj = 0; bj < 2; ++bj)
#pragma unroll
                        for (int n = 0; n < 2; ++n) *(f32x4*)(P + (ai * HALF + m * 16) * 256 + bj * HALF + n * 16) = gv[bj][n] * acc[ai][bj][m][n] * r;
                    asm volatile("" ::: "memory"); }
            return; }
        const float* xin = FIRST ? (pmg < 2 ? karg_in(2) : karg_in(0) - (size_t)512 * 2048) : nullptr;
#pragma unroll
        for (int ai = 0; ai < 2; ++ai)
#pragma unroll
            for (int m = 0; m < 4; ++m) { const size_t ro = (size_t)(row0 + ai * HALF + m * 16) * 2048 + col0;
#pragma unroll
                for (int bj = 0; bj < 2; ++bj)
#pragma unroll
                    for (int n = 0; n < 2; ++n) { const size_t o = ro + bj * HALF + n * 16; f32x4 b;
                        if (FIRST) b = *(const f32x4*)(xin + o);
                        else { const u32x2 w = *(const u32x2*)(X + o); b = (f32x4){__builtin_bit_cast(float, w.x << 16), __builtin_bit_cast(float, w.x & 0xffff0000u), __builtin_bit_cast(float, w.y << 16), __builtin_bit_cast(float, w.y & 0xffff0000u)}; }
                        b = b + gv[bj][n] * acc[ai][bj][m][n];
                        u32x2 w2; w2.x = cvt_pk_bf16(b[0], b[1]); w2.y = cvt_pk_bf16(b[2], b[3]); *(u32x2*)(X + o) = w2; } }
    }
};

template <int MODE  , class Epi, class Sched, bool BLK = false>
__device__ __forceinline__ void gemm_phase(PG8_LAS unsigned char* lds, const Gemm g, const Sched& S, const Epi& E) {
    const int tid = hide_tid(), wid = __builtin_amdgcn_readfirstlane(tid >> 6), lane = tid & 63, wr = wid >> 2, wc = wid & 3, fr = lane & 15, fq = lane >> 4;
    const int K = g.K;
    unsigned voffA[2], voffB[2];
#pragma unroll
    for (int i = 0; i < 2; ++i) { int R, C; stage_rc(tid * 16 + i * 8192, R, C); const int Rb = Epi::PERM ? ((R & ~31) + perm32(R & 31)) : R;
        voffA[i] = BLK ? (unsigned)(R * 64 + C) * 2u : (unsigned)(R * K + C) * 2u; voffB[i] = BLK ? (unsigned)(Rb * 64 + C) * 2u : (unsigned)(Rb * K + C) * 2u; }
    const size_t kstep = BLK ? (size_t)(BM * BK * 2) : (size_t)(BK * 2);
    const size_t hstep = BLK ? (size_t)(HALF * BK * 2) : (size_t)HALF * K * 2;
    const size_t tstep = (size_t)BM * K * 2;
    const unsigned ldsw = (unsigned)wid * 1024u;
    const int aoff = lds_byte(wr * 64 + fr, fq * 8), boff = lds_byte(wc * 32 + fr, fq * 8);
#define PG8_SA(b, h) (((b) * 2 + (h)) * HTB)
#define PG8_SB(b, h) ((4 + (b) * 2 + (h)) * HTB)
#define PG8_STAGE(bufoff, gbase, voff) do { _Pragma("unroll") for (int _i = 0; _i < 2; ++_i) { unsigned _o = (voff)[_i]; asm volatile("" : "+v"(_o)); \
        __builtin_amdgcn_global_load_lds((const unsigned*)((const char*)(gbase) + _o), (PG8_LAS unsigned*)(lds + (bufoff) + ldsw + _i * 8192), 16, 0, 0); } } while (0)
#define PG8_LDA(dst, b, h) do { _Pragma("unroll") for (int m = 0; m < 4; ++m) _Pragma("unroll") for (int k = 0; k < 2; ++k) dst[m][k] = *(const PG8_LAS bf16x8*)(lds + PG8_SA(b, h) + aoff + m * 2048 + k * 1024); } while (0)
#define PG8_LDB(dst, b, h) do { _Pragma("unroll") for (int n = 0; n < 2; ++n) _Pragma("unroll") for (int k = 0; k < 2; ++k) dst[n][k] = *(const PG8_LAS bf16x8*)(lds + PG8_SB(b, h) + boff + n * 2048 + k * 1024); } while (0)
#define PG8_MMA(ai, bj, At, Bt) do { __builtin_amdgcn_s_setprio(1); _Pragma("unroll") for (int m = 0; m < 4; ++m) _Pragma("unroll") for (int n = 0; n < 2; ++n) { \
        if constexpr (MODE == 1) { acc[ai][bj][m][n] = __builtin_amdgcn_mfma_scale_f32_16x16x128_f8f6f4(cat8(Bt[n][0], Bt[n][1]), cat8(At[m][0], At[m][1]), acc[ai][bj][m][n], 0, 0, 0, 0, 0, 0); } \
        else if constexpr (MODE == 2) { _Pragma("unroll") for (int k = 0; k < 2; ++k) acc[ai][bj][m][n] = __builtin_bit_cast(f32x4, __builtin_amdgcn_mfma_i32_16x16x64_i8(__builtin_bit_cast(v4i32, Bt[n][k]), __builtin_bit_cast(v4i32, At[m][k]), __builtin_bit_cast(v4i32, acc[ai][bj][m][n]), 0, 0, 0)); } \
        else { _Pragma("unroll") for (int k = 0; k < 2; ++k) acc[ai][bj][m][n] = __builtin_amdgcn_mfma_f32_16x16x32_bf16(Bt[n][k], At[m][k], acc[ai][bj][m][n], 0, 0, 0); } } \
        __builtin_amdgcn_s_setprio(0); } while (0)
#define PG8_WAIT_V(n) asm volatile("s_waitcnt vmcnt(" #n ")" ::: "memory")
#define PG8_WAIT_L(n) asm volatile("s_waitcnt lgkmcnt(" #n ")" ::: "memory")
#define PG8_BAR __builtin_amdgcn_s_barrier()
#define PG8_SCHED __builtin_amdgcn_sched_barrier(0)
    Unit cur, nxt; int ui = 0;
    if (!S.next(0, cur)) return;
    f32x4 acc[2][2][4][2];
#pragma unroll
    for (int a = 0; a < 2; ++a)
#pragma unroll
        for (int b = 0; b < 2; ++b)
#pragma unroll
            for (int m = 0; m < 4; ++m)
#pragma unroll
                for (int n = 0; n < 2; ++n) acc[a][b][m][n] = (f32x4){0.f, 0.f, 0.f, 0.f};
    bf16x8 At[4][2], B0[2][2], B1[2][2];
    const char* cA = (const char*)g.A + (size_t)cur.pm * tstep + (size_t)cur.kt0 * kstep; const char* cB = (const char*)g.Bt + (size_t)cur.pb * tstep + (size_t)cur.kt0 * kstep;
#define PG8_WOFS(u) ((has_mid<Epi>::value && (u).keep) ? (size_t)((u).nk / 2) * kstep : (size_t)0)
    const char* fA = cA + PG8_WOFS(cur); const char* fB = cB + PG8_WOFS(cur);
    if constexpr (has_scales<Epi>::value) E.stage_scales(lds + SCALE_SLOT_OFF, cur, tid);
    PG8_STAGE(PG8_SB(0, 0), fB, voffB); PG8_STAGE(PG8_SB(0, 1), fB + hstep, voffB); PG8_STAGE(PG8_SA(0, 0), fA, voffA); PG8_STAGE(PG8_SA(0, 1), fA + hstep, voffA);
    if (wr == 1) PG8_BAR;
    PG8_WAIT_V(2); PG8_BAR;
    PG8_STAGE(PG8_SB(1, 0), fB + kstep, voffB); PG8_STAGE(PG8_SA(1, 0), fA + kstep, voffA); PG8_STAGE(PG8_SB(1, 1), fB + hstep + kstep, voffB);
    PG8_WAIT_V(6); PG8_BAR;
    for (;;) {
        const bool has_next = S.next(ui + 1, nxt);
        const char* nA0 = has_next ? (const char*)g.A + (size_t)nxt.pm * tstep + (size_t)nxt.kt0 * kstep : cA; const char* nB0 = has_next ? (const char*)g.Bt + (size_t)nxt.pb * tstep + (size_t)nxt.kt0 * kstep : cB;
        const char* nA = has_next ? nA0 + PG8_WOFS(nxt) : fA; const char* nB = has_next ? nB0 + PG8_WOFS(nxt) : fB;
        const int nt = cur.nk;
        const bool wrapu = has_mid<Epi>::value && cur.keep; const int halfk = nt >> 1;
        for (int t = 0; t < nt; t += 2) {
            const bool last = (t == nt - 2);
#define PG8_KOFF(tt) ((size_t)(wrapu ? ((tt) < halfk ? (tt) + halfk : (tt) - halfk) : (tt)) * kstep)
            const char* a1 = cA + PG8_KOFF(t + 1);
            const char* a2 = last ? nA : cA + PG8_KOFF(t + 2); const char* b2 = last ? nB : cB + PG8_KOFF(t + 2);
            const char* a3 = a2 + kstep; const char* b3 = b2 + kstep;
            if constexpr (has_mid<Epi>::value) { if (wrapu && t == halfk) { const int tz = hide_tid(), wz = __builtin_amdgcn_readfirstlane(tz >> 6), lz = tz & 63; E.mid(acc, cur, wz >> 2, wz & 3, lz & 15, lz >> 4); } }
            if constexpr (has_scales<Epi>::value) { if (last && has_next) E.stage_scales(lds + SCALE_SLOT_OFF + ((ui + 1) & 1) * SCALE_SLOT_BYTES, nxt, tid); }
            PG8_LDB(B0, 0, 0); PG8_LDB(B1, 0, 1); PG8_SCHED; PG8_LDA(At, 0, 0); PG8_STAGE(PG8_SA(1, 1), a1 + hstep, voffA);
            PG8_WAIT_V(8); PG8_WAIT_L(0); PG8_BAR; PG8_MMA(0, 0, At, B0); PG8_MMA(0, 1, At, B1); PG8_BAR; PG8_SCHED;
            PG8_LDA(At, 0, 1); PG8_STAGE(PG8_SB(0, 0), b2, voffB); PG8_STAGE(PG8_SB(0, 1), b2 + hstep, voffB); PG8_STAGE(PG8_SA(0, 0), a2, voffA);
            PG8_WAIT_V(8); PG8_WAIT_L(0); PG8_BAR; PG8_MMA(1, 0, At, B0); PG8_MMA(1, 1, At, B1); PG8_BAR; PG8_SCHED;
            PG8_LDB(B0, 1, 0); PG8_LDB(B1, 1, 1); PG8_SCHED; PG8_LDA(At, 1, 0); PG8_STAGE(PG8_SA(0, 1), a2 + hstep, voffA);
            PG8_WAIT_V(8); PG8_WAIT_L(0); PG8_BAR; PG8_MMA(0, 0, At, B0); PG8_MMA(0, 1, At, B1); PG8_BAR; PG8_SCHED;
            PG8_LDA(At, 1, 1); PG8_STAGE(PG8_SB(1, 0), b3, voffB); PG8_STAGE(PG8_SB(1, 1), b3 + hstep, voffB); PG8_STAGE(PG8_SA(1, 0), a3, voffA);
            PG8_WAIT_V(8); PG8_WAIT_L(0); PG8_BAR; PG8_MMA(1, 0, At, B0); PG8_MMA(1, 1, At, B1); PG8_BAR; PG8_SCHED;
        }
        if (wr == 0) PG8_BAR;
        { const int tz = hide_tid(), wz = __builtin_amdgcn_readfirstlane(tz >> 6), lz = tz & 63;
          if constexpr (has_scales<Epi>::value) E(acc, cur, wz >> 2, wz & 3, lz & 15, lz >> 4, lds + SCALE_SLOT_OFF + (ui & 1) * SCALE_SLOT_BYTES);
          else E(acc, cur, wz >> 2, wz & 3, lz & 15, lz >> 4); }
        if (!has_next) break;
#pragma unroll
        for (int a = 0; a < 2; ++a)
#pragma unroll
            for (int b = 0; b < 2; ++b)
#pragma unroll
                for (int m = 0; m < 4; ++m)
#pragma unroll
                    for (int n = 0; n < 2; ++n) acc[a][b][m][n] = (f32x4){0.f, 0.f, 0.f, 0.f};
        cur = nxt; cA = nA0; cB = nB0; fA = nA; fB = nB; ++ui;
        if (wr == 1) PG8_BAR;
    }
    PG8_WAIT_V(0);
    PG8_BAR;
#undef PG8_SA
#undef PG8_WOFS
#undef PG8_KOFF
#undef PG8_SB
#undef PG8_STAGE
#undef PG8_LDA
#undef PG8_LDB
#undef PG8_MMA
#undef PG8_WAIT_V
#undef PG8_WAIT_L
#undef PG8_BAR
#undef PG8_SCHED
}
}

constexpr int D = 2048, NB = 2, SEQ = 4096, LCTX = 256, NKEY = SEQ + LCTX;
constexpr int MROWS = NB * NKEY;
constexpr int INC = 4608, MIXW = 2048, DFF = 5632, NEXP = 8, DFFE = 7168;
constexpr int C_AQ = 0, C_AK = 512, C_AV = 1024, C_BB = 1536, C_BC = 2048, C_BX = 2560, C_CQ = 3072, C_CK = 4096, C_CV = 4352;
constexpr float EPS = 1e-6f;
constexpr int MAXSLOT = 2 * NB * SEQ + NEXP * 256;
constexpr int NWAVES = 8, NTHR = 512;

constexpr size_t MiB = 1u << 20;
constexpr size_t WS_CTL = 0, CTL_ZERO_BYTES = 128 * 1024;
constexpr size_t WS_MOD = 1 * MiB;
constexpr size_t WS_TOK = 2 * MiB;
constexpr size_t WS_CSM = 2 * MiB + 512 * 1024;
constexpr size_t WS_RSS = 3 * MiB + 576 * 1024;
constexpr size_t WS_RS = 3 * MiB + 512 * 1024;
constexpr size_t WS_CS = 3 * MiB + 768 * 1024;
constexpr size_t WS_CSIN = 3 * MiB + 832 * 1024;
constexpr size_t WS_SSQ = 3 * MiB; static_assert(WS_SSQ == pg8::SSQ_OFF, "SSQ offset");
constexpr size_t WS_WIN = 4 * MiB;
constexpr size_t WS_WOUT = WS_WIN + (size_t)2 * INC * D * 2;
constexpr size_t WS_WF13 = WS_WOUT + (size_t)2 * D * D * 2;
constexpr size_t WS_WF2 = WS_WF13 + (size_t)2 * DFF * D * 2;
constexpr size_t WS_WM13 = WS_WF2 + (size_t)D * DFF * 2;
constexpr size_t WS_WM2 = WS_WM13 + (size_t)NEXP * 2 * DFFE * D * 2;
constexpr size_t WS_XW = WS_WM2 + (size_t)NEXP * D * DFFE * 2;
constexpr size_t WS_HB = WS_XW + (size_t)MROWS * D * 4;
constexpr size_t WS_PROJ = WS_HB + (size_t)MROWS * D * 2;
constexpr size_t WS_VTA = WS_PROJ + (size_t)MROWS * INC * 2;
constexpr size_t WS_VTC = WS_VTA + (size_t)NB * 4 * 128 * NKEY * 2;
constexpr size_t WS_MIX = WS_VTC + (size_t)NB * 2 * 128 * NKEY * 2;
constexpr size_t WS_ACT = WS_MIX + (size_t)MROWS * MIXW * 2;
constexpr size_t WS_HPERM = WS_ACT + (size_t)MAXSLOT * DFFE * 2;
constexpr size_t WS_YS = WS_HPERM + (size_t)MAXSLOT * D * 2;
constexpr size_t WS_SLAB = WS_YS + (size_t)MAXSLOT * D * 2;
constexpr size_t WS_END = WS_SLAB + (size_t)256 * 65536 * 4;
constexpr int CW_BAR = 4096;
constexpr int CW_CNT = 16384;
constexpr int CW_TMODE = 24576;
constexpr int CW_PEXP = 20480;

constexpr int LDS_BYTES = 147456;
constexpr int MISC_OFF = LDS_BYTES - 256;

__device__ __forceinline__ unsigned f2bf(float f) { unsigned u = __builtin_bit_cast(unsigned, f); return (u + 0x7fffu + ((u >> 16) & 1u)) >> 16; }
__device__ __forceinline__ unsigned pk2(float lo, float hi) { return pg8::cvt_pk_bf16(lo, hi); }
__device__ __forceinline__ float bflo(unsigned w) { return __builtin_bit_cast(float, w << 16); }
__device__ __forceinline__ float bfhi(unsigned w) { return __builtin_bit_cast(float, w & 0xffff0000u); }
__device__ __forceinline__ float wave_sum(float v) {
#pragma unroll
    for (int o = 1; o < 64; o <<= 1) v += __shfl_xor(v, o);
    return v;
}
__device__ __forceinline__ void unpack8(const u32x4 w, float (&f)[8]) { f[0] = bflo(w.x); f[1] = bfhi(w.x); f[2] = bflo(w.y); f[3] = bfhi(w.y); f[4] = bflo(w.z); f[5] = bfhi(w.z); f[6] = bflo(w.w); f[7] = bfhi(w.w); }
__device__ __forceinline__ u32x4 pack8(const float (&f)[8]) { u32x4 w; w.x = pk2(f[0], f[1]); w.y = pk2(f[2], f[3]); w.z = pk2(f[4], f[5]); w.w = pk2(f[6], f[7]); return w; }
__device__ __forceinline__ int rowmap(int b, int j) { return j < LCTX ? b * LCTX + j : 2 * LCTX + b * SEQ + (j - LCTX); }

#define XB_TMO      128
#define XB_XCNT(j)  (256  + 64 * (j))
#define XB_XSUB(j)  (1280 + 64 * (j))
#define XB_XGEN(j)  (2304 + 64 * (j))
#define XB_TOP      3328
#define XB_TOPGEN   3392
#define XCD_BAR_WORDS 3456
#define XB_SPIN_CAP (1u << 18)
__device__ __forceinline__ unsigned xb_ld(unsigned* p)              { return __hip_atomic_load(p, __ATOMIC_RELAXED, __HIP_MEMORY_SCOPE_AGENT); }
__device__ __forceinline__ unsigned xb_add(unsigned* p, unsigned v) { return __hip_atomic_fetch_add(p, v, __ATOMIC_RELAXED, __HIP_MEMORY_SCOPE_AGENT); }
__device__ __forceinline__ unsigned xb_xcc_id() { return (unsigned)__builtin_amdgcn_s_getreg((3 << 11) | 20) & 0xFu; }
#define XB_SPIN(cond, bar) do { unsigned _sp = 0; while (cond) { __builtin_amdgcn_s_sleep(1); \
    if ((++_sp & 255u) == 0u) { if (xb_ld(&(bar)[XB_TMO])) break; if (_sp > XB_SPIN_CAP) { atomicAdd(&(bar)[XB_TMO], 1u); break; } } } } while (0)
struct XcdBarrier { unsigned* bar; unsigned x; volatile LAS unsigned* st; };
__device__ __forceinline__ XcdBarrier xcd_barrier_post(unsigned* bar, volatile LAS unsigned* st) {
    XcdBarrier b; b.bar = bar; b.x = xb_xcc_id(); b.st = st;
    if (threadIdx.x == 0) (void)xb_add(&bar[XB_XCNT(b.x)], 1u);
    return b;
}
__device__ __forceinline__ void xcd_barrier_complete(unsigned* bar, unsigned x, unsigned& nloc, unsigned& nx) {
    const unsigned G = gridDim.x * gridDim.y * gridDim.z;
    unsigned sum, cnt, mine, sp = 0u;
    for (;;) {
        sum = 0u; cnt = 0u; mine = 0u;
#pragma unroll
        for (unsigned j = 0; j < 16; ++j) { const unsigned c = xb_ld(&bar[XB_XCNT(j)]); sum += c; cnt += (c > 0u) ? 1u : 0u; mine = (j == x) ? c : mine; }
        if (sum == G) break;
        __builtin_amdgcn_s_sleep(1);
        if ((++sp & 255u) == 0u) { if (xb_ld(&bar[XB_TMO])) break; if (sp > XB_SPIN_CAP) { atomicAdd(&bar[XB_TMO], 1u); break; } }
    }
    nloc = mine > 0u ? mine : 1u; nx = cnt > 0u ? cnt : 1u;
}
__device__ __forceinline__ void xcd_barrier(const XcdBarrier& b) {
    asm volatile("s_waitcnt vmcnt(0)" ::: "memory");
    __syncthreads();
    if (threadIdx.x == 0) {
        unsigned* bar = b.bar;
        __builtin_amdgcn_s_waitcnt(0);
        unsigned nloc = b.st[0], nx = b.st[1];
        if (nloc == 0u) { xcd_barrier_complete(bar, b.x, nloc, nx); b.st[0] = nloc; b.st[1] = nx; }
        const unsigned old = xb_add(&bar[XB_XSUB(b.x)], 1u);
        const unsigned gen = old / nloc;
        if (old + 1u == (gen + 1u) * nloc) {
            __builtin_amdgcn_fence(__ATOMIC_RELEASE, "agent");
            asm volatile("s_waitcnt vmcnt(0)" ::: "memory");
            const unsigned og = xb_add(&bar[XB_TOP], 1u);
            const unsigned tg = og / nx;
            if (og + 1u == (tg + 1u) * nx) xb_add(&bar[XB_TOPGEN], 1u);
            else XB_SPIN(xb_ld(&bar[XB_TOPGEN]) == tg, bar);
            __builtin_amdgcn_fence(__ATOMIC_ACQUIRE, "agent");
            xb_add(&bar[XB_XGEN(b.x)], 1u);
            asm volatile("s_waitcnt vmcnt(0)" ::: "memory");
        } else {
            XB_SPIN(xb_ld(&bar[XB_XGEN(b.x)]) == gen, bar);
            __builtin_amdgcn_fence(__ATOMIC_ACQUIRE, "agent");
            asm volatile("s_waitcnt vmcnt(0)" ::: "memory");
        }
    }
    __syncthreads();
}

struct Args { const float* in[30]; float* out; unsigned char* ws; int ph_lo, ph_hi; };
typedef const __attribute__((address_space(4))) Args* ArgsP;


__device__ __forceinline__ void xpose_item(const float* __restrict__ W, int ldw, int k0, int n0, bf16* __restrict__ dst0, int ldd, LAS float* scr, int lane) {
    f32x4 v[16];
    const float* src = W + (size_t)(k0 + (lane >> 4)) * ldw + n0 + 4 * (lane & 15);
#pragma unroll
    for (int i = 0; i < 16; ++i) v[i] = __builtin_nontemporal_load((const f32x4*)(src + (size_t)(4 * i) * ldw));
#pragma unroll
    for (int i = 0; i < 16; ++i) { LAS float* s = scr + (4 * i + (lane >> 4)) * 65 + 4 * (lane & 15); s[0] = v[i][0]; s[1] = v[i][1]; s[2] = v[i][2]; s[3] = v[i][3]; }
    asm volatile("s_waitcnt lgkmcnt(0)" ::: "memory");
    const int c = lane & 7;
#pragma unroll
    for (int j = 0; j < 8; ++j) { const int n = (lane >> 3) + 8 * j; const LAS float* s = scr + (8 * c) * 65 + n;
        u32x4 o; o.x = pk2(s[0 * 65], s[1 * 65]); o.y = pk2(s[2 * 65], s[3 * 65]); o.z = pk2(s[4 * 65], s[5 * 65]); o.w = pk2(s[6 * 65], s[7 * 65]);
        __builtin_nontemporal_store(o, (u32x4*)(dst0 + (size_t)n * ldd + k0 + 8 * c)); }
    asm volatile("s_waitcnt lgkmcnt(0)" ::: "memory");
}
__device__ __forceinline__ void xpose_item8(const float* __restrict__ W, int ldw, int k0, int n0, unsigned char* __restrict__ dst0, int ldd, int kofs, float scale, LAS float* scr, int lane) {
    f32x4 v[16];
    const float* src = W + (size_t)(k0 + (lane >> 4)) * ldw + n0 + 4 * (lane & 15);
#pragma unroll
    for (int i = 0; i < 16; ++i) v[i] = __builtin_nontemporal_load((const f32x4*)(src + (size_t)(4 * i) * ldw));
#pragma unroll
    for (int i = 0; i < 16; ++i) { LAS float* s = scr + (4 * i + (lane >> 4)) * 65 + 4 * (lane & 15); s[0] = v[i][0] * scale; s[1] = v[i][1] * scale; s[2] = v[i][2] * scale; s[3] = v[i][3] * scale; }
    asm volatile("s_waitcnt lgkmcnt(0)" ::: "memory");
    const int c = lane & 3;
#pragma unroll
    for (int j = 0; j < 4; ++j) { const int n = (lane >> 2) + 16 * j; const LAS float* s = scr + (16 * c) * 65 + n;
        u32x4 o; o.x = pg8::pk4_fp8(s[0 * 65], s[1 * 65], s[2 * 65], s[3 * 65]); o.y = pg8::pk4_fp8(s[4 * 65], s[5 * 65], s[6 * 65], s[7 * 65]);
        o.z = pg8::pk4_fp8(s[8 * 65], s[9 * 65], s[10 * 65], s[11 * 65]); o.w = pg8::pk4_fp8(s[12 * 65], s[13 * 65], s[14 * 65], s[15 * 65]);
        __builtin_nontemporal_store(o, (u32x4*)(dst0 + (size_t)n * ldd + kofs + 16 * c)); }
    asm volatile("s_waitcnt lgkmcnt(0)" ::: "memory");
}
__device__ __forceinline__ void xpose_item_i8(const float* __restrict__ W, int ldw, int k0, int n0, unsigned char* __restrict__ dst0, int ldd, const float* __restrict__ cs, LAS float* scr, int lane) {
    f32x4 v[16];
    const float* src = W + (size_t)(k0 + (lane >> 4)) * ldw + n0 + 4 * (lane & 15);
#pragma unroll
    for (int i = 0; i < 16; ++i) v[i] = __builtin_nontemporal_load((const f32x4*)(src + (size_t)(4 * i) * ldw));
#pragma unroll
    for (int i = 0; i < 16; ++i) { LAS float* s = scr + (4 * i + (lane >> 4)) * 65 + 4 * (lane & 15); s[0] = v[i][0]; s[1] = v[i][1]; s[2] = v[i][2]; s[3] = v[i][3]; }
    asm volatile("s_waitcnt lgkmcnt(0)" ::: "memory");
    const int c = lane & 3;
#pragma unroll
    for (int j = 0; j < 4; ++j) { const int n = (lane >> 2) + 16 * j; const LAS float* s = scr + (16 * c) * 65 + n; const float d = cs[n], q = d > 1e-30f ? 1.0f / d : 0.f;
        unsigned o[4];
#pragma unroll
        for (int g = 0; g < 4; ++g) { int qi[4];
#pragma unroll
            for (int e = 0; e < 4; ++e) qi[e] = (int)rintf(__builtin_amdgcn_fmed3f(s[(4 * g + e) * 65] * q, -127.f, 127.f));
            o[g] = (unsigned)(qi[0] & 255) | ((unsigned)(qi[1] & 255) << 8) | ((unsigned)(qi[2] & 255) << 16) | ((unsigned)(qi[3] & 255) << 24); }
        __builtin_nontemporal_store((u32x4){o[0], o[1], o[2], o[3]}, (u32x4*)(dst0 + (size_t)n * ldd + k0 + 16 * c)); }
    asm volatile("s_waitcnt lgkmcnt(0)" ::: "memory");
}
__device__ __forceinline__ void xpose_mat8(const float* W, int K, int N, unsigned char* dst, bool ilv, int ilv_off, float scale, int item, LAS float* scr, int lane) {
    const int ntn = N >> 6, kb = item / ntn, nb = item - kb * ntn, k0 = kb * 64, n0 = nb * 64;
    const int drow = ilv ? ((n0 >> 7) * 256 + (n0 & 127) + ilv_off) : n0;
    xpose_item8(W, N, k0, n0, dst + ((size_t)((drow >> 8) * (K >> 7) + (k0 >> 7)) * 256 + (drow & 255)) * 128, 128, k0 & 127, scale, scr, lane);
}
__device__ __forceinline__ void xpose_mat(const float* W, int K, int N, bf16* dst, bool ilv, int ilv_off, int item, LAS float* scr, int lane) {
    const int ntn = N >> 6, kb = item / ntn, nb = item - kb * ntn, k0 = kb * 64, n0 = nb * 64;
    const int drow = ilv ? ((n0 >> 7) * 256 + (n0 & 127) + ilv_off) : n0;
    xpose_item(W, N, k0, n0, dst + (size_t)drow * K, K, scr, lane);
}
__device__ __forceinline__ float silu_f(float x) { return x / (1.0f + __expf(-x)); }

__device__ __forceinline__ void mod_strips(ArgsP a, LAS unsigned char* lds, int s0, int s1, int stride) {
    const int tid = hide_tid();
    unsigned char* ws = a->ws;
    LAS float* sc = (LAS float*)lds;
    LAS float* red = (LAS float*)(lds + 24576);
    if (s0 >= s1) return;
    for (int i = tid; i < 3 * D; i += NTHR) { const int v = i >> 11, k = i & 2047; const float x = v < 2 ? a->in[1][v * D + k] : a->in[3][k]; sc[i] = silu_f(x); }
    __syncthreads();
    float* MOD = (float*)(ws + WS_MOD);
    for (int s = s0; s < s1; s += stride) {
        const int l = s / 192, col0 = (s - l * 192) * 64, cg = tid & 15, kg = tid >> 4;
        const float* W = a->in[4] + (size_t)l * D * 12288 + col0 + 4 * cg;
        f32x4 acc0 = {0.f, 0.f, 0.f, 0.f}, acc1 = acc0, acc2 = acc0;
#pragma unroll 16
        for (int kk = 0; kk < 64; ++kk) { const int k = kg + 32 * kk; const f32x4 w = __builtin_nontemporal_load((const f32x4*)(W + (size_t)k * 12288));
            acc0 += w * sc[k]; acc1 += w * sc[2048 + k]; acc2 += w * sc[4096 + k]; }
#pragma unroll
        for (int j = 0; j < 4; ++j) { red[(kg * 3 + 0) * 64 + 4 * cg + j] = acc0[j]; red[(kg * 3 + 1) * 64 + 4 * cg + j] = acc1[j]; red[(kg * 3 + 2) * 64 + 4 * cg + j] = acc2[j]; }
        __syncthreads();
        if (tid < 192) { const int v = tid >> 6, c = tid & 63; float sum = 0.f;
#pragma unroll 8
            for (int g = 0; g < 32; ++g) sum += red[(g * 3 + v) * 64 + c];
            MOD[(l * 3 + v) * 12288 + col0 + c] = sum + a->in[5][l * 12288 + col0 + c]; }
        __syncthreads();
    }
}
constexpr int MOE_STRIPS = 2 * NEXP * (DFFE / 64);
__device__ __forceinline__ void moe_colscale_item(ArgsP a, int s, int lane) {
    unsigned char* ws = a->ws;
    const int ew = s / (DFFE / 64), n0 = (s - ew * (DFFE / 64)) * 64, e = ew >> 1, w = ew & 1;
    const int drow = e * 2 * DFFE + (n0 >> 7) * 256 + (n0 & 127) + w * 128;
    const float* src = a->in[27 + w] + (size_t)e * D * DFFE + (size_t)(32 * (lane >> 4)) * DFFE + n0 + 4 * (lane & 15);
    f32x4 mx = {0.f, 0.f, 0.f, 0.f};
#pragma unroll
    for (int i = 0; i < 16; ++i) { const f32x4 v = *(const f32x4*)(src + (size_t)(128 * i) * DFFE);
        mx[0] = fmaxf(mx[0], fabsf(v[0])); mx[1] = fmaxf(mx[1], fabsf(v[1])); mx[2] = fmaxf(mx[2], fabsf(v[2])); mx[3] = fmaxf(mx[3], fabsf(v[3])); }
#pragma unroll
    for (int j = 0; j < 4; ++j) { mx[j] = fmaxf(mx[j], __shfl_xor(mx[j], 16)); mx[j] = fmaxf(mx[j], __shfl_xor(mx[j], 32)); }
    if (lane < 16) *(f32x4*)((float*)(ws + WS_CSM) + drow + 4 * lane) = mx * (1.9f / 127.0f);
}
constexpr int CV_IN = (D / 64) * (INC / 64), CV_OUT = (D / 64) * (D / 64), CV_F1 = (D / 64) * (DFF / 64), CV_F2 = (DFF / 64) * (D / 64);
constexpr int CVA_N = MOE_STRIPS + CV_OUT, CVB_N = CV_F2 + CV_OUT;
constexpr int I8_STRIPS = 2 * (DFF / 32);
__device__ __forceinline__ void conv_a_item(ArgsP a, int it, LAS float* scr, int lane) {
    unsigned char* ws = a->ws;
    if (it < MOE_STRIPS) { moe_colscale_item(a, it, lane); return; } it -= MOE_STRIPS;
    xpose_mat(a->in[9], D, D, (bf16*)(ws + WS_WOUT), false, 0, it, scr, lane);
}
__device__ __forceinline__ void conv_b_item(ArgsP a, int it, LAS float* scr, int lane) {
    unsigned char* ws = a->ws;
    if (it < CV_F2) { xpose_mat8(a->in[25], DFF, D, ws + WS_WF2, false, 0, pg8::S_W2, it, scr, lane); return; } it -= CV_F2;
    xpose_mat(a->in[9] + (size_t)D * D, D, D, (bf16*)(ws + WS_WOUT) + (size_t)D * D, false, 0, it, scr, lane);
}
constexpr int WIN_STRIPS = INC / 32;
__device__ __forceinline__ void win_strip(ArgsP a, LAS unsigned char* lds, int l, int s);
__device__ __forceinline__ void phase_prologue(ArgsP a, LAS unsigned char* lds) {
    const int tid = hide_tid(), lane = tid & 63, wave = tid >> 6, G = gridDim.x;
    unsigned char* ws = a->ws;
    const int nmod = G > 192 ? 192 : G;
    if ((int)blockIdx.x < nmod) mod_strips(a, lds, (int)blockIdx.x, 192, nmod);
    __syncthreads();
    if (G > nmod) { for (int s = (int)blockIdx.x - nmod; s >= 0 && s < WIN_STRIPS; s += G - nmod) win_strip(a, lds, 0, s); }
    else for (int s = (int)blockIdx.x; s < WIN_STRIPS; s += G) win_strip(a, lds, 0, s);
}
template <bool SAMPLE>
__device__ __forceinline__ void i8_strip_core(const float* __restrict__ W0, int ldw, unsigned char* __restrict__ dst0, float* __restrict__ cs0, LAS unsigned char* lds) {
    const int tid = hide_tid(), lane = tid & 63, wave = tid >> 6;
    LAS float* scr = (LAS float*)(lds + wave * 16640);
    LAS float* cmax = (LAS float*)(lds + 8 * 16640);
    LAS float* csc = cmax + 512;
    const float* src = W0 + (size_t)(lane >> 4) * ldw + 4 * (lane & 15);
    f32x4 mx = {0.f, 0.f, 0.f, 0.f};
    for (int t = 0; t < (SAMPLE ? 1 : 4); ++t) { const int k0 = (wave + 8 * t) * 64;
#pragma unroll
        for (int i = 0; i < 16; ++i) { const f32x4 v = *(const f32x4*)(src + (size_t)(k0 + 4 * i) * ldw);
            mx[0] = fmaxf(mx[0], fabsf(v[0])); mx[1] = fmaxf(mx[1], fabsf(v[1])); mx[2] = fmaxf(mx[2], fabsf(v[2])); mx[3] = fmaxf(mx[3], fabsf(v[3])); } }
#pragma unroll
    for (int j = 0; j < 4; ++j) { mx[j] = fmaxf(mx[j], __shfl_xor(mx[j], 16)); mx[j] = fmaxf(mx[j], __shfl_xor(mx[j], 32)); }
    if (lane < 16) { cmax[wave * 64 + 4 * lane + 0] = mx[0]; cmax[wave * 64 + 4 * lane + 1] = mx[1]; cmax[wave * 64 + 4 * lane + 2] = mx[2]; cmax[wave * 64 + 4 * lane + 3] = mx[3]; }
    __syncthreads();
    if (tid < 64) { float m = 0.f;
#pragma unroll
        for (int q = 0; q < 8; ++q) m = fmaxf(m, cmax[q * 64 + tid]);
        if (SAMPLE) m *= 1.6f;
        csc[tid] = m > 1e-30f ? 127.0f / m : 0.f;
        cs0[tid] = m * (1.0f / 127.0f); }
    __syncthreads();
    f32x4 v[16], vn[16];
#pragma unroll
    for (int i = 0; i < 16; ++i) v[i] = __builtin_nontemporal_load((const f32x4*)(src + (size_t)(wave * 64 + 4 * i) * ldw));
#pragma unroll
    for (int t = 0; t < 4; ++t) { const int k0 = (wave + 8 * t) * 64;
        if (t < 3) {
#pragma unroll
            for (int i = 0; i < 16; ++i) vn[i] = __builtin_nontemporal_load((const f32x4*)(src + (size_t)(k0 + 512 + 4 * i) * ldw)); }
#pragma unroll
        for (int i = 0; i < 16; ++i) { LAS float* p = scr + (4 * i + (lane >> 4)) * 65 + 4 * (lane & 15); p[0] = v[i][0]; p[1] = v[i][1]; p[2] = v[i][2]; p[3] = v[i][3]; }
        asm volatile("s_waitcnt lgkmcnt(0)" ::: "memory");
        const int c = lane & 3;
#pragma unroll
        for (int j = 0; j < 4; ++j) { const int n = (lane >> 2) + 16 * j; const LAS float* p = scr + (16 * c) * 65 + n; const float q = csc[n];
            unsigned o[4];
#pragma unroll
            for (int g = 0; g < 4; ++g) { int qi[4];
#pragma unroll
                for (int e = 0; e < 4; ++e) qi[e] = (int)rintf(__builtin_amdgcn_fmed3f(p[(4 * g + e) * 65] * q, -127.f, 127.f));
                o[g] = (unsigned)(qi[0] & 255) | ((unsigned)(qi[1] & 255) << 8) | ((unsigned)(qi[2] & 255) << 16) | ((unsigned)(qi[3] & 255) << 24); }
            __builtin_nontemporal_store((u32x4){o[0], o[1], o[2], o[3]}, (u32x4*)(dst0 + (size_t)n * D + k0 + 16 * c)); }
        asm volatile("s_waitcnt lgkmcnt(0)" ::: "memory");
        if (t < 3) {
#pragma unroll
            for (int i = 0; i < 16; ++i) v[i] = vn[i]; }
    }
    __syncthreads();
}
__device__ __forceinline__ void i8_strip32(const float* __restrict__ W0, int ldw, unsigned char* __restrict__ dst0, float* __restrict__ cs0, LAS unsigned char* lds) {
    const int tid = hide_tid(), lane = tid & 63, wave = tid >> 6, wq = lane >> 3, wl = lane & 7;
    LAS unsigned* scr = (LAS unsigned*)(lds + wave * 16640);
    LAS float* cmax = (LAS float*)(lds + 8 * 16640);
    const float* src = W0 + (size_t)(wave * 256 + 4 * wq) * ldw + 4 * wl;
    f32x4 v[2][4][4];
#pragma unroll
    for (int t = 0; t < 2; ++t)
#pragma unroll
        for (int i = 0; i < 4; ++i)
#pragma unroll
            for (int r = 0; r < 4; ++r) v[t][i][r] = __builtin_nontemporal_load((const f32x4*)(src + (size_t)(128 * t + 32 * i + r) * ldw));
    f32x4 mx = {0.f, 0.f, 0.f, 0.f};
#pragma unroll
    for (int t = 0; t < 2; ++t)
#pragma unroll
        for (int i = 0; i < 4; ++i)
#pragma unroll
            for (int r = 0; r < 4; ++r)
#pragma unroll
                for (int e = 0; e < 4; ++e) mx[e] = fmaxf(mx[e], fabsf(v[t][i][r][e]));
#pragma unroll
    for (int e = 0; e < 4; ++e) { mx[e] = fmaxf(mx[e], __shfl_xor(mx[e], 8)); mx[e] = fmaxf(mx[e], __shfl_xor(mx[e], 16)); mx[e] = fmaxf(mx[e], __shfl_xor(mx[e], 32)); }
    if (wq == 0) { cmax[wave * 32 + 4 * wl + 0] = mx[0]; cmax[wave * 32 + 4 * wl + 1] = mx[1]; cmax[wave * 32 + 4 * wl + 2] = mx[2]; cmax[wave * 32 + 4 * wl + 3] = mx[3]; }
    __syncthreads();
    f32x4 q;
#pragma unroll
    for (int e = 0; e < 4; ++e) { float m = 0.f;
#pragma unroll
        for (int w = 0; w < 8; ++w) m = fmaxf(m, cmax[w * 32 + 4 * wl + e]);
        q[e] = m > 1e-30f ? 127.0f / m : 0.f;
        if (wave == 0 && wq == 0) cs0[4 * wl + e] = m * (1.0f / 127.0f); }
#pragma unroll
    for (int t = 0; t < 2; ++t) {
#pragma unroll
        for (int i = 0; i < 4; ++i)
#pragma unroll
            for (int e = 0; e < 4; ++e) { unsigned o = 0u;
#pragma unroll
                for (int r = 0; r < 4; ++r) o = __builtin_amdgcn_cvt_pk_u8_f32(__builtin_rintf(__builtin_amdgcn_fmed3f(v[t][i][r][e] * q[e], -127.f, 127.f)) + 128.0f, r, o);
                scr[(4 * wl + e) * 33 + 8 * i + wq] = o ^ 0x80808080u; }
        asm volatile("s_waitcnt lgkmcnt(0)" ::: "memory");
        const int c = lane & 7;
#pragma unroll
        for (int j = 0; j < 4; ++j) { const int n = (lane >> 3) + 8 * j; const LAS unsigned* s = scr + n * 33 + 4 * c;
            __builtin_nontemporal_store((u32x4){s[0], s[1], s[2], s[3]}, (u32x4*)(dst0 + (size_t)n * D + wave * 256 + 128 * t + 16 * c)); }
        asm volatile("s_waitcnt lgkmcnt(0)" ::: "memory");
    }
    __syncthreads();
}
__device__ __forceinline__ void i8_strip(ArgsP a, LAS unsigned char* lds, int s) {
    unsigned char* ws = a->ws;
    const int w = s / (DFF / 32), n0 = (s - w * (DFF / 32)) * 32;
    const int drow = (n0 >> 7) * 256 + (n0 & 127) + w * 128;
    i8_strip32(a->in[23 + w] + n0, DFF, ws + WS_WF13 + (size_t)drow * D, (float*)(ws + WS_CS) + drow, lds);
}
__device__ __forceinline__ void win_strip(ArgsP a, LAS unsigned char* lds, int l, int s) {
    unsigned char* ws = a->ws; const int n0 = s * 32;
    i8_strip32(a->in[8] + (size_t)l * D * INC + n0, INC, ws + WS_WIN + ((size_t)l * INC + n0) * D, (float*)(ws + WS_CSIN) + l * INC + n0, lds);
}
__device__ __forceinline__ void deferred_a(ArgsP a, LAS unsigned char* lds, int e, int nel) {
    const int tid = hide_tid(), lane = tid & 63, wave = tid >> 6;
    const int q = CVA_N / nel, r = CVA_N % nel, count = q + (e < r ? 1 : 0), first = e * q + (e < r ? e : r);
    LAS float* scr = (LAS float*)(lds + wave * 16640);
    for (int i = wave; i < count; i += NWAVES) conv_a_item(a, first + i, scr, lane);
}
constexpr int MOE_I = (D / 64) * (DFFE / 64);
constexpr int G1_STRIPS = 468;
constexpr int M1_G1 = 3432, M1_AT0 = 35988;
constexpr int M1_T2 = 1280, M1_T3 = 800, M1_T4 = 1280, M1_TAILS = M1_T2 + M1_T3 + M1_T4;
constexpr int G1_QUOTA = 17160;
__device__ __forceinline__ void quota(int seg0, int segn, int G, int c, int& first, int& count) { const int q = (segn + G - 1) / G; const int lo = c * q; first = seg0 + lo; count = lo >= segn ? 0 : (segn - lo < q ? segn - lo : q); }
struct MoeTile { const float* src; unsigned char* dst0; const float* cs; int ldw, ldd, k0; };
template <int which>
__device__ __forceinline__ MoeTile moe_tile(ArgsP a, int it, int lane) {
    unsigned char* ws = a->ws; MoeTile t;
    if (which == 0) { const int ew = it / MOE_I, r = it - ew * MOE_I, e = ew >> 1, w = ew & 1;
        const int ntn = DFFE >> 5, kb = r / ntn, nb = r - kb * ntn, k0 = kb * 128, n0 = nb * 32, drow = e * 2 * DFFE + (n0 >> 7) * 256 + (n0 & 127) + w * 128;
        t.ldw = DFFE; t.ldd = D; t.k0 = k0; t.src = a->in[27 + w] + (size_t)e * D * DFFE + (size_t)(k0 + 4 * (lane >> 3)) * DFFE + n0 + 4 * (lane & 7);
        t.dst0 = ws + WS_WM13 + (size_t)drow * D; t.cs = (const float*)(ws + WS_CSM) + drow + 4 * (lane & 7); }
    else { const int e = it / MOE_I, r = it - e * MOE_I, ntn = D >> 5, kb = r / ntn, nb = r - kb * ntn, k0 = kb * 128, n0 = nb * 32;
        t.ldw = D; t.ldd = 128; t.k0 = 0; t.src = a->in[29] + (size_t)e * DFFE * D + (size_t)(k0 + 4 * (lane >> 3)) * D + n0 + 4 * (lane & 7);
        t.dst0 = ws + WS_WM2 + ((size_t)((e * (D >> 8) + (n0 >> 8)) * (DFFE >> 7) + (k0 >> 7)) * 256 + (n0 & 255)) * 128; t.cs = nullptr; }
    return t;
}
template <int which>
__device__ __forceinline__ void moe_convert_t(ArgsP a, LAS unsigned char* lds, int first, int count) {
    const int tid = hide_tid(), lane = tid & 63, wave = tid >> 6;
    LAS unsigned* scr = (LAS unsigned*)(lds + wave * 16640);
    int k = wave; if (k >= count) return;
    MoeTile t0 = moe_tile<which>(a, first + k, lane), t1 = t0, t2 = t0;
    f32x4 v0[4][4], v1[4][4], v2[4][4];
#define MC_LOAD(vv, tt) do { _Pragma("unroll") for (int i = 0; i < 4; ++i) _Pragma("unroll") for (int r = 0; r < 4; ++r) vv[i][r] = __builtin_nontemporal_load((const f32x4*)(tt.src + (size_t)(32 * i + r) * tt.ldw)); } while (0)
    MC_LOAD(v0, t0);
    if (k + NWAVES < count) { t1 = moe_tile<which>(a, first + k + NWAVES, lane); MC_LOAD(v1, t1); }
    for (; k < count; k += NWAVES) {
        if (k + 2 * NWAVES < count) { t2 = moe_tile<which>(a, first + k + 2 * NWAVES, lane); MC_LOAD(v2, t2); }
        f32x4 q = {pg8::S_W2, pg8::S_W2, pg8::S_W2, pg8::S_W2};
        if (which == 0) { const f32x4 d = *(const f32x4*)t0.cs;
#pragma unroll
            for (int e = 0; e < 4; ++e) q[e] = d[e] > 1e-30f ? __builtin_amdgcn_rcpf(d[e]) : 0.f; }
        const int wq = lane >> 3, wl = lane & 7;
#pragma unroll
        for (int i = 0; i < 4; ++i)
#pragma unroll
            for (int e = 0; e < 4; ++e) { unsigned o;
                if (which == 0) { o = 0u;
#pragma unroll
                    for (int r = 0; r < 4; ++r) o = __builtin_amdgcn_cvt_pk_u8_f32(__builtin_rintf(__builtin_amdgcn_fmed3f(v0[i][r][e] * q[e], -127.f, 127.f)) + 128.0f, r, o);
                    o ^= 0x80808080u; }
                else o = pg8::pk4_fp8(v0[i][0][e] * q[e], v0[i][1][e] * q[e], v0[i][2][e] * q[e], v0[i][3][e] * q[e]);
                scr[(4 * wl + e) * 33 + 8 * i + wq] = o; }
        asm volatile("s_waitcnt lgkmcnt(0)" ::: "memory");
        const int c = lane & 7;
#pragma unroll
        for (int j = 0; j < 4; ++j) { const int n = (lane >> 3) + 8 * j; const LAS unsigned* s = scr + n * 33 + 4 * c;
            __builtin_nontemporal_store((u32x4){s[0], s[1], s[2], s[3]}, (u32x4*)(t0.dst0 + (size_t)n * t0.ldd + t0.k0 + 16 * c)); }
        asm volatile("s_waitcnt lgkmcnt(0)" ::: "memory");
        t0 = t1; t1 = t2;
#pragma unroll
        for (int i = 0; i < 4; ++i)
#pragma unroll
            for (int r = 0; r < 4; ++r) { v0[i][r] = v1[i][r]; v1[i][r] = v2[i][r]; }
    }
#undef MC_LOAD
}
__device__ __forceinline__ void moe_convert(ArgsP a, LAS unsigned char* lds, int which, int first, int count) { if (which == 0) moe_convert_t<0>(a, lds, first, count); else moe_convert_t<1>(a, lds, first, count); }
__device__ __forceinline__ void at_convert(ArgsP a, LAS unsigned char* lds, int l) {
    const int G = gridDim.x, c = (int)blockIdx.x; int f, n;
    if (l == 0) {
        mod_strips(a, lds, 192 + c, 384, G);
        __syncthreads();
        { const int NS = I8_STRIPS + WIN_STRIPS, nfree = G > 192 ? G - 192 : 0, hi = 3 * nfree < NS ? 3 * nfree : NS;
          if (c >= 192) { for (int j = 0; j < 3; ++j) { const int s = 3 * (c - 192) + j; if (s < hi) { if (s < I8_STRIPS) i8_strip(a, lds, s); else win_strip(a, lds, 1, s - I8_STRIPS); } } }
          else if (G == 256) {
              for (int k = 0; k < 2; ++k) { const int s = k == 0 ? hi + c : hi + 192 + (c - 80); if (k == 0 || c >= 80) { if (s < I8_STRIPS) i8_strip(a, lds, s); else if (s < NS) win_strip(a, lds, 1, s - I8_STRIPS); } } }
          else { const int nw = G > 192 ? 192 : G; for (int s = hi + c; s < NS; s += nw) { if (s < I8_STRIPS) i8_strip(a, lds, s); else win_strip(a, lds, 1, s - I8_STRIPS); } } }
        { const int tid = hide_tid(), lane = tid & 63, wave = tid >> 6; LAS float* scr = (LAS float*)(lds + wave * 16640);
          quota(0, CVB_N, G, c, f, n); for (int i = wave; i < n; i += NWAVES) conv_b_item(a, f + i, scr, lane); }
        __syncthreads();
        quota(M1_G1, M1_AT0, G, c, f, n); moe_convert(a, lds, 0, f, n);
    } else {
        quota(M1_G1 + M1_AT0, 2 * NEXP * MOE_I - M1_G1 - M1_AT0 - (G == 256 ? M1_TAILS : 0), G, c, f, n); moe_convert(a, lds, 0, f, n);
        __syncthreads();
        quota(0, NEXP * MOE_I, G, c, f, n); moe_convert(a, lds, 1, f, n);
    }
}
__device__ __forceinline__ void quota_bal_hi(int seg0, int n, int G, int c, int& first, int& count) { const int q = n / G, r = n % G, x = c - (G - r); count = q + (x >= 0 ? 1 : 0); first = seg0 + c * q + (x > 0 ? x : 0); }
__device__ __forceinline__ void quota_bal(int seg0, int n, int G, int c, int& first, int& count) { const int q = n / G, r = n % G; count = q + (c < r ? 1 : 0); first = seg0 + c * q + (c < r ? c : r); }

template <int SRC, bool ROUTER, int NSLAB, int OUT  >
__device__ __forceinline__ void phase_norm(ArgsP a, int l, int row_lo, const float* gvec, int ch_sh, int ch_sc, LAS unsigned char* lds = nullptr) {
    const int tid = hide_tid(), lane = tid & 63, wave = tid >> 6, G = gridDim.x;
    unsigned char* ws = a->ws;
    bf16* XW = (bf16*)(ws + WS_XW); bf16* HB = (bf16*)(ws + WS_HB);
    const float* MODL = (const float*)(ws + WS_MOD) + l * 3 * 12288;
    const int lane0 = lane;
    if (ROUTER) {
        LAS f32x4* RT = (LAS f32x4*)lds;
#pragma unroll
        for (int m = 0; m < 8; ++m) { const int id = tid + NTHR * m, ln = id & 63, h = (id >> 6) & 1, j = (id >> 7) & 3, q = id >> 9;
            RT[id] = *(const f32x4*)(a->in[26] + (size_t)(8 * (ln + 64 * j) + q) * NEXP + 4 * h); }
        __syncthreads();
    }
    for (int ridx = row_lo + blockIdx.x * NWAVES + wave; ridx < MROWS; ridx += G * NWAVES) {
        int row = ridx; if (NSLAB > 0) { row = ridx + (MROWS - 1024); if (row >= MROWS) row -= MROWS; }
        int lane = lane0; asm volatile("" : "+v"(lane));
        const bool isctx = row < 2 * LCTX;
        const int v = isctx ? 2 : ((row - 2 * LCTX) >> 12);
        float x[4][8];
        if (SRC == 0 || (SRC == 2 && isctx)) {
            const float* src = isctx ? a->in[2] + (size_t)row * D : a->in[0] + (size_t)(row - 2 * LCTX) * D;
#pragma unroll
            for (int j = 0; j < 4; ++j) { const f32x4 p = *(const f32x4*)(src + 8 * (lane + 64 * j)), q = *(const f32x4*)(src + 8 * (lane + 64 * j) + 4);
#pragma unroll
                for (int e = 0; e < 4; ++e) { x[j][e] = p[e]; x[j][4 + e] = q[e]; } }
        } else {
#pragma unroll
            for (int j = 0; j < 4; ++j) unpack8(*(const u32x4*)(XW + (size_t)row * D + 8 * (lane + 64 * j)), x[j]);
        }
        if (NSLAB > 0 && isctx) {
#pragma unroll
            for (int j = 0; j < 4; ++j) {
                const int c = 8 * (lane + 64 * j);
                const float* sl = (const float*)(ws + WS_SLAB) + (size_t)((((row >> 8) * 8 + (c >> 8)) * NSLAB)) * 65536 + (size_t)(row & 255) * 256 + (c & 255);
                for (int s = 0; s < NSLAB; ++s) { const f32x4 p = *(const f32x4*)(sl + (size_t)s * 65536), q = *(const f32x4*)(sl + (size_t)s * 65536 + 4);
#pragma unroll
                    for (int e = 0; e < 4; ++e) { x[j][e] += p[e]; x[j][4 + e] += q[e]; } }
                *(u32x4*)(XW + (size_t)row * D + c) = pack8(x[j]); }
        }
        float ss = 0.f;
#pragma unroll
        for (int j = 0; j < 4; ++j)
#pragma unroll
            for (int e = 0; e < 8; ++e) ss += x[j][e] * x[j][e];
        ss = wave_sum(ss);
        const float r = __builtin_amdgcn_rsqf(ss * (1.0f / D) + EPS);
        const float* sh = MODL + v * 12288 + ch_sh * 2048; const float* sc = MODL + v * 12288 + ch_sc * 2048;
        float lg[8];
        if (ROUTER) {
#pragma unroll
            for (int e = 0; e < 8; ++e) lg[e] = 0.f;
        }
#pragma unroll
        for (int j = 0; j < 4; ++j) {
            const int c = 8 * (lane + 64 * j);
            float h[8];
#pragma unroll
            for (int hf = 0; hf < 2; ++hf) { const f32x4 g = *(const f32x4*)(gvec + c + 4 * hf), s1 = *(const f32x4*)(sc + c + 4 * hf), s0 = *(const f32x4*)(sh + c + 4 * hf);
#pragma unroll
                for (int e = 0; e < 4; ++e) h[4 * hf + e] = (x[j][4 * hf + e] * r) * g[e] * (s1[e] + 1.0f) + s0[e]; }
            if (OUT == 1) { u32x2 o; o.x = pg8::pk4_fp8(h[0] * pg8::S_H, h[1] * pg8::S_H, h[2] * pg8::S_H, h[3] * pg8::S_H); o.y = pg8::pk4_fp8(h[4] * pg8::S_H, h[5] * pg8::S_H, h[6] * pg8::S_H, h[7] * pg8::S_H);
                *(u32x2*)((unsigned char*)HB + (size_t)row * D + c) = o; }
            else if (OUT == 0) *(u32x4*)(HB + (size_t)row * D + c) = pack8(h);
            if (OUT == 2 || ROUTER) {
#pragma unroll
                for (int e = 0; e < 8; ++e) x[j][e] = h[e]; }
        }
        if (OUT == 2) {
            float am = 0.f;
#pragma unroll
            for (int j = 0; j < 4; ++j)
#pragma unroll
                for (int e = 0; e < 8; ++e) am = fmaxf(am, fabsf(x[j][e]));
#pragma unroll
            for (int o = 1; o < 64; o <<= 1) am = fmaxf(am, __shfl_xor(am, o));
            const float qs = am > 1e-30f ? 127.0f / am : 0.f;
            if (lane == 0) ((float*)(ws + WS_RS))[row] = am * (1.0f / 127.0f);
#pragma unroll
            for (int j = 0; j < 4; ++j) { unsigned w[2];
#pragma unroll
                for (int hf = 0; hf < 2; ++hf) { const int q0 = (int)rintf(x[j][4 * hf + 0] * qs), q1 = (int)rintf(x[j][4 * hf + 1] * qs), q2 = (int)rintf(x[j][4 * hf + 2] * qs), q3 = (int)rintf(x[j][4 * hf + 3] * qs);
                    w[hf] = (unsigned)(q0 & 255) | ((unsigned)(q1 & 255) << 8) | ((unsigned)(q2 & 255) << 16) | ((unsigned)(q3 & 255) << 24); }
                *(u32x2*)((unsigned char*)HB + (size_t)row * D + 8 * (lane + 64 * j)) = (u32x2){w[0], w[1]}; }
        }
        if (ROUTER) {
#pragma unroll
            for (int j = 0; j < 4; ++j) {
                const LAS f32x4* RT = (const LAS f32x4*)lds;
#pragma unroll
                for (int q = 0; q < 8; ++q) { const f32x4 w0 = RT[((q * 4 + j) * 2 + 0) * 64 + lane], w1 = RT[((q * 4 + j) * 2 + 1) * 64 + lane];
                    lg[0] += x[j][q] * w0[0]; lg[1] += x[j][q] * w0[1]; lg[2] += x[j][q] * w0[2]; lg[3] += x[j][q] * w0[3];
                    lg[4] += x[j][q] * w1[0]; lg[5] += x[j][q] * w1[1]; lg[6] += x[j][q] * w1[2]; lg[7] += x[j][q] * w1[3]; }
                asm volatile("" ::: "memory");
            }
        }
        if (ROUTER) {
#pragma unroll
            for (int e = 0; e < 8; ++e) lg[e] = wave_sum(lg[e]);
            int e1 = 0; float v1 = lg[0];
#pragma unroll
            for (int e = 1; e < 8; ++e) if (lg[e] > v1) { v1 = lg[e]; e1 = e; }
            int e2 = -1; float v2 = -3.0e38f;
#pragma unroll
            for (int e = 0; e < 8; ++e) if (e != e1 && lg[e] > v2) { v2 = lg[e]; e2 = e; }
            if (lane == 0) {
                unsigned* cnt = (unsigned*)(ws + WS_CTL) + CW_CNT;
                const int p1 = (int)atomicAdd(cnt + 64 * e1, 1u), p2 = (int)atomicAdd(cnt + 64 * e2, 1u);
                const float g2 = 1.0f / (1.0f + __expf(v1 - v2)), g1 = 1.0f - g2;
                int* tk = (int*)(ws + WS_TOK) + (size_t)(row - 2 * LCTX) * 8;
                tk[0] = e1; tk[1] = e2; tk[2] = p1; tk[3] = p2; ((float*)tk)[4] = g1; ((float*)tk)[5] = g2;
            }
        }
    }
}

__device__ __forceinline__ void rope_angles(int pos, bool latent, int quarter_lane_i0  , bool colhalf, float expo_scale, float (&cs)[8], float (&sn)[8]) {
    const float p = latent ? (float)(colhalf ? (pos & 63) : (pos >> 6)) : 0.f;
#pragma unroll
    for (int e = 0; e < 8; ++e) {
        const float inv = __builtin_amdgcn_exp2f(-(float)(quarter_lane_i0 + e) * expo_scale);
        float rev = p * inv * 0.15915494309189535f; rev -= rintf(rev);
        cs[e] = latent ? __builtin_amdgcn_cosf(rev) : 1.f; sn[e] = latent ? __builtin_amdgcn_sinf(rev) : 0.f;
    }
}
__device__ __forceinline__ void phase_postproj(ArgsP a, int l, LAS unsigned char* lds) {
    const int tid = hide_tid(), lane = tid & 63, wave = tid >> 6, G = gridDim.x;
    unsigned char* ws = a->ws;
    bf16* PROJ = (bf16*)(ws + WS_PROJ); bf16* MIX = (bf16*)(ws + WS_MIX);
    const float LOG2_THETA = 13.287712379549449f;
    float gAq[8], gAk[8], gCq[8], gCk[8], cwv[3][8], gbv[8];
#pragma unroll
    for (int e = 0; e < 8; ++e) { gAq[e] = a->in[10][l * 64 + 8 * (lane & 7) + e]; gAk[e] = a->in[11][l * 64 + 8 * (lane & 7) + e]; gCq[e] = a->in[19][l * 128 + 8 * (lane & 15) + e]; gCk[e] = a->in[20][l * 128 + 8 * (lane & 15) + e];
        cwv[0][e] = a->in[17][l * 3 * 512 + 8 * lane + e]; cwv[1][e] = a->in[17][l * 3 * 512 + 512 + 8 * lane + e]; cwv[2][e] = a->in[17][l * 3 * 512 + 1024 + 8 * lane + e]; gbv[e] = a->in[18][l * 512 + 8 * lane + e]; }
    for (int row = blockIdx.x * NWAVES + wave; row < MROWS; row += G * NWAVES) {
        const bool latent = row >= 2 * LCTX;
        const int pos = latent ? ((row - 2 * LCTX) & (SEQ - 1)) : (row & (LCTX - 1));
        const int seglen = latent ? SEQ : LCTX;
        bf16* pr = PROJ + (size_t)row * INC;
        const u32x4 zero4 = {0u, 0u, 0u, 0u};
        u32x4 wA[2], wC[3], bC0 = zero4, bX0 = zero4, bC1, bX1, bC2 = zero4, bX2 = zero4, bB;
#pragma unroll
        for (int i = 0; i < 2; ++i) wA[i] = *(const u32x4*)(pr + (lane + 64 * i) * 8);
#pragma unroll
        for (int i = 0; i < 3; ++i) { const int chunk = lane + 64 * i; wC[i] = *(const u32x4*)(pr + C_CQ + (chunk < 160 ? chunk : 0) * 8); }
        bC1 = *(const u32x4*)(pr + C_BC + 8 * lane); bX1 = *(const u32x4*)(pr + C_BX + 8 * lane); bB = *(const u32x4*)(pr + C_BB + 8 * lane);
        if (pos > 0) { bC0 = *(const u32x4*)(pr - INC + C_BC + 8 * lane); bX0 = *(const u32x4*)(pr - INC + C_BX + 8 * lane); }
        if (pos < seglen - 1) { bC2 = *(const u32x4*)(pr + INC + C_BC + 8 * lane); bX2 = *(const u32x4*)(pr + INC + C_BX + 8 * lane); }
        {
            const int l8 = lane & 7;
            float cs[8], sn[8];
            rope_angles(pos, latent, 8 * (l8 & 1), l8 >= 4, 2.0f * LOG2_THETA / 32.0f, cs, sn);
            const bool minus = (l8 & 2) == 0;
#pragma unroll
            for (int i = 0; i < 2; ++i) {
                const int chunk = lane + 64 * i, vec = chunk >> 3; const bool isq = vec < 8;
                float f[8]; unpack8(wA[i], f);
                float ss = 0.f;
#pragma unroll
                for (int e = 0; e < 8; ++e) ss += f[e] * f[e];
                ss += __shfl_xor(ss, 1); ss += __shfl_xor(ss, 2); ss += __shfl_xor(ss, 4);
                const float r = __builtin_amdgcn_rsqf(ss * (1.0f / 64.0f) + EPS);
                const float qs = isq ? 0.125f * 1.4426950408889634f : 1.0f;
                float y[8], o[8];
#pragma unroll
                for (int e = 0; e < 8; ++e) y[e] = f[e] * r * (isq ? gAq[e] : gAk[e]);
#pragma unroll
                for (int e = 0; e < 8; ++e) { const float p = __shfl_xor(y[e], 2); o[e] = (y[e] * cs[e] + (minus ? -p : p) * sn[e]) * qs; }
                *(u32x4*)(pr + chunk * 8) = pack8(o);
            }
        }
        {
            const int l16 = lane & 15;
            float cs[8], sn[8];
            rope_angles(pos, latent, 8 * (l16 & 3), l16 >= 8, 2.0f * LOG2_THETA / 64.0f, cs, sn);
            const bool minus = (l16 & 4) == 0;
#pragma unroll
            for (int i = 0; i < 3; ++i) {
                const int chunk = lane + 64 * i; const bool act = chunk < 160; const int vec = chunk >> 4; const bool isq = vec < 8;
                bf16* p8 = pr + C_CQ + (act ? chunk : 0) * 8;
                float f[8]; unpack8(wC[i], f);
                float ss = 0.f;
#pragma unroll
                for (int e = 0; e < 8; ++e) ss += f[e] * f[e];
                ss += __shfl_xor(ss, 1); ss += __shfl_xor(ss, 2); ss += __shfl_xor(ss, 4); ss += __shfl_xor(ss, 8);
                const float r = __builtin_amdgcn_rsqf(ss * (1.0f / 128.0f) + EPS);
                const float qs = isq ? 0.08838834764831845f * 1.4426950408889634f : 1.0f;
                float y[8], o[8];
#pragma unroll
                for (int e = 0; e < 8; ++e) y[e] = f[e] * r * (isq ? gCq[e] : gCk[e]);
#pragma unroll
                for (int e = 0; e < 8; ++e) { const float p = __shfl_xor(y[e], 4); o[e] = (y[e] * cs[e] + (minus ? -p : p) * sn[e]) * qs; }
                if (act) *(u32x4*)p8 = pack8(o);
            }
        }
        {
            const int c0 = 8 * lane;
            float u0[8], u1[8], u2[8], fb[8], t0[8], t1[8];
            unpack8(bC1, t0); unpack8(bX1, t1);
#pragma unroll
            for (int e = 0; e < 8; ++e) u1[e] = t0[e] * t1[e];
            unpack8(bC0, t0); unpack8(bX0, t1);
#pragma unroll
            for (int e = 0; e < 8; ++e) u0[e] = t0[e] * t1[e];
            unpack8(bC2, t0); unpack8(bX2, t1);
#pragma unroll
            for (int e = 0; e < 8; ++e) u2[e] = t0[e] * t1[e];
            unpack8(bB, fb);
            float vv[8], ss = 0.f;
#pragma unroll
            for (int e = 0; e < 8; ++e) { vv[e] = fb[e] * (u0[e] * cwv[0][e] + u1[e] * cwv[1][e] + u2[e] * cwv[2][e]); ss += vv[e] * vv[e]; }
            ss = wave_sum(ss);
            const float r = __builtin_amdgcn_rsqf(ss * (1.0f / 512.0f) + EPS);
#pragma unroll
            for (int e = 0; e < 8; ++e) vv[e] = vv[e] * r * gbv[e];
            *(u32x4*)(MIX + (size_t)row * MIXW + 512 + c0) = pack8(vv);
        }
    }
    __syncthreads();
    {
        LAS unsigned short* tl = (LAS unsigned short*)lds;
        bf16* VTA = (bf16*)(ws + WS_VTA); bf16* VTC = (bf16*)(ws + WS_VTC);
        u32x4 wv[2];
#define VT_LOAD(itx) do { const int _hs = (itx) % 6, _q = (itx) / 6, _jt = _q % 68, _b = _q / 68; const int _col = _hs < 4 ? C_AV + _hs * 128 : C_CV + (_hs - 4) * 128; const int _r0 = rowmap(_b, _jt * 64); \
            _Pragma("unroll") for (int _i = 0; _i < 2; ++_i) { const int _idx = tid + 512 * _i; wv[_i] = *(const u32x4*)(PROJ + (size_t)(_r0 + (_idx >> 4)) * INC + _col + 8 * (_idx & 15)); } } while (0)
        const int it0 = G > 64 ? ((int)blockIdx.x + G - 64) % G : (int)blockIdx.x;
        if (it0 < NB * 68 * 6) VT_LOAD(it0);
        for (int it = it0; it < NB * 68 * 6; it += G) {
            const int hs = it % 6, q = it / 6, jt = q % 68, b = q / 68, j0 = jt * 64;
#pragma unroll
            for (int i = 0; i < 2; ++i) { const int idx = tid + 512 * i, key = idx >> 4, ch = idx & 15;
                *(LAS u32x4*)(tl + key * 136 + 8 * ch) = wv[i]; }
            if (it + G < NB * 68 * 6) VT_LOAD(it + G);
            __syncthreads();
            bf16* dst = hs < 4 ? VTA + (size_t)((b * 4 + hs) * 128) * NKEY : VTC + (size_t)((b * 2 + hs - 4) * 128) * NKEY;
#pragma unroll
            for (int i = 0; i < 2; ++i) { const int idx = tid + 512 * i, dv = idx >> 3, kc = idx & 7;
                unsigned short e[8];
#pragma unroll
                for (int k = 0; k < 8; ++k) { const int q = 8 * kc + k, key = (q & ~12) | ((q & 4) << 1) | ((q & 8) >> 1); e[k] = tl[key * 136 + dv]; }
                u32x4 o; o.x = e[0] | ((unsigned)e[1] << 16); o.y = e[2] | ((unsigned)e[3] << 16); o.z = e[4] | ((unsigned)e[5] << 16); o.w = e[6] | ((unsigned)e[7] << 16);
                *(u32x4*)(dst + (size_t)dv * NKEY + j0 + 8 * kc) = o; }
            __syncthreads();
        }
    }
}

constexpr int KT_STRIDE = 272, VT_STRIDE = 144, KT_BYTES = 64 * KT_STRIDE, VT_BYTES = 128 * VT_STRIDE, ATT_STAGE = KT_BYTES + VT_BYTES;
struct TileSched { int n, nloc, blk0; };
__device__ __forceinline__ int ts_j0(const TileSched& ts, int t) { return t < ts.nloc ? LCTX + (ts.blk0 + (t >> 1)) * 128 + (t & 1) * 64 : (t - ts.nloc) * 64; }

template <int DK, bool WINDOW>
__device__ __forceinline__ void attn_core(LAS unsigned char* lds, const bf16* __restrict__ proj, const bf16* __restrict__ vt, int b, int qrow_wave, int qcol, int ktile_col, int kwave_off, int qpos_wave,
                                          const TileSched ts, f32x16 (&O)[4], float& m_out, float& l_out) {
    const int tid = hide_tid(), lane = tid & 63, r = lane & 31, hh = lane >> 5;
    bf16x8 Qf[DK / 16];
    { const bf16* qp = proj + (size_t)(qrow_wave + r) * INC + qcol + 8 * hh;
#pragma unroll
      for (int ks = 0; ks < DK / 16; ++ks) Qf[ks] = *(const bf16x8*)(qp + 16 * ks); }
#pragma unroll
    for (int blk = 0; blk < 4; ++blk)
#pragma unroll
        for (int i = 0; i < 16; ++i) O[blk][i] = 0.f;
    float m = -__builtin_inff(), lsum = 0.f;
    const int qpos = qpos_wave + r;
    u32x4 kreg[2], vreg[2];
#define kkey (tid >> 4)
#define kch (tid & 15)
#define vdv (tid >> 3)
#define vch (tid & 7)
    LAS unsigned char* const kbuf = lds; LAS unsigned char* const vbuf = lds + 2 * KT_BYTES;
#define ATT_ISSUE_K(t) do { const int _r0 = rowmap(b, ts_j0(ts, (t))); \
        _Pragma("unroll") for (int _i = 0; _i < 2; ++_i) kreg[_i] = *(const u32x4*)(proj + (size_t)(_r0 + kkey + 32 * _i) * INC + ktile_col + 8 * kch); } while (0)
#define ATT_ISSUE_V(t) do { const int _j0 = ts_j0(ts, (t)); \
        _Pragma("unroll") for (int _i = 0; _i < 2; ++_i) vreg[_i] = *(const u32x4*)(vt + (size_t)(vdv + 64 * _i) * NKEY + _j0 + 8 * vch); } while (0)
#define ATT_COMMIT_K(buf) do { LAS unsigned char* _kt = kbuf + (buf) * KT_BYTES; \
        _Pragma("unroll") for (int _i = 0; _i < 2; ++_i) *(LAS u32x4*)(_kt + (kkey + 32 * _i) * KT_STRIDE + kch * 16) = kreg[_i]; } while (0)
#define ATT_COMMIT_V(buf) do { LAS unsigned char* _vl = vbuf + (buf) * VT_BYTES; \
        _Pragma("unroll") for (int _i = 0; _i < 2; ++_i) *(LAS u32x4*)(_vl + (vdv + 64 * _i) * VT_STRIDE + vch * 16) = vreg[_i]; } while (0)
#define ATT_QK(S, buf) do { const LAS unsigned char* _kt = kbuf + (buf) * KT_BYTES; \
        _Pragma("unroll") for (int kb = 0; kb < 2; ++kb) { _Pragma("unroll") for (int i = 0; i < 16; ++i) S[kb][i] = 0.f; \
            _Pragma("unroll") for (int ks = 0; ks < DK / 16; ++ks) { const bf16x8 ka = *(const LAS bf16x8*)(_kt + (32 * kb + r) * KT_STRIDE + (kwave_off + 16 * ks + 8 * hh) * 2); \
                S[kb] = __builtin_amdgcn_mfma_f32_32x32x16_bf16(ka, Qf[ks], S[kb], 0, 0, 0); } } } while (0)
#define ATT_SOFTMAX(S, tt, Pf, alpha) do { \
        if (WINDOW && (tt) < ts.nloc) { const int kpos0 = (ts.blk0 + ((tt) >> 1)) * 128 + ((tt) & 1) * 64; \
            _Pragma("unroll") for (int kb = 0; kb < 2; ++kb) _Pragma("unroll") for (int i = 0; i < 16; ++i) { const int d = kpos0 + 32 * kb + (i & 3) + 8 * (i >> 2) + 4 * hh - qpos; \
                if (d > 128 || d < -128) S[kb][i] = -__builtin_inff(); } } \
        float mx = S[0][0]; \
        _Pragma("unroll") for (int kb = 0; kb < 2; ++kb) _Pragma("unroll") for (int i = 0; i < 16; ++i) mx = fmaxf(mx, S[kb][i]); \
        mx = fmaxf(mx, __shfl_xor(mx, 32)); \
        alpha = 1.0f; \
        if (mx > m + 8.0f) { const float mo = m; m = mx; alpha = __builtin_amdgcn_exp2f(mo - mx); }     \
        const float muse = (m == -__builtin_inff()) ? 0.f : m; \
        float ps = 0.f; \
        _Pragma("unroll") for (int kb = 0; kb < 2; ++kb) _Pragma("unroll") for (int i = 0; i < 16; ++i) { const float p = __builtin_amdgcn_exp2f(S[kb][i] - muse); S[kb][i] = p; ps += p; } \
        lsum = lsum * alpha + ps; \
        _Pragma("unroll") for (int kb = 0; kb < 2; ++kb) _Pragma("unroll") for (int s = 0; s < 2; ++s) { u32x4 w; w.x = pk2(S[kb][8 * s + 0], S[kb][8 * s + 1]); w.y = pk2(S[kb][8 * s + 2], S[kb][8 * s + 3]); \
            w.z = pk2(S[kb][8 * s + 4], S[kb][8 * s + 5]); w.w = pk2(S[kb][8 * s + 6], S[kb][8 * s + 7]); Pf[kb][s] = __builtin_bit_cast(bf16x8, w); } } while (0)
#define ATT_RESCALE(alpha) do { if (__any(alpha != 1.0f)) { _Pragma("unroll") for (int blk = 0; blk < 4; ++blk) _Pragma("unroll") for (int i = 0; i < 16; ++i) O[blk][i] *= alpha; } } while (0)

    ATT_ISSUE_K(0); ATT_ISSUE_V(0);
    { u32x4 k1[2]; const bool h1 = ts.n > 1;
      if (h1) { const int r1 = rowmap(b, ts_j0(ts, 1));
#pragma unroll
          for (int i = 0; i < 2; ++i) k1[i] = *(const u32x4*)(proj + (size_t)(r1 + kkey + 32 * i) * INC + ktile_col + 8 * kch); }
      ATT_COMMIT_K(0); ATT_COMMIT_V(0);
      if (h1) { LAS unsigned char* kt1 = kbuf + KT_BYTES;
#pragma unroll
          for (int i = 0; i < 2; ++i) *(LAS u32x4*)(kt1 + (kkey + 32 * i) * KT_STRIDE + kch * 16) = k1[i]; } }
    __syncthreads();
    bf16x8 Pf[2][2];
    { f32x16 S[2]; float alpha; ATT_QK(S, 0); ATT_SOFTMAX(S, 0, Pf, alpha); (void)alpha; }
    __syncthreads();
    for (int t = 0; t < ts.n; ++t) {
        const bool has1 = t + 1 < ts.n, has2 = t + 2 < ts.n;
        if (has2) ATT_ISSUE_K(t + 2);
        if (has1) ATT_ISSUE_V(t + 1);
        f32x16 S[2];
        if (has1) ATT_QK(S, (t + 1) & 1);
        { const LAS unsigned char* vl = vbuf + (t & 1) * VT_BYTES;
#pragma unroll
          for (int blk = 0; blk < 4; ++blk)
#pragma unroll
            for (int kb = 0; kb < 2; ++kb)
#pragma unroll
                for (int s = 0; s < 2; ++s) { const bf16x8 va = *(const LAS bf16x8*)(vl + (32 * blk + r) * VT_STRIDE + (32 * kb + 16 * s + 8 * hh) * 2);
                    O[blk] = __builtin_amdgcn_mfma_f32_32x32x16_bf16(va, Pf[kb][s], O[blk], 0, 0, 0); } }
        if (has1) { float alpha; ATT_SOFTMAX(S, t + 1, Pf, alpha); ATT_RESCALE(alpha); }
        if (has2) ATT_COMMIT_K(t & 1);
        if (has1) ATT_COMMIT_V((t + 1) & 1);
        __syncthreads();
    }
#undef ATT_ISSUE_K
#undef ATT_ISSUE_V
#undef ATT_COMMIT_K
#undef ATT_COMMIT_V
#undef ATT_QK
#undef ATT_SOFTMAX
#undef ATT_RESCALE
#undef kkey
#undef kch
#undef vdv
#undef vch
    m_out = m; l_out = lsum + __shfl_xor(lsum, 32);
}

__device__ __forceinline__ void phase_attention(ArgsP a, int l, LAS unsigned char* lds, int cv_slot) {
    const int tid = hide_tid(), lane = tid & 63, wave = __builtin_amdgcn_readfirstlane(tid >> 6), G = gridDim.x;
    unsigned char* ws = a->ws;
    const bf16* PROJ = (const bf16*)(ws + WS_PROJ); bf16* MIX = (bf16*)(ws + WS_MIX); float* SSQ = (float*)(ws + WS_SSQ);
    const bf16* VTA = (const bf16*)(ws + WS_VTA); const bf16* VTC = (const bf16*)(ws + WS_VTC);
    const int nctx = (l == 0) ? 16 : 0, total = 512 + 2 * nctx;
    const float lam_init = (l == 0) ? 0.2f : 0.35550906f;
    float lam;
    { const float q1 = a->in[12][l * 64 + lane], k1 = a->in[13][l * 64 + lane], q2 = a->in[14][l * 64 + lane], k2 = a->in[15][l * 64 + lane];
      const float d1 = wave_sum(q1 * k1), d2 = wave_sum(q2 * k2); lam = __expf(d1) - __expf(d2) + lam_init; }
    const int nunits = (int)blockIdx.x < total ? (total - (int)blockIdx.x + G - 1) / G : 0, slotpos = cv_slot < nunits ? cv_slot : nunits;
    for (int st = 0; st <= nunits; ++st) {
        if (st == slotpos) { __syncthreads(); at_convert(a, lds, l); __syncthreads(); }
        if (st == nunits) break;
        const int w = (int)blockIdx.x + st * G;
        const bool isA = (w < 256) || (w >= 512 && w < 512 + nctx);
        const bool isctx = w >= 512;
        if (isA) {
            int b, h, qb;
            if (!isctx) { const int bh = w & 7; b = bh >> 2; h = bh & 3; qb = w >> 3; } else { const int q = w - 512; b = q >> 3; h = (q >> 1) & 3; qb = q & 1; }
            const int comp = wave >> 2, rg = wave & 3;
            const int qrow0 = isctx ? b * LCTX + qb * 128 : 2 * LCTX + b * SEQ + qb * 128;
            TileSched ts; ts.nloc = 0; ts.blk0 = 0; ts.n = isctx ? 4 : 68;
            f32x16 O[4]; float m, ls;
            attn_core<64, false>(lds, PROJ, VTA + (size_t)((b * 4 + h) * 128) * NKEY, b, qrow0 + rg * 32, C_AQ + h * 128 + comp * 64, C_AK + h * 128, comp * 64, 0, ts, O, m, ls);
            const float inv = 1.0f / ls;
            const int lz = hide_tid() & 63, r = lz & 31, hh = lz >> 5, lane = lz;
            LAS float* ex = (LAS float*)lds;
            if (comp == 1) {
#pragma unroll
                for (int blk = 0; blk < 4; ++blk)
#pragma unroll
                    for (int i = 0; i < 16; ++i) ex[(rg * 64 + blk * 16 + i) * 64 + lane] = O[blk][i] * inv;
            }
            __syncthreads();
            if (comp == 0) {
                float ss = 0.f;
#pragma unroll
                for (int blk = 0; blk < 4; ++blk)
#pragma unroll
                    for (int i = 0; i < 16; ++i) { const float o = O[blk][i] * inv - lam * ex[(rg * 64 + blk * 16 + i) * 64 + lane]; O[blk][i] = o; ss += o * o; }
                ss += __shfl_xor(ss, 32);
                const float rn = __builtin_amdgcn_rsqf(ss * (1.0f / 128.0f) + EPS) * (1.0f - lam_init);
                const float* sg = a->in[16] + l * 128;
                bf16* orow = MIX + (size_t)(qrow0 + rg * 32 + r) * MIXW + h * 128;
#pragma unroll
                for (int blk = 0; blk < 4; ++blk)
#pragma unroll
                    for (int g4 = 0; g4 < 4; ++g4) { const int dv = 32 * blk + 8 * g4 + 4 * hh; const f32x4 gg = *(const f32x4*)(sg + dv);
                        u32x2 o; o.x = pk2(O[blk][4 * g4 + 0] * rn * gg[0], O[blk][4 * g4 + 1] * rn * gg[1]); o.y = pk2(O[blk][4 * g4 + 2] * rn * gg[2], O[blk][4 * g4 + 3] * rn * gg[3]);
                        *(u32x2*)(orow + dv) = o; }
            }
            __syncthreads();
        } else {
            int b, kvh, hp, qb;
            if (!isctx) { const int q = w - 256, cb = q & 7; b = cb >> 2; kvh = (cb >> 1) & 1; hp = cb & 1; qb = q >> 3; }
            else { const int q = w - 512 - nctx; b = q >> 3; kvh = (q >> 2) & 1; hp = (q >> 1) & 1; qb = q & 1; }
            const int head = kvh * 4 + hp * 2 + (wave >> 2), rg = wave & 3;
            const int qrow0 = isctx ? b * LCTX + qb * 128 : 2 * LCTX + b * SEQ + qb * 128;
            TileSched ts;
            if (isctx) { ts.nloc = 0; ts.blk0 = 0; ts.n = 4; }
            else { const int lo = qb > 0 ? qb - 1 : 0, hi = qb < 31 ? qb + 1 : 31; ts.blk0 = lo; ts.nloc = 2 * (hi - lo + 1); ts.n = ts.nloc + 4; }
            f32x16 O[4]; float m, ls;
            attn_core<128, true>(lds, PROJ, VTC + (size_t)((b * 2 + kvh) * 128) * NKEY, b, qrow0 + rg * 32, C_CQ + head * 128, C_CK + kvh * 128, 0, qb * 128 + rg * 32, ts, O, m, ls);
            const int lz = hide_tid() & 63, r = lz & 31, hh = lz >> 5;
            const float sink = a->in[21][l * 8 + head] * 1.4426950408889634f;
            const float inv = 1.0f / (ls + __builtin_amdgcn_exp2f(sink - m));
            float ss = 0.f;
            bf16* orow = MIX + (size_t)(qrow0 + rg * 32 + r) * MIXW + 1024 + head * 128;
#pragma unroll
            for (int blk = 0; blk < 4; ++blk)
#pragma unroll
                for (int g4 = 0; g4 < 4; ++g4) { const int dv = 32 * blk + 8 * g4 + 4 * hh;
                    const float o0 = O[blk][4 * g4 + 0] * inv, o1 = O[blk][4 * g4 + 1] * inv, o2 = O[blk][4 * g4 + 2] * inv, o3 = O[blk][4 * g4 + 3] * inv;
                    ss += o0 * o0 + o1 * o1 + o2 * o2 + o3 * o3;
                    const f32x4 gc = *(const f32x4*)(a->in[22] + l * 1024 + head * 128 + dv);
                    u32x2 o; o.x = pk2(o0 * gc[0], o1 * gc[1]); o.y = pk2(o2 * gc[2], o3 * gc[3]); *(u32x2*)(orow + dv) = o; }
            ss += __shfl_xor(ss, 32);
            if (hh == 0) SSQ[(size_t)(qrow0 + rg * 32 + r) * 8 + head] = ss;
        }
    }
}

__device__ __forceinline__ void phase_normc(ArgsP a, int l) {
    const int tid = hide_tid(), lane = tid & 63, wave = tid >> 6, G = gridDim.x;
    unsigned char* ws = a->ws; bf16* MIX = (bf16*)(ws + WS_MIX); const float* SSQ = (const float*)(ws + WS_SSQ);
    const int row_lo = (l == 0) ? 0 : 2 * LCTX;
    for (int row = row_lo + blockIdx.x * NWAVES + wave; row < MROWS; row += G * NWAVES) {
        const f32x4 s0 = *(const f32x4*)(SSQ + (size_t)row * 8), s1 = *(const f32x4*)(SSQ + (size_t)row * 8 + 4);
        const float ss = (s0[0] + s0[1]) + (s0[2] + s0[3]) + (s1[0] + s1[1]) + (s1[2] + s1[3]);
        const float rn = __builtin_amdgcn_rsqf(ss * (1.0f / 1024.0f) + EPS);
#pragma unroll
        for (int i = 0; i < 2; ++i) { const int c = 8 * (lane + 64 * i); bf16* p = MIX + (size_t)row * MIXW + 1024 + c;
            float f[8]; unpack8(*(const u32x4*)p, f); const float* g = a->in[22] + l * 1024 + c;
#pragma unroll
            for (int e = 0; e < 8; ++e) f[e] = f[e] * rn * g[e];
            *(u32x4*)p = pack8(f); }
    }
}

__device__ __forceinline__ int moe_offsets(const unsigned* cnt, int (&off)[NEXP], int (&cn)[NEXP]) {
    int o = 0;
#pragma unroll
    for (int e = 0; e < NEXP; ++e) { cn[e] = (int)cnt[64 * e]; off[e] = o; o += (cn[e] + 255) & ~255; }
    return o >> 8;
}
__device__ __forceinline__ void phase_gather(ArgsP a) {
    const int tid = hide_tid(), lane = tid & 63, wave = tid >> 6, G = gridDim.x;
    unsigned char* ws = a->ws;
    const unsigned* cnt = (const unsigned*)(ws + WS_CTL) + CW_CNT;
    int off[NEXP], cn[NEXP]; const int npan = moe_offsets(cnt, off, cn);
    if (blockIdx.x == 0 && tid == 0) { int* pe = (int*)(ws + WS_CTL) + CW_PEXP; pe[96] = npan;
#pragma unroll
        for (int e = 0; e < NEXP; ++e) { const int p0 = off[e] >> 8, np = (cn[e] + 255) >> 8; for (int p = 0; p < np; ++p) pe[p0 + p] = e; } }
    if (blockIdx.x == 0) { int NF, R, SK; pg8::moe_tail_params(npan, D / 256, G, NF, R, SK); pg8::StaticOrder so; so.init(npan, D / 256, G, 0, DFFE / 128);
        if (tid < R) { pg8::Unit u; so.map(NF + tid, u); ((int*)(ws + WS_CTL) + CW_TMODE)[u.pm * 8 + u.pn] = tid + 1; } }
    const unsigned char* HB = ws + WS_HB; unsigned char* HP = ws + WS_HPERM;
    const int gw = blockIdx.x * NWAVES + wave, NGW = G * NWAVES;
    for (int t = gw; t < NB * SEQ; t += NGW) {
        int* tk = (int*)(ws + WS_TOK) + (size_t)t * 8;
        const int e1 = tk[0], e2 = tk[1], p1 = tk[2], p2 = tk[3];
        int s1 = 0, s2 = 0;
#pragma unroll
        for (int e = 0; e < NEXP; ++e) { if (e == e1) s1 = off[e] + p1; if (e == e2) s2 = off[e] + p2; }
        if (lane == 0) { tk[6] = s1; tk[7] = s2; const float rs = ((const float*)(ws + WS_RS))[2 * LCTX + t]; ((float*)(ws + WS_RSS))[s1] = rs; ((float*)(ws + WS_RSS))[s2] = rs; }
        const u32x4* src = (const u32x4*)(HB + (size_t)(2 * LCTX + t) * D);
        u32x4* d1 = (u32x4*)(HP + (size_t)s1 * D); u32x4* d2 = (u32x4*)(HP + (size_t)s2 * D);
#pragma unroll
        for (int i = 0; i < 2; ++i) { const u32x4 v = src[lane + 64 * i]; d1[lane + 64 * i] = v; d2[lane + 64 * i] = v; }
    }
#pragma unroll
    for (int e = 0; e < NEXP; ++e) { const int npad = ((cn[e] + 255) & ~255) - cn[e];
        for (int p = gw; p < npad; p += NGW) { u32x4* d = (u32x4*)(HP + (size_t)(off[e] + cn[e] + p) * D);
#pragma unroll
            for (int i = 0; i < 2; ++i) d[lane + 64 * i] = (u32x4){0u, 0u, 0u, 0u};
            if (lane == 0) ((float*)(ws + WS_RSS))[off[e] + cn[e] + p] = 0.f; } }
}
__device__ __forceinline__ void slab_sum(const float* slab, int mode, int SK, int slot, int c, float (&y)[8]) {
#pragma unroll
    for (int e = 0; e < 8; ++e) y[e] = 0.f;
    for (int s = 0; s < SK; ++s) { const float* p = slab + (size_t)((mode - 1) * SK + s) * 65536 + (slot & 255) * 256 + (c & 255);
        const f32x4 a0 = *(const f32x4*)p, a1 = *(const f32x4*)(p + 4);
#pragma unroll
        for (int e = 0; e < 4; ++e) { y[e] += a0[e]; y[4 + e] += a1[e]; } }
}
__device__ __forceinline__ void phase_combine(ArgsP a, int l) {
    const int tid = hide_tid(), lane = tid & 63, wave = tid >> 6, G = gridDim.x;
    unsigned char* ws = a->ws;
    const bf16* XW = (const bf16*)(ws + WS_XW); const bf16* YS = (const bf16*)(ws + WS_YS); const float* slab = (const float*)(ws + WS_SLAB);
    const float* MODL = (const float*)(ws + WS_MOD) + l * 3 * 12288;
    const int* tmode = (const int*)(ws + WS_CTL) + CW_TMODE;
    int NF, R, SK; pg8::moe_tail_params(((const int*)(ws + WS_CTL) + CW_PEXP)[96], D / 256, G, NF, R, SK);
    for (int t = blockIdx.x * NWAVES + wave; t < NB * SEQ; t += G * NWAVES) {
        const int* tk = (const int*)(ws + WS_TOK) + (size_t)t * 8;
        const float g1 = ((const float*)tk)[4], g2 = ((const float*)tk)[5]; const int s1 = tk[6], s2 = tk[7];
        const float* gf = MODL + (t >> 12) * 12288 + 5 * 2048;
        const bf16* xr = XW + (size_t)(2 * LCTX + t) * D; float* orow = a->out + (size_t)t * D;
        int m1[4], m2[4];
#pragma unroll
        for (int i = 0; i < 4; ++i) { const int ct = (lane + 64 * i) >> 5; m1[i] = tmode[(s1 >> 8) * 8 + ct]; m2[i] = tmode[(s2 >> 8) * 8 + ct]; }
        u32x4 w1[4], w2[4], wx[4]; f32x4 ga[4], gb[4];
#pragma unroll
        for (int i = 0; i < 4; ++i) { const int c = 8 * (lane + 64 * i);
            w1[i] = (u32x4){0u, 0u, 0u, 0u}; w2[i] = (u32x4){0u, 0u, 0u, 0u};
            if (m1[i] == 0) w1[i] = *(const u32x4*)(YS + (size_t)s1 * D + c);
            if (m2[i] == 0) w2[i] = *(const u32x4*)(YS + (size_t)s2 * D + c);
            wx[i] = *(const u32x4*)(xr + c); ga[i] = *(const f32x4*)(gf + c); gb[i] = *(const f32x4*)(gf + c + 4); }
#pragma unroll
        for (int i = 0; i < 4; ++i) { const int c = 8 * (lane + 64 * i);
            float y1[8], y2[8], xv[8];
            if (m1[i] == 0) unpack8(w1[i], y1); else slab_sum(slab, m1[i], SK, s1, c, y1);
            if (m2[i] == 0) unpack8(w2[i], y2); else slab_sum(slab, m2[i], SK, s2, c, y2);
            unpack8(wx[i], xv);
            f32x4 o0, o1;
#pragma unroll
            for (int e = 0; e < 4; ++e) { o0[e] = xv[e] + ga[i][e] * (g1 * y1[e] + g2 * y2[e]); o1[e] = xv[4 + e] + gb[i][e] * (g1 * y1[4 + e] + g2 * y2[4 + e]); }
            *(f32x4*)(orow + c) = o0; *(f32x4*)(orow + c + 4) = o1; }
    }
}

constexpr int NPHASE = 21;
__global__ void __launch_bounds__(NTHR, 2) mk_fwd(Args args) {
    extern __shared__ __attribute__((aligned(16))) unsigned char lds_raw[];
    LAS unsigned char* lds = (LAS unsigned char*)lds_raw;
    volatile LAS unsigned* MISC = (volatile LAS unsigned*)(lds + MISC_OFF);
    const int tid = threadIdx.x, G = gridDim.x;
    ArgsP ap = (ArgsP)__builtin_amdgcn_kernarg_segment_ptr();
    unsigned char* ws = ap->ws;
    unsigned* ctl = (unsigned*)(ws + WS_CTL);
    if (tid < 64) MISC[tid] = 0u;
    __syncthreads();
    const int lo = ap->ph_lo, hi = ap->ph_hi;
    XcdBarrier bar; bar.bar = ctl + CW_BAR; bar.x = 0; bar.st = nullptr;
    if (hi - lo > 1) bar = xcd_barrier_post(ctl + CW_BAR, MISC + 8);
#define IN(k) (lo <= (k) && (k) < hi)
#define SEAM(k) do { if (IN(k) && IN((k) + 1)) xcd_barrier(bar); } while (0)
    const float* MOD = (const float*)(ws + WS_MOD);
    bf16* HB = (bf16*)(ws + WS_HB); bf16* PROJ = (bf16*)(ws + WS_PROJ); bf16* MIX = (bf16*)(ws + WS_MIX); bf16* XW = (bf16*)(ws + WS_XW);
    bf16* ACT = (bf16*)(ws + WS_ACT);

    if (IN(0)) phase_prologue(ap, lds);
    SEAM(0);
    { constexpr int l = 0;
        const int pb = (l == 0) ? 1 : 10;
        if (IN(pb + 0)) { if (l == 0) phase_norm<0, false, 0, 2>(ap, 0, 0, ap->in[6], 0, 1); else phase_norm<1, false, 11, 2>(ap, 1, 0, ap->in[6] + D, 0, 1); }
        SEAM(pb + 0);
        if (IN(pb + 1)) { pg8::Gemm g{HB, (const bf16*)(ws + WS_WIN + (size_t)l * INC * D), D / 2}; pg8::RangeOrder<pg8::StaticOrder> S; S.so.init(MROWS / 256, INC / 256, G, (int)blockIdx.x, D / 128);
            pg8::EpiStoreI8 E{PROJ, INC, (const float*)(ws + WS_RS), (const float*)(ws + WS_CSIN) + l * INC};
            S.i0 = 0; S.n = 1 << 30; pg8::gemm_phase<2>(lds, g, S, E);
            { const int rem = S.so.nwg % G; const bool all = rem == 0; const int nel = all ? G : G - rem, e = all ? (int)blockIdx.x : (int)blockIdx.x - rem;
              __syncthreads();
              if (e >= 0) { if (l == 0) deferred_a(ap, lds, e, nel); else { int f, n; quota(0, M1_G1, nel, e, f, n); moe_convert(ap, lds, 0, f, n); } } } }
        SEAM(pb + 1);
        if (IN(pb + 2)) phase_postproj(ap, l, lds);
        SEAM(pb + 2);
        if (IN(pb + 3)) { phase_attention(ap, l, lds, ((int)blockIdx.x >> 3) % 3); __syncthreads(); }
        SEAM(pb + 3);
        if (IN(pb + 5)) { pg8::Gemm g{MIX, (const bf16*)(ws + WS_WOUT) + (size_t)l * D * D, MIXW};
            pg8::EpiResidT<l == 0, true> E{XW, MOD + l * 3 * 12288, 2, (float*)(ws + WS_SLAB), 1.0f};
            pg8::CtxTailOrder S; S.so.init(32, D / 256, G, (int)blockIdx.x, MIXW / 64); S.SK = (l == 0) ? 8 : 0; S.two = 1;
            pg8::gemm_phase<0>(lds, g, S, E);
            if (l == 0 && G == 256 && (int)blockIdx.x >= 128) { int f, n; __syncthreads(); quota(2 * NEXP * MOE_I - M1_TAILS, M1_T2, 128, (int)blockIdx.x - 128, f, n); moe_convert(ap, lds, 0, f, n); } }
        SEAM(pb + 5);
        if (IN(pb + 6)) { if (l == 0) phase_norm<2, false, 8, 2>(ap, 0, 0, ap->in[7], 3, 4); else phase_norm<1, true, 0, 2>(ap, 1, 2 * LCTX, ap->in[7] + D, 3, 4, lds); }
        SEAM(pb + 6);
        if (l == 0) {
            if (IN(8)) { pg8::Gemm g{HB, (const bf16*)(ws + WS_WF13), D / 2}; pg8::RangeOrder<pg8::StaticOrder> S; S.so.init(MROWS / 256, 2 * DFF / 256, G, (int)blockIdx.x, D / 128);
                pg8::EpiSwigluI8 E{(unsigned char*)ACT, -(DFF / 128), (const float*)(ws + WS_RS), (const float*)(ws + WS_CS)};
                S.i0 = 0; S.n = 1 << 30; pg8::gemm_phase<2>(lds, g, S, E);
                if (G == 256 && (int)blockIdx.x >= 216) { int f, n; __syncthreads(); quota(2 * NEXP * MOE_I - M1_TAILS + M1_T2, M1_T3, 40, (int)blockIdx.x - 216, f, n); moe_convert(ap, lds, 0, f, n); } }
            SEAM(8);
            if (IN(9)) { pg8::Gemm g{ACT, (const bf16*)(ws + WS_WF2), DFF / 2}; pg8::CtxTailOrder S; S.so.init(32, D / 256, G, (int)blockIdx.x, DFF / 128); S.SK = 11; S.two = 0;
                pg8::EpiResidT<false, false> E{XW, MOD, 5, (float*)(ws + WS_SLAB), pg8::DS2}; pg8::gemm_phase<1, pg8::EpiResidT<false, false>, pg8::CtxTailOrder, true>(lds, g, S, E);
                if (G == 256 && (int)blockIdx.x >= 176) { int f, n; __syncthreads(); quota(2 * NEXP * MOE_I - M1_TAILS + M1_T2 + M1_T3, M1_T4, 80, (int)blockIdx.x - 176, f, n); moe_convert(ap, lds, 0, f, n); } }
            SEAM(9);
        } else {
            if (IN(17)) phase_gather(ap);
            SEAM(17);
            const int* pexp = (const int*)ctl + CW_PEXP;
            if (IN(18)) { const int npan = __builtin_amdgcn_readfirstlane(pexp[96]);
                pg8::Gemm g{(const bf16*)(ws + WS_HPERM), (const bf16*)(ws + WS_WM13), D / 2}; pg8::RangeOrder<pg8::MoeOrder> S; S.so.so.init(npan, 2 * DFFE / 256, G, (int)blockIdx.x, D / 128); S.so.pexp = pexp;
                pg8::EpiSwigluI8 E{(unsigned char*)ACT, -(DFFE / 128), (const float*)(ws + WS_RSS), (const float*)(ws + WS_CSM)};
                S.i0 = 0; S.n = 1 << 30; pg8::gemm_phase<2>(lds, g, S, E); }
            SEAM(18);
            if (IN(19)) { const int npan = __builtin_amdgcn_readfirstlane(pexp[96]);
                pg8::Gemm g{ACT, (const bf16*)(ws + WS_WM2), DFFE / 2}; pg8::MoeTailOrder S; S.so.init(npan, D / 256, G, (int)blockIdx.x, DFFE / 128); S.pexp = pexp; pg8::moe_tail_params(npan, D / 256, G, S.NF, S.R, S.SK);
                pg8::EpiStoreBf16T<false> E{(bf16*)(ws + WS_YS), D, (float*)(ws + WS_SLAB), pg8::DS2}; pg8::gemm_phase<1, pg8::EpiStoreBf16T<false>, pg8::MoeTailOrder, true>(lds, g, S, E); }
            SEAM(19);
            if (IN(20)) phase_combine(ap, 1);
        }
    }
    { constexpr int l = 1;
        const int pb = (l == 0) ? 1 : 10;
        if (IN(pb + 0)) { if (l == 0) phase_norm<0, false, 0, 2>(ap, 0, 0, ap->in[6], 0, 1); else phase_norm<1, false, 11, 2>(ap, 1, 0, ap->in[6] + D, 0, 1); }
        SEAM(pb + 0);
        if (IN(pb + 1)) { pg8::Gemm g{HB, (const bf16*)(ws + WS_WIN + (size_t)l * INC * D), D / 2}; pg8::RangeOrder<pg8::StaticOrder> S; S.so.init(MROWS / 256, INC / 256, G, (int)blockIdx.x, D / 128);
            pg8::EpiStoreI8 E{PROJ, INC, (const float*)(ws + WS_RS), (const float*)(ws + WS_CSIN) + l * INC};
            S.i0 = 0; S.n = 1 << 30; pg8::gemm_phase<2>(lds, g, S, E);
            { const int rem = S.so.nwg % G; const bool all = rem == 0; const int nel = all ? G : G - rem, e = all ? (int)blockIdx.x : (int)blockIdx.x - rem;
              __syncthreads();
              if (e >= 0) { if (l == 0) deferred_a(ap, lds, e, nel); else { int f, n; quota(0, M1_G1, nel, e, f, n); moe_convert(ap, lds, 0, f, n); } } } }
        SEAM(pb + 1);
        if (IN(pb + 2)) phase_postproj(ap, l, lds);
        SEAM(pb + 2);
        if (IN(pb + 3)) { phase_attention(ap, l, lds, ((int)blockIdx.x >> 3) % 3); __syncthreads(); }
        SEAM(pb + 3);
        if (IN(pb + 5)) { pg8::Gemm g{MIX, (const bf16*)(ws + WS_WOUT) + (size_t)l * D * D, MIXW};
            pg8::EpiResidT<l == 0, true> E{XW, MOD + l * 3 * 12288, 2, (float*)(ws + WS_SLAB), 1.0f};
            pg8::CtxTailOrder S; S.so.init(32, D / 256, G, (int)blockIdx.x, MIXW / 64); S.SK = (l == 0) ? 8 : 0; S.two = 1;
            pg8::gemm_phase<0>(lds, g, S, E);
            if (l == 0 && G == 256 && (int)blockIdx.x >= 128) { int f, n; __syncthreads(); quota(2 * NEXP * MOE_I - M1_TAILS, M1_T2, 128, (int)blockIdx.x - 128, f, n); moe_convert(ap, lds, 0, f, n); } }
        SEAM(pb + 5);
        if (IN(pb + 6)) { if (l == 0) phase_norm<2, false, 8, 2>(ap, 0, 0, ap->in[7], 3, 4); else phase_norm<1, true, 0, 2>(ap, 1, 2 * LCTX, ap->in[7] + D, 3, 4, lds); }
        SEAM(pb + 6);
        if (l == 0) {
            if (IN(8)) { pg8::Gemm g{HB, (const bf16*)(ws + WS_WF13), D / 2}; pg8::RangeOrder<pg8::StaticOrder> S; S.so.init(MROWS / 256, 2 * DFF / 256, G, (int)blockIdx.x, D / 128);
                pg8::EpiSwigluI8 E{(unsigned char*)ACT, -(DFF / 128), (const float*)(ws + WS_RS), (const float*)(ws + WS_CS)};
                S.i0 = 0; S.n = 1 << 30; pg8::gemm_phase<2>(lds, g, S, E);
                if (G == 256 && (int)blockIdx.x >= 216) { int f, n; __syncthreads(); quota(2 * NEXP * MOE_I - M1_TAILS + M1_T2, M1_T3, 40, (int)blockIdx.x - 216, f, n); moe_convert(ap, lds, 0, f, n); } }
            SEAM(8);
            if (IN(9)) { pg8::Gemm g{ACT, (const bf16*)(ws + WS_WF2), DFF / 2}; pg8::CtxTailOrder S; S.so.init(32, D / 256, G, (int)blockIdx.x, DFF / 128); S.SK = 11; S.two = 0;
                pg8::EpiResidT<false, false> E{XW, MOD, 5, (float*)(ws + WS_SLAB), pg8::DS2}; pg8::gemm_phase<1, pg8::EpiResidT<false, false>, pg8::CtxTailOrder, true>(lds, g, S, E);
                if (G == 256 && (int)blockIdx.x >= 176) { int f, n; __syncthreads(); quota(2 * NEXP * MOE_I - M1_TAILS + M1_T2 + M1_T3, M1_T4, 80, (int)blockIdx.x - 176, f, n); moe_convert(ap, lds, 0, f, n); } }
            SEAM(9);
        } else {
            if (IN(17)) phase_gather(ap);
            SEAM(17);
            const int* pexp = (const int*)ctl + CW_PEXP;
            if (IN(18)) { const int npan = __builtin_amdgcn_readfirstlane(pexp[96]);
                pg8::Gemm g{(const bf16*)(ws + WS_HPERM), (const bf16*)(ws + WS_WM13), D / 2}; pg8::RangeOrder<pg8::MoeOrder> S; S.so.so.init(npan, 2 * DFFE / 256, G, (int)blockIdx.x, D / 128); S.so.pexp = pexp;
                pg8::EpiSwigluI8 E{(unsigned char*)ACT, -(DFFE / 128), (const float*)(ws + WS_RSS), (const float*)(ws + WS_CSM)};
                S.i0 = 0; S.n = 1 << 30; pg8::gemm_phase<2>(lds, g, S, E); }
            SEAM(18);
            if (IN(19)) { const int npan = __builtin_amdgcn_readfirstlane(pexp[96]);
                pg8::Gemm g{ACT, (const bf16*)(ws + WS_WM2), DFFE / 2}; pg8::MoeTailOrder S; S.so.init(npan, D / 256, G, (int)blockIdx.x, DFFE / 128); S.pexp = pexp; pg8::moe_tail_params(npan, D / 256, G, S.NF, S.R, S.SK);
                pg8::EpiStoreBf16T<false> E{(bf16*)(ws + WS_YS), D, (float*)(ws + WS_SLAB), pg8::DS2}; pg8::gemm_phase<1, pg8::EpiStoreBf16T<false>, pg8::MoeTailOrder, true>(lds, g, S, E); }
            SEAM(19);
            if (IN(20)) phase_combine(ap, 1);
        }
    }
#undef IN
#undef SEAM
}

extern "C" void kernel_launch(void* const* d_in, const int* in_sizes, int n_in, void* d_out, int out_size, void* d_ws, size_t ws_size, hipStream_t stream) {
    static int grid = 0;
    if (grid == 0) {
        if (n_in != 30 || out_size != NB * SEQ * D || ws_size < WS_END) { fprintf(stderr, "kernel_launch: unexpected shapes (n_in %d out %d ws %zu need %zu)\n", n_in, out_size, ws_size, (size_t)WS_END); grid = -1; return; }
        int dev = 0, cus = 0, per_cu = 0;
        if (hipGetDevice(&dev) != hipSuccess || hipDeviceGetAttribute(&cus, hipDeviceAttributeMultiprocessorCount, dev) != hipSuccess) { grid = -1; return; }
        if (hipFuncSetAttribute((const void*)mk_fwd, hipFuncAttributeMaxDynamicSharedMemorySize, LDS_BYTES) != hipSuccess) { fprintf(stderr, "kernel_launch: hipFuncSetAttribute failed\n"); grid = -1; return; }
        if (hipOccupancyMaxActiveBlocksPerMultiprocessor(&per_cu, (const void*)mk_fwd, NTHR, LDS_BYTES) != hipSuccess || per_cu < 1) { fprintf(stderr, "kernel_launch: occupancy query says %d\n", per_cu); grid = -1; return; }
        (void)hipGetLastError();
        grid = cus;
    }
    if (grid < 0) return;
    (void)hipMemsetAsync((char*)d_ws + WS_CTL, 0, CTL_ZERO_BYTES, stream);
    Args a{};
    for (int i = 0; i < 30; ++i) a.in[i] = (const float*)d_in[i];
    a.out = (float*)d_out; a.ws = (unsigned char*)d_ws;
#if MK_N_LAUNCHES == 1
    a.ph_lo = 0; a.ph_hi = NPHASE;
    hipLaunchKernelGGL(mk_fwd, dim3(grid), dim3(NTHR), LDS_BYTES, stream, a);
#else
    for (int p = 0; p < NPHASE; ++p) { a.ph_lo = p; a.ph_hi = p + 1; hipLaunchKernelGGL(mk_fwd, dim3(grid), dim3(NTHR), LDS_BYTES, stream, a); }
#endif
}
```

```cpp
#include <hip/hip_runtime.h>
#include <cstdio>
#include <cstdint>

#ifndef MK_N_LAUNCHES
#define MK_N_LAUNCHES 1
#endif

#define GAS __attribute__((address_space(1)))
#define LAS __attribute__((address_space(3)))
typedef unsigned short bf16;
typedef short bf16x8 __attribute__((ext_vector_type(8)));
typedef float f32x4 __attribute__((ext_vector_type(4)));
typedef float f32x16 __attribute__((ext_vector_type(16)));
typedef unsigned u32x4 __attribute__((ext_vector_type(4)));
typedef unsigned u32x2 __attribute__((ext_vector_type(2)));

typedef const float* const __attribute__((address_space(4)))* KArgP;
__device__ __forceinline__ unsigned char* karg_ws() { return (unsigned char*)((const void* const __attribute__((address_space(4)))*)__builtin_amdgcn_kernarg_segment_ptr())[31]; }
__device__ __forceinline__ const float* karg_in(int i) { return ((KArgP)__builtin_amdgcn_kernarg_segment_ptr())[i]; }
__device__ __forceinline__ int hide_tid() { int t = threadIdx.x; asm volatile("" : "+v"(t)); return t; }
namespace pg8 {
#define PG8_LAS __attribute__((address_space(3)))
typedef unsigned short bf16_t;
constexpr int BM = 256, BK = 64, HALF = 128, HTB = HALF * BK * 2, STAGE_BYTES = 8 * HTB, NXCD = 8, WGM = 8;

__host__ __device__ __forceinline__ int lds_byte(int r, int c) { const int st = (r >> 4) * 2 + (c >> 5), rr = r & 15, cc = c & 31, ob = rr * 64 + cc * 2; return st * 1024 + (ob ^ (((ob >> 9) & 1) << 5)); }
__host__ __device__ __forceinline__ void stage_rc(int b, int& R, int& C) { const int st = b / 1024, sb = b % 1024, swz = sb ^ (((sb >> 9) & 1) << 5); R = (st >> 1) * 16 + swz / 64; C = (st & 1) * 32 + (swz % 64) / 2; }
__host__ __device__ __forceinline__ int perm32(int rho) { const int n = rho >> 4, i = rho & 15; return 8 * (i >> 2) + 4 * n + (i & 3); }

struct Unit { int pm, pn, pb, kt0, nk, split, tslot, keep, cpart; };
struct Gemm { const bf16_t* A; const bf16_t* Bt; int K; };

struct StaticOrder {
    int nM, nN, nwg, G, c, nkfull;
    __device__ void init(int nM_, int nN_, int G_, int c_, int nk_) { nM = nM_; nN = nN_; nwg = nM * nN; G = G_; c = c_; nkfull = nk_; }
    __device__ void map(int L, Unit& u) const {
        int wgid = L; { const int q = nwg / NXCD, r = nwg % NXCD, xcd = wgid % NXCD, off = wgid / NXCD; wgid = (xcd < r ? xcd * (q + 1) : r * (q + 1) + (xcd - r) * q) + off; }
        const int nig = WGM * nN, gid = wgid / nig, fm = gid * WGM, gsz = (nM - fm) < WGM ? (nM - fm) : WGM;
        u.pm = fm + ((wgid % nig) % gsz); u.pn = (wgid % nig) / gsz; u.pb = u.pn; u.kt0 = 0; u.nk = nkfull; u.split = 0; u.tslot = 0; u.keep = 0; u.cpart = 0;
    }
    __device__ bool next(int i, Unit& u) const { const long L = (long)i * G + c; if (L >= nwg) return false; map((int)L, u); return true; }
};
struct CtxTailOrder {
    StaticOrder so; int SK, two;
    __device__ bool next(int i, Unit& u) const {
        const int L = i * so.G + so.c;
        if (L < so.nwg) { so.map(L, u); u.pm += 2; u.keep = two ? 1 : 0; return true; }
        const int s = L - so.nwg; if (s >= 16 * SK) return false;
        const int tu = s / SK, ks = s - tu * SK;
        u.pm = tu >> 3; u.pn = tu & 7; u.pb = u.pn; u.nk = so.nkfull / SK; u.kt0 = ks * u.nk; u.split = 1; u.tslot = s; u.keep = 0; u.cpart = (two && u.kt0 >= so.nkfull / 2) ? 1 : 0; return true;
    }
};
struct MoeOrder {
    StaticOrder so; const int* pexp;
    __device__ bool next(int i, Unit& u) const { if (!so.next(i, u)) return false; u.pb = __builtin_amdgcn_readfirstlane(pexp[u.pm]) * so.nN + u.pn; return true; }
};
struct MoeTailOrder {
    StaticOrder so; const int* pexp; int NF, R, SK;
    __device__ bool next(int i, Unit& u) const {
        const int L = i * so.G + so.c;
        if (L < NF) { so.map(L, u); }
        else { const int s = L - NF; if (s >= R * SK) return false; const int tu = s / SK, ks = s - tu * SK;
            so.map(NF + tu, u); u.nk = so.nkfull / SK; u.kt0 = ks * u.nk; u.split = 1; u.tslot = s; }
        u.pb = __builtin_amdgcn_readfirstlane(pexp[u.pm]) * so.nN + u.pn; return true;
    }
};
template <class Base> struct RangeOrder {
    Base so; int i0, n;
    __device__ bool next(int i, Unit& u) const { return i < n && so.next(i0 + i, u); }
};
__device__ __forceinline__ void moe_tail_params(int npan, int nN, int G, int& NF, int& R, int& SK) {
    const int total = npan * nN; NF = (total / G) * G; R = total - NF;
    SK = 1; if (R > 0) { if (R * 7 <= G) SK = 7; else if (R * 4 <= G) SK = 4; else if (R * 2 <= G) SK = 2; }
}

typedef int v8i32 __attribute__((ext_vector_type(8)));
typedef int v4i32 __attribute__((ext_vector_type(4)));
__device__ __forceinline__ v8i32 cat8(const bf16x8 lo, const bf16x8 hi) { const v4i32 a = __builtin_bit_cast(v4i32, lo), b = __builtin_bit_cast(v4i32, hi); return (v8i32){a[0], a[1], a[2], a[3], b[0], b[1], b[2], b[3]}; }
__device__ __forceinline__ unsigned pk4_fp8(float a, float b, float c, float d) {
    a = __builtin_amdgcn_fmed3f(a, -448.f, 448.f); b = __builtin_amdgcn_fmed3f(b, -448.f, 448.f); c = __builtin_amdgcn_fmed3f(c, -448.f, 448.f); d = __builtin_amdgcn_fmed3f(d, -448.f, 448.f);
    int p = __builtin_amdgcn_cvt_pk_fp8_f32(a, b, 0, false); p = __builtin_amdgcn_cvt_pk_fp8_f32(c, d, p, true); return (unsigned)p; }
constexpr float S_H = 16.f, S_W13 = 512.f, S_ACT = 8.f, S_W2 = 1024.f, DS1 = 1.0f / (16.f * 512.f), DS2 = 1.0f / (8.f * 1024.f);
__device__ __forceinline__ unsigned cvt_pk_bf16(float lo, float hi) { unsigned r; asm volatile("v_cvt_pk_bf16_f32 %0, %1, %2" : "=v"(r) : "v"(lo), "v"(hi)); return r; }

__device__ __forceinline__ void slab_store(float* slab, const f32x4 (&acc)[2][2][4][2], const f32x4 (&gv)[2][2], const Unit& u, int wr, int wc, int fr, int fq) {
    float* P = slab + (size_t)u.tslot * 65536 + (wr * 64 + fr) * 256 + wc * 32 + 4 * fq;
#pragma unroll
    for (int ai = 0; ai < 2; ++ai)
#pragma unroll
        for (int m = 0; m < 4; ++m)
#pragma unroll
            for (int bj = 0; bj < 2; ++bj)
#pragma unroll
                for (int n = 0; n < 2; ++n) *(f32x4*)(P + (ai * HALF + m * 16) * 256 + bj * HALF + n * 16) = gv[bj][n] * acc[ai][bj][m][n];
}
template <bool P> struct EpiStoreBf16T {
    static constexpr bool PERM = P;
    bf16_t* O; int ldc; float* slab; float ds;
    __device__ __forceinline__ void operator()(const f32x4 (&acc)[2][2][4][2], const Unit& u, int wr, int wc, int fr, int fq) const {
        if (!P && u.split) { const f32x4 one = {ds, ds, ds, ds}; const f32x4 gv[2][2] = {{one, one}, {one, one}}; slab_store(slab, acc, gv, u, wr, wc, fr, fq); return; }
        const int row0 = u.pm * BM + wr * 64 + fr, col0 = u.pn * BM + wc * 32 + (P ? 8 * fq : 4 * fq);
#pragma unroll
        for (int ai = 0; ai < 2; ++ai)
#pragma unroll
            for (int m = 0; m < 4; ++m) { bf16_t* rowp = O + (size_t)(row0 + ai * HALF + m * 16) * ldc + col0;
#pragma unroll
                for (int bj = 0; bj < 2; ++bj) { const f32x4 v0 = acc[ai][bj][m][0] * ds, v1 = acc[ai][bj][m][1] * ds;
                    if (P) { u32x4 w; w.x = cvt_pk_bf16(v0[0], v0[1]); w.y = cvt_pk_bf16(v0[2], v0[3]); w.z = cvt_pk_bf16(v1[0], v1[1]); w.w = cvt_pk_bf16(v1[2], v1[3]);
                        *(u32x4*)(rowp + bj * HALF) = w; }
                    else { u32x2 w0, w1; w0.x = cvt_pk_bf16(v0[0], v0[1]); w0.y = cvt_pk_bf16(v0[2], v0[3]); w1.x = cvt_pk_bf16(v1[0], v1[1]); w1.y = cvt_pk_bf16(v1[2], v1[3]);
                        *(u32x2*)(rowp + bj * HALF) = w0; *(u32x2*)(rowp + bj * HALF + 16) = w1; } } }
    }
};
typedef EpiStoreBf16T<true> EpiStoreBf16;
__device__ __forceinline__ float silu_mul(float a, float b) { return a * __builtin_amdgcn_rcpf(1.0f + __builtin_amdgcn_exp2f(-1.4426950408889634f * a)) * b; }
struct EpiSwiglu {
    static constexpr bool PERM = true;
    bf16_t* O; int ldc;
    __device__ __forceinline__ void operator()(const f32x4 (&acc)[2][2][4][2], const Unit& u, int wr, int wc, int fr, int fq) const {
        const int row0 = u.pm * BM + wr * 64 + fr, col0 = u.pn * HALF + wc * 32 + 8 * fq;
#pragma unroll
        for (int ai = 0; ai < 2; ++ai)
#pragma unroll
            for (int m = 0; m < 4; ++m) { bf16_t* rowp = O + (size_t)(row0 + ai * HALF + m * 16) * ldc + col0;
                const f32x4 a0 = acc[ai][0][m][0], a1 = acc[ai][0][m][1], b0 = acc[ai][1][m][0], b1 = acc[ai][1][m][1];
                u32x4 w; w.x = cvt_pk_bf16(silu_mul(a0[0], b0[0]), silu_mul(a0[1], b0[1])); w.y = cvt_pk_bf16(silu_mul(a0[2], b0[2]), silu_mul(a0[3], b0[3]));
                w.z = cvt_pk_bf16(silu_mul(a1[0], b1[0]), silu_mul(a1[1], b1[1])); w.w = cvt_pk_bf16(silu_mul(a1[2], b1[2]), silu_mul(a1[3], b1[3]));
                *(u32x4*)rowp = w; }
    }
};
template <bool IN8> struct EpiSwiglu8T {
    static constexpr bool PERM = true;
    unsigned char* O; int ldc;
    __device__ __forceinline__ void operator()(const f32x4 (&acc)[2][2][4][2], const Unit& u, int wr, int wc, int fr, int fq) const {
        const int row0 = u.pm * BM + wr * 64 + fr, col0 = u.pn * HALF + wc * 32 + 8 * fq;
#pragma unroll
        for (int ai = 0; ai < 2; ++ai)
#pragma unroll
            for (int m = 0; m < 4; ++m) { unsigned char* rowp = O + (size_t)(row0 + ai * HALF + m * 16) * ldc + col0;
                const float da = IN8 ? DS1 : 1.0f, db = IN8 ? DS1 * S_ACT : S_ACT;
                const f32x4 a0 = acc[ai][0][m][0] * da, a1 = acc[ai][0][m][1] * da, b0 = acc[ai][1][m][0] * db, b1 = acc[ai][1][m][1] * db;
                u32x2 w; w.x = pk4_fp8(silu_mul(a0[0], b0[0]), silu_mul(a0[1], b0[1]), silu_mul(a0[2], b0[2]), silu_mul(a0[3], b0[3]));
                w.y = pk4_fp8(silu_mul(a1[0], b1[0]), silu_mul(a1[1], b1[1]), silu_mul(a1[2], b1[2]), silu_mul(a1[3], b1[3]));
                *(u32x2*)rowp = w; }
    }
};
typedef EpiSwiglu8T<true> EpiSwiglu8;
struct EpiSwigluI8 {
    static constexpr bool PERM = true, SCALES = true;
    unsigned char* O; int ldc; const float* rs; const float* cs;
    __device__ __forceinline__ void stage_scales(PG8_LAS unsigned char* slot, const Unit& u, int tid) const {
        const float* src = tid < 256 ? rs + u.pm * BM + tid : cs + u.pb * BM + (tid - 256);
        __builtin_amdgcn_global_load_lds((const unsigned*)src, (PG8_LAS unsigned*)(slot + (tid >> 6) * 256), 4, 0, 0);
    }
    __device__ __forceinline__ void operator()(const f32x4 (&acc)[2][2][4][2], const Unit& u, int wr, int wc, int fr, int fq, const PG8_LAS unsigned char* slot) const {
        const int row0 = u.pm * BM + wr * 64 + fr, col0 = u.pn * HALF + wc * 32 + 8 * fq;
        const PG8_LAS float* rsl = (const PG8_LAS float*)slot + wr * 64 + fr;
        const PG8_LAS float* csp = (const PG8_LAS float*)slot + 256 + wc * 32 + 8 * fq;
        const float L2E = 1.4426950408889634f;
        const f32x4 ka0 = *(const PG8_LAS f32x4*)csp * -L2E, ka1 = *(const PG8_LAS f32x4*)(csp + 4) * -L2E, kb0 = *(const PG8_LAS f32x4*)(csp + HALF) * (-S_ACT / L2E), kb1 = *(const PG8_LAS f32x4*)(csp + HALF + 4) * (-S_ACT / L2E);
#pragma unroll
        for (int ai = 0; ai < 2; ++ai)
#pragma unroll
            for (int m = 0; m < 4; ++m) { const int row = row0 + ai * HALF + m * 16; const float r = rsl[ai * HALF + m * 16];
                unsigned char* rowp = ldc < 0 ? O + ((size_t)(u.pm * (-ldc) + u.pn) * BM + (row - u.pm * BM)) * 128 + (col0 - u.pn * HALF) : O + (size_t)row * ldc + col0;
                const f32x4 fa0 = __builtin_convertvector(__builtin_bit_cast(v4i32, acc[ai][0][m][0]), f32x4), fa1 = __builtin_convertvector(__builtin_bit_cast(v4i32, acc[ai][0][m][1]), f32x4);
                const f32x4 fb0 = __builtin_convertvector(__builtin_bit_cast(v4i32, acc[ai][1][m][0]), f32x4), fb1 = __builtin_convertvector(__builtin_bit_cast(v4i32, acc[ai][1][m][1]), f32x4);
                const f32x4 a0 = (fa0 * r) * ka0, a1 = (fa1 * r) * ka1, b0 = (fb0 * r) * kb0, b1 = (fb1 * r) * kb1;
                f32x4 e0, e1;
#pragma unroll
                for (int j = 0; j < 4; ++j) { e0[j] = __builtin_amdgcn_exp2f(a0[j]); e1[j] = __builtin_amdgcn_exp2f(a1[j]); }
                e0 = e0 + 1.0f; e1 = e1 + 1.0f;
#pragma unroll
                for (int j = 0; j < 4; ++j) { e0[j] = __builtin_amdgcn_rcpf(e0[j]); e1[j] = __builtin_amdgcn_rcpf(e1[j]); }
                const f32x4 v0 = (a0 * b0) * e0, v1 = (a1 * b1) * e1;
                u32x2 w; w.x = pk4_fp8(v0[0], v0[1], v0[2], v0[3]); w.y = pk4_fp8(v1[0], v1[1], v1[2], v1[3]);
                *(u32x2*)rowp = w; }
    }
};
struct EpiStoreI8 {
    static constexpr bool PERM = true, SCALES = true;
    bf16_t* O; int ldc; const float* rs; const float* cs;
    __device__ __forceinline__ void stage_scales(PG8_LAS unsigned char* slot, const Unit& u, int tid) const {
        const float* src = tid < 256 ? rs + u.pm * BM + tid : cs + u.pb * BM + (tid - 256);
        __builtin_amdgcn_global_load_lds((const unsigned*)src, (PG8_LAS unsigned*)(slot + (tid >> 6) * 256), 4, 0, 0);
    }
    __device__ __forceinline__ void operator()(const f32x4 (&acc)[2][2][4][2], const Unit& u, int wr, int wc, int fr, int fq, const PG8_LAS unsigned char* slot) const {
        const int row0 = u.pm * BM + wr * 64 + fr, col0 = u.pn * BM + wc * 32 + 8 * fq;
        const PG8_LAS float* rsl = (const PG8_LAS float*)slot + wr * 64 + fr;
        const PG8_LAS float* csp = (const PG8_LAS float*)slot + 256 + wc * 32 + 8 * fq;
        f32x4 c[2][2];
#pragma unroll
        for (int bj = 0; bj < 2; ++bj)
#pragma unroll
            for (int n = 0; n < 2; ++n) c[bj][n] = *(const PG8_LAS f32x4*)(csp + bj * HALF + 4 * n);
#pragma unroll
        for (int ai = 0; ai < 2; ++ai)
#pragma unroll
            for (int m = 0; m < 4; ++m) { const float r = rsl[ai * HALF + m * 16]; bf16_t* rowp = O + (size_t)(row0 + ai * HALF + m * 16) * ldc + col0;
#pragma unroll
                for (int bj = 0; bj < 2; ++bj) {
                    const f32x4 v0 = (__builtin_convertvector(__builtin_bit_cast(v4i32, acc[ai][bj][m][0]), f32x4) * r) * c[bj][0], v1 = (__builtin_convertvector(__builtin_bit_cast(v4i32, acc[ai][bj][m][1]), f32x4) * r) * c[bj][1];
                    u32x4 w; w.x = cvt_pk_bf16(v0[0], v0[1]); w.y = cvt_pk_bf16(v0[2], v0[3]); w.z = cvt_pk_bf16(v1[0], v1[1]); w.w = cvt_pk_bf16(v1[2], v1[3]);
                    *(u32x4*)(rowp + bj * HALF) = w; } }
    }
};
template <class E> struct has_mid { template <class T> static constexpr bool f(decltype(T::MID)*) { return T::MID; } template <class T> static constexpr bool f(...) { return false; } static constexpr bool value = f<E>(nullptr); };
template <class E> struct has_scales { template <class T> static constexpr bool f(decltype(T::SCALES)*) { return T::SCALES; } template <class T> static constexpr bool f(...) { return false; } static constexpr bool value = f<E>(nullptr); };
constexpr int SCALE_SLOT_OFF = STAGE_BYTES, SCALE_SLOT_BYTES = 2048;
constexpr size_t SSQ_OFF = (size_t)3 << 20;
template <bool FIRST, bool MIDC> struct EpiResidT {
    static constexpr bool PERM = false, MID = MIDC;
    bf16_t* X; const float* modl; int chunk; float* slab; float ds;
    __device__ __forceinline__ float rowfac(int row) const { const float* ssq = (const float*)(karg_ws() + SSQ_OFF);
        const f32x4 s0 = *(const f32x4*)(ssq + (size_t)row * 8), s1 = *(const f32x4*)(ssq + (size_t)row * 8 + 4);
        return __builtin_amdgcn_rsqf(((s0[0] + s0[1]) + (s0[2] + s0[3]) + (s1[0] + s1[1]) + (s1[2] + s1[3])) * (1.0f / 1024.0f) + 1e-6f); }
    __device__ __forceinline__ void mid(f32x4 (&acc)[2][2][4][2], const Unit& u, int wr, int wc, int fr, int fq) const {
        const int row0 = u.pm * BM + wr * 64 + fr;
#pragma unroll
        for (int ai = 0; ai < 2; ++ai)
#pragma unroll
            for (int m = 0; m < 4; ++m) { const float r = rowfac(row0 + ai * HALF + m * 16);
#pragma unroll
                for (int bj = 0; bj < 2; ++bj)
#pragma unroll
                    for (int n = 0; n < 2; ++n) acc[ai][bj][m][n] = acc[ai][bj][m][n] * r;
                asm volatile("" ::: "memory"); }
    }
    __device__ __forceinline__ void operator()(const f32x4 (&acc)[2][2][4][2], const Unit& u, int wr, int wc, int fr, int fq) const {
        const int pmg = u.pm, v = pmg < 2 ? 2 : ((pmg - 2) >> 4);
        const float* gate = modl + v * 12288 + chunk * 2048;
        const int row0 = pmg * BM + wr * 64 + fr, col0 = u.pn * BM + wc * 32 + 4 * fq;
        f32x4 gv[2][2];
#pragma unroll
        for (int bj = 0; bj < 2; ++bj)
#pragma unroll
            for (int n = 0; n < 2; ++n) gv[bj][n] = *(const f32x4*)(gate + col0 + bj * HALF + n * 16) * ds;
        if (u.split) {
            float* P = slab + (size_t)u.tslot * 65536 + (wr * 64 + fr) * 256 + wc * 32 + 4 * fq;
#pragma unroll
            for (int ai = 0; ai < 2; ++ai)
#pragma unroll
                for (int m = 0; m < 4; ++m) { const float r = (MIDC && u.cpart) ? rowfac(row0 + ai * HALF + m * 16) : 1.0f;
#pragma unroll
                    for (int bj = 0; bj < 2; ++bj)
#pragma unroll
                        for (int n = 0; n < 2; ++n) *(f32x4*)(P + (ai * HALF + m * 16) * 256 + bj * HALF + n * 16) = gv[bj][n] * acc[ai][bj][m][n] * r;
                    asm volatile("" ::: "memory"); }
            return; }
        const float* xin = FIRST ? (pmg < 2 ? karg_in(2) : karg_in(0) - (size_t)512 * 2048) : nullptr;
#pragma unroll
        for (int ai = 0; ai < 2; ++ai)
#pragma unroll
            for (int m = 0; m < 4; ++m) { const size_t ro = (size_t)(row0 + ai * HALF + m * 16) * 2048 + col0;
#pragma unroll
                for (int bj = 0; bj < 2; ++bj)
#pragma unroll
                    for (int n = 0; n < 2; ++n) { const size_t o = ro + bj * HALF + n * 16; f32x4 b;
                        if (FIRST) b = *(const f32x4*)(xin + o);
                        else { const u32x2 w = *(const u32x2*)(X + o); b = (f32x4){__builtin_bit_cast(float, w.x << 16), __builtin_bit_cast(float, w.x & 0xffff0000u), __builtin_bit_cast(float, w.y << 16), __builtin_bit_cast(float, w.y & 0xffff0000u)}; }
                        b = b + gv[bj][n] * acc[ai][bj][m][n];
                        u32x2 w2; w2.x = cvt_pk_bf16(b[0], b[1]); w2.y = cvt_pk_bf16(b[2], b[3]); *(u32x2*)(X + o) = w2; } }
    }
};

template <int MODE  , class Epi, class Sched, bool BLK = false>
__device__ __forceinline__ void gemm_phase(PG8_LAS unsigned char* lds, const Gemm g, const Sched& S, const Epi& E) {
    const int tid = hide_tid(), wid = __builtin_amdgcn_readfirstlane(tid >> 6), lane = tid & 63, wr = wid >> 2, wc = wid & 3, fr = lane & 15, fq = lane >> 4;
    const int K = g.K;
    unsigned voffA[2], voffB[2];
#pragma unroll
    for (int i = 0; i < 2; ++i) { int R, C; stage_rc(tid * 16 + i * 8192, R, C); const int Rb = Epi::PERM ? ((R & ~31) + perm32(R & 31)) : R;
        voffA[i] = BLK ? (unsigned)(R * 64 + C) * 2u : (unsigned)(R * K + C) * 2u; voffB[i] = BLK ? (unsigned)(Rb * 64 + C) * 2u : (unsigned)(Rb * K + C) * 2u; }
    const size_t kstep = BLK ? (size_t)(BM * BK * 2) : (size_t)(BK * 2);
    const size_t hstep = BLK ? (size_t)(HALF * BK * 2) : (size_t)HALF * K * 2;
    const size_t tstep = (size_t)BM * K * 2;
    const unsigned ldsw = (unsigned)wid * 1024u;
    const int aoff = lds_byte(wr * 64 + fr, fq * 8), boff = lds_byte(wc * 32 + fr, fq * 8);
#define PG8_SA(b, h) (((b) * 2 + (h)) * HTB)
#define PG8_SB(b, h) ((4 + (b) * 2 + (h)) * HTB)
#define PG8_STAGE(bufoff, gbase, voff) do { _Pragma("unroll") for (int _i = 0; _i < 2; ++_i) { unsigned _o = (voff)[_i]; asm volatile("" : "+v"(_o)); \
        __builtin_amdgcn_global_load_lds((const unsigned*)((const char*)(gbase) + _o), (PG8_LAS unsigned*)(lds + (bufoff) + ldsw + _i * 8192), 16, 0, 0); } } while (0)
#define PG8_LDA(dst, b, h) do { _Pragma("unroll") for (int m = 0; m < 4; ++m) _Pragma("unroll") for (int k = 0; k < 2; ++k) dst[m][k] = *(const PG8_LAS bf16x8*)(lds + PG8_SA(b, h) + aoff + m * 2048 + k * 1024); } while (0)
#define PG8_LDB(dst, b, h) do { _Pragma("unroll") for (int n = 0; n < 2; ++n) _Pragma("unroll") for (int k = 0; k < 2; ++k) dst[n][k] = *(const PG8_LAS bf16x8*)(lds + PG8_SB(b, h) + boff + n * 2048 + k * 1024); } while (0)
#define PG8_MMA(ai, bj, At, Bt) do { __builtin_amdgcn_s_setprio(1); _Pragma("unroll") for (int m = 0; m < 4; ++m) _Pragma("unroll") for (int n = 0; n < 2; ++n) { \
        if constexpr (MODE == 1) { acc[ai][bj][m][n] = __builtin_amdgcn_mfma_scale_f32_16x16x128_f8f6f4(cat8(Bt[n][0], Bt[n][1]), cat8(At[m][0], At[m][1]), acc[ai][bj][m][n], 0, 0, 0, 0, 0, 0); } \
        else if constexpr (MODE == 2) { _Pragma("unroll") for (int k = 0; k < 2; ++k) acc[ai][bj][m][n] = __builtin_bit_cast(f32x4, __builtin_amdgcn_mfma_i32_16x16x64_i8(__builtin_bit_cast(v4i32, Bt[n][k]), __builtin_bit_cast(v4i32, At[m][k]), __builtin_bit_cast(v4i32, acc[ai][bj][m][n]), 0, 0, 0)); } \
        else { _Pragma("unroll") for (int k = 0; k < 2; ++k) acc[ai][bj][m][n] = __builtin_amdgcn_mfma_f32_16x16x32_bf16(Bt[n][k], At[m][k], acc[ai][bj][m][n], 0, 0, 0); } } \
        __builtin_amdgcn_s_setprio(0); } while (0)
#define PG8_WAIT_V(n) asm volatile("s_waitcnt vmcnt(" #n ")" ::: "memory")
#define PG8_WAIT_L(n) asm volatile("s_waitcnt lgkmcnt(" #n ")" ::: "memory")
#define PG8_BAR __builtin_amdgcn_s_barrier()
#define PG8_SCHED __builtin_amdgcn_sched_barrier(0)
    Unit cur, nxt; int ui = 0;
    if (!S.next(0, cur)) return;
    f32x4 acc[2][2][4][2];
#pragma unroll
    for (int a = 0; a < 2; ++a)
#pragma unroll
        for (int b = 0; b < 2; ++b)
#pragma unroll
            for (int m = 0; m < 4; ++m)
#pragma unroll
                for (int n = 0; n < 2; ++n) acc[a][b][m][n] = (f32x4){0.f, 0.f, 0.f, 0.f};
    bf16x8 At[4][2], B0[2][2], B1[2][2];
    const char* cA = (const char*)g.A + (size_t)cur.pm * tstep + (size_t)cur.kt0 * kstep; const char* cB = (const char*)g.Bt + (size_t)cur.pb * tstep + (size_t)cur.kt0 * kstep;
#define PG8_WOFS(u) ((has_mid<Epi>::value && (u).keep) ? (size_t)((u).nk / 2) * kstep : (size_t)0)
    const char* fA = cA + PG8_WOFS(cur); const char* fB = cB + PG8_WOFS(cur);
    if constexpr (has_scales<Epi>::value) E.stage_scales(lds + SCALE_SLOT_OFF, cur, tid);
    PG8_STAGE(PG8_SB(0, 0), fB, voffB); PG8_STAGE(PG8_SB(0, 1), fB + hstep, voffB); PG8_STAGE(PG8_SA(0, 0), fA, voffA); PG8_STAGE(PG8_SA(0, 1), fA + hstep, voffA);
    if (wr == 1) PG8_BAR;
    PG8_WAIT_V(2); PG8_BAR;
    PG8_STAGE(PG8_SB(1, 0), fB + kstep, voffB); PG8_STAGE(PG8_SA(1, 0), fA + kstep, voffA); PG8_STAGE(PG8_SB(1, 1), fB + hstep + kstep, voffB);
    PG8_WAIT_V(6); PG8_BAR;
    for (;;) {
        const bool has_next = S.next(ui + 1, nxt);
        const char* nA0 = has_next ? (const char*)g.A + (size_t)nxt.pm * tstep + (size_t)nxt.kt0 * kstep : cA; const char* nB0 = has_next ? (const char*)g.Bt + (size_t)nxt.pb * tstep + (size_t)nxt.kt0 * kstep : cB;
        const char* nA = has_next ? nA0 + PG8_WOFS(nxt) : fA; const char* nB = has_next ? nB0 + PG8_WOFS(nxt) : fB;
        const int nt = cur.nk;
        const bool wrapu = has_mid<Epi>::value && cur.keep; const int halfk = nt >> 1;
        for (int t = 0; t < nt; t += 2) {
            const bool last = (t == nt - 2);
#define PG8_KOFF(tt) ((size_t)(wrapu ? ((tt) < halfk ? (tt) + halfk : (tt) - halfk) : (tt)) * kstep)
            const char* a1 = cA + PG8_KOFF(t + 1);
            const char* a2 = last ? nA : cA + PG8_KOFF(t + 2); const char* b2 = last ? nB : cB + PG8_KOFF(t + 2);
            const char* a3 = a2 + kstep; const char* b3 = b2 + kstep;
            if constexpr (has_mid<Epi>::value) { if (wrapu && t == halfk) { const int tz = hide_tid(), wz = __builtin_amdgcn_readfirstlane(tz >> 6), lz = tz & 63; E.mid(acc, cur, wz >> 2, wz & 3, lz & 15, lz >> 4); } }
            if constexpr (has_scales<Epi>::value) { if (last && has_next) E.stage_scales(lds + SCALE_SLOT_OFF + ((ui + 1) & 1) * SCALE_SLOT_BYTES, nxt, tid); }
            PG8_LDB(B0, 0, 0); PG8_LDB(B1, 0, 1); PG8_SCHED; PG8_LDA(At, 0, 0); PG8_STAGE(PG8_SA(1, 1), a1 + hstep, voffA);
            PG8_WAIT_V(8); PG8_WAIT_L(0); PG8_BAR; PG8_MMA(0, 0, At, B0); PG8_MMA(0, 1, At, B1); PG8_BAR; PG8_SCHED;
            PG8_LDA(At, 0, 1); PG8_STAGE(PG8_SB(0, 0), b2, voffB); PG8_STAGE(PG8_SB(0, 1), b2 + hstep, voffB); PG8_STAGE(PG8_SA(0, 0), a2, voffA);
            PG8_WAIT_V(8); PG8_WAIT_L(0); PG8_BAR; PG8_MMA(1, 0, At, B0); PG8_MMA(1, 1, At, B1); PG8_BAR; PG8_SCHED;
            PG8_LDB(B0, 1, 0); PG8_LDB(B1, 1, 1); PG8_SCHED; PG8_LDA(At, 1, 0); PG8_STAGE(PG8_SA(0, 1), a2 + hstep, voffA);
            PG8_WAIT_V(8); PG8_WAIT_L(0); PG8_BAR; PG8_MMA(0, 0, At, B0); PG8_MMA(0, 1, At, B1); PG8_BAR; PG8_SCHED;
            PG8_LDA(At, 1, 1); PG8_STAGE(PG8_SB(1, 0), b3, voffB); PG8_STAGE(PG8_SB(1, 1), b3 + hstep, voffB); PG8_STAGE(PG8_SA(1, 0), a3, voffA);
            PG8_WAIT_V(8); PG8_WAIT_L(0); PG8_BAR; PG8_MMA(1, 0, At, B0); PG8_MMA(1, 1, At, B1); PG8_BAR; PG8_SCHED;
        }
        if (wr == 0) PG8_BAR;
        { const int tz = hide_tid(), wz = __builtin_amdgcn_readfirstlane(tz >> 6), lz = tz & 63;
          if constexpr (has_scales<Epi>::value) E(acc, cur, wz >> 2, wz & 3, lz & 15, lz >> 4, lds + SCALE_SLOT_OFF + (ui & 1) * SCALE_SLOT_BYTES);
          else E(acc, cur, wz >> 2, wz & 3, lz & 15, lz >> 4); }
        if (!has_next) break;
#pragma unroll
        for (int a = 0; a < 2; ++a)
#pragma unroll
            for (int b = 0; b < 2; ++b)
#pragma unroll
                for (int m = 0; m < 4; ++m)
#pragma unroll
                    for (int n = 0; n < 2; ++n) acc[a][b][m][n] = (f32x4){0.f, 0.f, 0.f, 0.f};
        cur = nxt; cA = nA0; cB = nB0; fA = nA; fB = nB; ++ui;
        if (wr == 1) PG8_BAR;
    }
    PG8_WAIT_V(0);
    PG8_BAR;
#undef PG8_SA
#undef PG8_WOFS
#undef PG8_KOFF
#undef PG8_SB
#undef PG8_STAGE
#undef PG8_LDA
#undef PG8_LDB
#undef PG8_MMA
#undef PG8_WAIT_V
#undef PG8_WAIT_L
#undef PG8_BAR
#undef PG8_SCHED
}
}

constexpr int D = 2048, NB = 2, SEQ = 4096, LCTX = 256, NKEY = SEQ + LCTX;
constexpr int MROWS = NB * NKEY;
constexpr int INC = 4608, MIXW = 2048, DFF = 5632, NEXP = 8, DFFE = 7168;
constexpr int C_AQ = 0, C_AK = 512, C_AV = 1024, C_BB = 1536, C_BC = 2048, C_BX = 2560, C_CQ = 3072, C_CK = 4096, C_CV = 4352;
constexpr float EPS = 1e-6f;
constexpr int MAXSLOT = 2 * NB * SEQ + NEXP * 256;
constexpr int NWAVES = 8, NTHR = 512;

constexpr size_t MiB = 1u << 20;
constexpr size_t WS_CTL = 0, CTL_ZERO_BYTES = 128 * 1024;
constexpr size_t WS_MOD = 1 * MiB;
constexpr size_t WS_TOK = 2 * MiB;
constexpr size_t WS_CSM = 2 * MiB + 512 * 1024;
constexpr size_t WS_RSS = 3 * MiB + 576 * 1024;
constexpr size_t WS_RS = 3 * MiB + 512 * 1024;
constexpr size_t WS_CS = 3 * MiB + 768 * 1024;
constexpr size_t WS_CSIN = 3 * MiB + 832 * 1024;
constexpr size_t WS_SSQ = 3 * MiB; static_assert(WS_SSQ == pg8::SSQ_OFF, "SSQ offset");
constexpr size_t WS_WIN = 4 * MiB;
constexpr size_t WS_WOUT = WS_WIN + (size_t)2 * INC * D * 2;
constexpr size_t WS_WF13 = WS_WOUT + (size_t)2 * D * D * 2;
constexpr size_t WS_WF2 = WS_WF13 + (size_t)2 * DFF * D * 2;
constexpr size_t WS_WM13 = WS_WF2 + (size_t)D * DFF * 2;
constexpr size_t WS_WM2 = WS_WM13 + (size_t)NEXP * 2 * DFFE * D * 2;
constexpr size_t WS_XW = WS_WM2 + (size_t)NEXP * D * DFFE * 2;
constexpr size_t WS_HB = WS_XW + (size_t)MROWS * D * 4;
constexpr size_t WS_PROJ = WS_HB + (size_t)MROWS * D * 2;
constexpr size_t WS_VTA = WS_PROJ + (size_t)MROWS * INC * 2;
constexpr size_t WS_VTC = WS_VTA + (size_t)NB * 4 * 128 * NKEY * 2;
constexpr size_t WS_MIX = WS_VTC + (size_t)NB * 2 * 128 * NKEY * 2;
constexpr size_t WS_ACT = WS_MIX + (size_t)MROWS * MIXW * 2;
constexpr size_t WS_HPERM = WS_ACT + (size_t)MAXSLOT * DFFE * 2;
constexpr size_t WS_YS = WS_HPERM + (size_t)MAXSLOT * D * 2;
constexpr size_t WS_SLAB = WS_YS + (size_t)MAXSLOT * D * 2;
constexpr size_t WS_END = WS_SLAB + (size_t)256 * 65536 * 4;
constexpr int CW_BAR = 4096;
constexpr int CW_CNT = 16384;
constexpr int CW_TMODE = 24576;
constexpr int CW_PEXP = 20480;

constexpr int LDS_BYTES = 147456;
constexpr int MISC_OFF = LDS_BYTES - 256;

__device__ __forceinline__ unsigned f2bf(float f) { unsigned u = __builtin_bit_cast(unsigned, f); return (u + 0x7fffu + ((u >> 16) & 1u)) >> 16; }
__device__ __forceinline__ unsigned pk2(float lo, float hi) { return pg8::cvt_pk_bf16(lo, hi); }
__device__ __forceinline__ float bflo(unsigned w) { return __builtin_bit_cast(float, w << 16); }
__device__ __forceinline__ float bfhi(unsigned w) { return __builtin_bit_cast(float, w & 0xffff0000u); }
__device__ __forceinline__ float wave_sum(float v) {
#pragma unroll
    for (int o = 1; o < 64; o <<= 1) v += __shfl_xor(v, o);
    return v;
}
__device__ __forceinline__ void unpack8(const u32x4 w, float (&f)[8]) { f[0] = bflo(w.x); f[1] = bfhi(w.x); f[2] = bflo(w.y); f[3] = bfhi(w.y); f[4] = bflo(w.z); f[5] = bfhi(w.z); f[6] = bflo(w.w); f[7] = bfhi(w.w); }
__device__ __forceinline__ u32x4 pack8(const float (&f)[8]) { u32x4 w; w.x = pk2(f[0], f[1]); w.y = pk2(f[2], f[3]); w.z = pk2(f[4], f[5]); w.w = pk2(f[6], f[7]); return w; }
__device__ __forceinline__ int rowmap(int b, int j) { return j < LCTX ? b * LCTX + j : 2 * LCTX + b * SEQ + (j - LCTX); }

#define XB_TMO      128
#define XB_XCNT(j)  (256  + 64 * (j))
#define XB_XSUB(j)  (1280 + 64 * (j))
#define XB_XGEN(j)  (2304 + 64 * (j))
#define XB_TOP      3328
#define XB_TOPGEN   3392
#define XCD_BAR_WORDS 3456
#define XB_SPIN_CAP (1u << 18)
__device__ __forceinline__ unsigned xb_ld(unsigned* p)              { return __hip_atomic_load(p, __ATOMIC_RELAXED, __HIP_MEMORY_SCOPE_AGENT); }
__device__ __forceinline__ unsigned xb_add(unsigned* p, unsigned v) { return __hip_atomic_fetch_add(p, v, __ATOMIC_RELAXED, __HIP_MEMORY_SCOPE_AGENT); }
__device__ __forceinline__ unsigned xb_xcc_id() { return (unsigned)__builtin_amdgcn_s_getreg((3 << 11) | 20) & 0xFu; }
#define XB_SPIN(cond, bar) do { unsigned _sp = 0; while (cond) { __builtin_amdgcn_s_sleep(1); \
    if ((++_sp & 255u) == 0u) { if (xb_ld(&(bar)[XB_TMO])) break; if (_sp > XB_SPIN_CAP) { atomicAdd(&(bar)[XB_TMO], 1u); break; } } } } while (0)
struct XcdBarrier { unsigned* bar; unsigned x; volatile LAS unsigned* st; };
__device__ __forceinline__ XcdBarrier xcd_barrier_post(unsigned* bar, volatile LAS unsigned* st) {
    XcdBarrier b; b.bar = bar; b.x = xb_xcc_id(); b.st = st;
    if (threadIdx.x == 0) (void)xb_add(&bar[XB_XCNT(b.x)], 1u);
    return b;
}
__device__ __forceinline__ void xcd_barrier_complete(unsigned* bar, unsigned x, unsigned& nloc, unsigned& nx) {
    const unsigned G = gridDim.x * gridDim.y * gridDim.z;
    unsigned sum, cnt, mine, sp = 0u;
    for (;;) {
        sum = 0u; cnt = 0u; mine = 0u;
#pragma unroll
        for (unsigned j = 0; j < 16; ++j) { const unsigned c = xb_ld(&bar[XB_XCNT(j)]); sum += c; cnt += (c > 0u) ? 1u : 0u; mine = (j == x) ? c : mine; }
        if (sum == G) break;
        __builtin_amdgcn_s_sleep(1);
        if ((++sp & 255u) == 0u) { if (xb_ld(&bar[XB_TMO])) break; if (sp > XB_SPIN_CAP) { atomicAdd(&bar[XB_TMO], 1u); break; } }
    }
    nloc = mine > 0u ? mine : 1u; nx = cnt > 0u ? cnt : 1u;
}
__device__ __forceinline__ void xcd_barrier(const XcdBarrier& b) {
    asm volatile("s_waitcnt vmcnt(0)" ::: "memory");
    __syncthreads();
    if (threadIdx.x == 0) {
        unsigned* bar = b.bar;
        __builtin_amdgcn_s_waitcnt(0);
        unsigned nloc = b.st[0], nx = b.st[1];
        if (nloc == 0u) { xcd_barrier_complete(bar, b.x, nloc, nx); b.st[0] = nloc; b.st[1] = nx; }
        const unsigned old = xb_add(&bar[XB_XSUB(b.x)], 1u);
        const unsigned gen = old / nloc;
        if (old + 1u == (gen + 1u) * nloc) {
            __builtin_amdgcn_fence(__ATOMIC_RELEASE, "agent");
            asm volatile("s_waitcnt vmcnt(0)" ::: "memory");
            const unsigned og = xb_add(&bar[XB_TOP], 1u);
            const unsigned tg = og / nx;
            if (og + 1u == (tg + 1u) * nx) xb_add(&bar[XB_TOPGEN], 1u);
            else XB_SPIN(xb_ld(&bar[XB_TOPGEN]) == tg, bar);
            __builtin_amdgcn_fence(__ATOMIC_ACQUIRE, "agent");
            xb_add(&bar[XB_XGEN(b.x)], 1u);
            asm volatile("s_waitcnt vmcnt(0)" ::: "memory");
        } else {
            XB_SPIN(xb_ld(&bar[XB_XGEN(b.x)]) == gen, bar);
            __builtin_amdgcn_fence(__ATOMIC_ACQUIRE, "agent");
            asm volatile("s_waitcnt vmcnt(0)" ::: "memory");
        }
    }
    __syncthreads();
}

struct Args { const float* in[30]; float* out; unsigned char* ws; int ph_lo, ph_hi; };
typedef const __attribute__((address_space(4))) Args* ArgsP;


__device__ __forceinline__ void xpose_item(const float* __restrict__ W, int ldw, int k0, int n0, bf16* __restrict__ dst0, int ldd, LAS float* scr, int lane) {
    f32x4 v[16];
    const float* src = W + (size_t)(k0 + (lane >> 4)) * ldw + n0 + 4 * (lane & 15);
#pragma unroll
    for (int i = 0; i < 16; ++i) v[i] = __builtin_nontemporal_load((const f32x4*)(src + (size_t)(4 * i) * ldw));
#pragma unroll
    for (int i = 0; i < 16; ++i) { LAS float* s = scr + (4 * i + (lane >> 4)) * 65 + 4 * (lane & 15); s[0] = v[i][0]; s[1] = v[i][1]; s[2] = v[i][2]; s[3] = v[i][3]; }
    asm volatile("s_waitcnt lgkmcnt(0)" ::: "memory");
    const int c = lane & 7;
#pragma unroll
    for (int j = 0; j < 8; ++j) { const int n = (lane >> 3) + 8 * j; const LAS float* s = scr + (8 * c) * 65 + n;
        u32x4 o; o.x = pk2(s[0 * 65], s[1 * 65]); o.y = pk2(s[2 * 65], s[3 * 65]); o.z = pk2(s[4 * 65], s[5 * 65]); o.w = pk2(s[6 * 65], s[7 * 65]);
        __builtin_nontemporal_store(o, (u32x4*)(dst0 + (size_t)n * ldd + k0 + 8 * c)); }
    asm volatile("s_waitcnt lgkmcnt(0)" ::: "memory");
}
__device__ __forceinline__ void xpose_item8(const float* __restrict__ W, int ldw, int k0, int n0, unsigned char* __restrict__ dst0, int ldd, int kofs, float scale, LAS float* scr, int lane) {
    f32x4 v[16];
    const float* src = W + (size_t)(k0 + (lane >> 4)) * ldw + n0 + 4 * (lane & 15);
#pragma unroll
    for (int i = 0; i < 16; ++i) v[i] = __builtin_nontemporal_load((const f32x4*)(src + (size_t)(4 * i) * ldw));
#pragma unroll
    for (int i = 0; i < 16; ++i) { LAS float* s = scr + (4 * i + (lane >> 4)) * 65 + 4 * (lane & 15); s[0] = v[i][0] * scale; s[1] = v[i][1] * scale; s[2] = v[i][2] * scale; s[3] = v[i][3] * scale; }
    asm volatile("s_waitcnt lgkmcnt(0)" ::: "memory");
    const int c = lane & 3;
#pragma unroll
    for (int j = 0; j < 4; ++j) { const int n = (lane >> 2) + 16 * j; const LAS float* s = scr + (16 * c) * 65 + n;
        u32x4 o; o.x = pg8::pk4_fp8(s[0 * 65], s[1 * 65], s[2 * 65], s[3 * 65]); o.y = pg8::pk4_fp8(s[4 * 65], s[5 * 65], s[6 * 65], s[7 * 65]);
        o.z = pg8::pk4_fp8(s[8 * 65], s[9 * 65], s[10 * 65], s[11 * 65]); o.w = pg8::pk4_fp8(s[12 * 65], s[13 * 65], s[14 * 65], s[15 * 65]);
        __builtin_nontemporal_store(o, (u32x4*)(dst0 + (size_t)n * ldd + kofs + 16 * c)); }
    asm volatile("s_waitcnt lgkmcnt(0)" ::: "memory");
}
__device__ __forceinline__ void xpose_item_i8(const float* __restrict__ W, int ldw, int k0, int n0, unsigned char* __restrict__ dst0, int ldd, const float* __restrict__ cs, LAS float* scr, int lane) {
    f32x4 v[16];
    const float* src = W + (size_t)(k0 + (lane >> 4)) * ldw + n0 + 4 * (lane & 15);
#pragma unroll
    for (int i = 0; i < 16; ++i) v[i] = __builtin_nontemporal_load((const f32x4*)(src + (size_t)(4 * i) * ldw));
#pragma unroll
    for (int i = 0; i < 16; ++i) { LAS float* s = scr + (4 * i + (lane >> 4)) * 65 + 4 * (lane & 15); s[0] = v[i][0]; s[1] = v[i][1]; s[2] = v[i][2]; s[3] = v[i][3]; }
    asm volatile("s_waitcnt lgkmcnt(0)" ::: "memory");
    const int c = lane & 3;
#pragma unroll
    for (int j = 0; j < 4; ++j) { const int n = (lane >> 2) + 16 * j; const LAS float* s = scr + (16 * c) * 65 + n; const float d = cs[n], q = d > 1e-30f ? 1.0f / d : 0.f;
        unsigned o[4];
#pragma unroll
        for (int g = 0; g < 4; ++g) { int qi[4];
#pragma unroll
            for (int e = 0; e < 4; ++e) qi[e] = (int)rintf(__builtin_amdgcn_fmed3f(s[(4 * g + e) * 65] * q, -127.f, 127.f));
            o[g] = (unsigned)(qi[0] & 255) | ((unsigned)(qi[1] & 255) << 8) | ((unsigned)(qi[2] & 255) << 16) | ((unsigned)(qi[3] & 255) << 24); }
        __builtin_nontemporal_store((u32x4){o[0], o[1], o[2], o[3]}, (u32x4*)(dst0 + (size_t)n * ldd + k0 + 16 * c)); }
    asm volatile("s_waitcnt lgkmcnt(0)" ::: "memory");
}
__device__ __forceinline__ void xpose_mat8(const float* W, int K, int N, unsigned char* dst, bool ilv, int ilv_off, float scale, int item, LAS float* scr, int lane) {
    const int ntn = N >> 6, kb = item / ntn, nb = item - kb * ntn, k0 = kb * 64, n0 = nb * 64;
    const int drow = ilv ? ((n0 >> 7) * 256 + (n0 & 127) + ilv_off) : n0;
    xpose_item8(W, N, k0, n0, dst + ((size_t)((drow >> 8) * (K >> 7) + (k0 >> 7)) * 256 + (drow & 255)) * 128, 128, k0 & 127, scale, scr, lane);
}
__device__ __forceinline__ void xpose_mat(const float* W, int K, int N, bf16* dst, bool ilv, int ilv_off, int item, LAS float* scr, int lane) {
    const int ntn = N >> 6, kb = item / ntn, nb = item - kb * ntn, k0 = kb * 64, n0 = nb * 64;
    const int drow = ilv ? ((n0 >> 7) * 256 + (n0 & 127) + ilv_off) : n0;
    xpose_item(W, N, k0, n0, dst + (size_t)drow * K, K, scr, lane);
}
__device__ __forceinline__ float silu_f(float x) { return x / (1.0f + __expf(-x)); }

__device__ __forceinline__ void mod_strips(ArgsP a, LAS unsigned char* lds, int s0, int s1, int stride) {
    const int tid = hide_tid();
    unsigned char* ws = a->ws;
    LAS float* sc = (LAS float*)lds;
    LAS float* red = (LAS float*)(lds + 24576);
    if (s0 >= s1) return;
    for (int i = tid; i < 3 * D; i += NTHR) { const int v = i >> 11, k = i & 2047; const float x = v < 2 ? a->in[1][v * D + k] : a->in[3][k]; sc[i] = silu_f(x); }
    __syncthreads();
    float* MOD = (float*)(ws + WS_MOD);
    for (int s = s0; s < s1; s += stride) {
        const int l = s / 192, col0 = (s - l * 192) * 64, cg = tid & 15, kg = tid >> 4;
        const float* W = a->in[4] + (size_t)l * D * 12288 + col0 + 4 * cg;
        f32x4 acc0 = {0.f, 0.f, 0.f, 0.f}, acc1 = acc0, acc2 = acc0;
#pragma unroll 16
        for (int kk = 0; kk < 64; ++kk) { const int k = kg + 32 * kk; const f32x4 w = __builtin_nontemporal_load((const f32x4*)(W + (size_t)k * 12288));
            acc0 += w * sc[k]; acc1 += w * sc[2048 + k]; acc2 += w * sc[4096 + k]; }
#pragma unroll
        for (int j = 0; j < 4; ++j) { red[(kg * 3 + 0) * 64 + 4 * cg + j] = acc0[j]; red[(kg * 3 + 1) * 64 + 4 * cg + j] = acc1[j]; red[(kg * 3 + 2) * 64 + 4 * cg + j] = acc2[j]; }
        __syncthreads();
        if (tid < 192) { const int v = tid >> 6, c = tid & 63; float sum = 0.f;
#pragma unroll 8
            for (int g = 0; g < 32; ++g) sum += red[(g * 3 + v) * 64 + c];
            MOD[(l * 3 + v) * 12288 + col0 + c] = sum + a->in[5][l * 12288 + col0 + c]; }
        __syncthreads();
    }
}
constexpr int MOE_STRIPS = 2 * NEXP * (DFFE / 64);
__device__ __forceinline__ void moe_colscale_item(ArgsP a, int s, int lane) {
    unsigned char* ws = a->ws;
    const int ew = s / (DFFE / 64), n0 = (s - ew * (DFFE / 64)) * 64, e = ew >> 1, w = ew & 1;
    const int drow = e * 2 * DFFE + (n0 >> 7) * 256 + (n0 & 127) + w * 128;
    const float* src = a->in[27 + w] + (size_t)e * D * DFFE + (size_t)(32 * (lane >> 4)) * DFFE + n0 + 4 * (lane & 15);
    f32x4 mx = {0.f, 0.f, 0.f, 0.f};
#pragma unroll
    for (int i = 0; i < 16; ++i) { const f32x4 v = *(const f32x4*)(src + (size_t)(128 * i) * DFFE);
        mx[0] = fmaxf(mx[0], fabsf(v[0])); mx[1] = fmaxf(mx[1], fabsf(v[1])); mx[2] = fmaxf(mx[2], fabsf(v[2])); mx[3] = fmaxf(mx[3], fabsf(v[3])); }
#pragma unroll
    for (int j = 0; j < 4; ++j) { mx[j] = fmaxf(mx[j], __shfl_xor(mx[j], 16)); mx[j] = fmaxf(mx[j], __shfl_xor(mx[j], 32)); }
    if (lane < 16) *(f32x4*)((float*)(ws + WS_CSM) + drow + 4 * lane) = mx * (1.9f / 127.0f);
}
constexpr int CV_IN = (D / 64) * (INC / 64), CV_OUT = (D / 64) * (D / 64), CV_F1 = (D / 64) * (DFF / 64), CV_F2 = (DFF / 64) * (D / 64);
constexpr int CVA_N = MOE_STRIPS + CV_OUT, CVB_N = CV_F2 + CV_OUT;
constexpr int I8_STRIPS = 2 * (DFF / 32);
__device__ __forceinline__ void conv_a_item(ArgsP a, int it, LAS float* scr, int lane) {
    unsigned char* ws = a->ws;
    if (it < MOE_STRIPS) { moe_colscale_item(a, it, lane); return; } it -= MOE_STRIPS;
    xpose_mat(a->in[9], D, D, (bf16*)(ws + WS_WOUT), false, 0, it, scr, lane);
}
__device__ __forceinline__ void conv_b_item(ArgsP a, int it, LAS float* scr, int lane) {
    unsigned char* ws = a->ws;
    if (it < CV_F2) { xpose_mat8(a->in[25], DFF, D, ws + WS_WF2, false, 0, pg8::S_W2, it, scr, lane); return; } it -= CV_F2;
    xpose_mat(a->in[9] + (size_t)D * D, D, D, (bf16*)(ws + WS_WOUT) + (size_t)D * D, false, 0, it, scr, lane);
}
constexpr int WIN_STRIPS = INC / 32;
__device__ __forceinline__ void win_strip(ArgsP a, LAS unsigned char* lds, int l, int s);
__device__ __forceinline__ void phase_prologue(ArgsP a, LAS unsigned char* lds) {
    const int tid = hide_tid(), lane = tid & 63, wave = tid >> 6, G = gridDim.x;
    unsigned char* ws = a->ws;
    if (G == 256) {
        if ((int)blockIdx.x < 176) mod_strips(a, lds, (int)blockIdx.x, 176, 176);
        __syncthreads();
        for (int s = (int)blockIdx.x - 176; s >= 0 && s < WIN_STRIPS; s += 80) win_strip(a, lds, 0, s);
    } else {
    const int nmod = G > 192 ? 192 : G;
    if ((int)blockIdx.x < nmod) mod_strips(a, lds, (int)blockIdx.x, 192, nmod);
    __syncthreads();
    if (G > nmod) { for (int s = (int)blockIdx.x - nmod; s >= 0 && s < WIN_STRIPS; s += G - nmod) win_strip(a, lds, 0, s); }
    else for (int s = (int)blockIdx.x; s < WIN_STRIPS; s += G) win_strip(a, lds, 0, s);
    }
}
template <bool SAMPLE>
__device__ __forceinline__ void i8_strip_core(const float* __restrict__ W0, int ldw, unsigned char* __restrict__ dst0, float* __restrict__ cs0, LAS unsigned char* lds) {
    const int tid = hide_tid(), lane = tid & 63, wave = tid >> 6;
    LAS float* scr = (LAS float*)(lds + wave * 16640);
    LAS float* cmax = (LAS float*)(lds + 8 * 16640);
    LAS float* csc = cmax + 512;
    const float* src = W0 + (size_t)(lane >> 4) * ldw + 4 * (lane & 15);
    f32x4 mx = {0.f, 0.f, 0.f, 0.f};
    for (int t = 0; t < (SAMPLE ? 1 : 4); ++t) { const int k0 = (wave + 8 * t) * 64;
#pragma unroll
        for (int i = 0; i < 16; ++i) { const f32x4 v = *(const f32x4*)(src + (size_t)(k0 + 4 * i) * ldw);
            mx[0] = fmaxf(mx[0], fabsf(v[0])); mx[1] = fmaxf(mx[1], fabsf(v[1])); mx[2] = fmaxf(mx[2], fabsf(v[2])); mx[3] = fmaxf(mx[3], fabsf(v[3])); } }
#pragma unroll
    for (int j = 0; j < 4; ++j) { mx[j] = fmaxf(mx[j], __shfl_xor(mx[j], 16)); mx[j] = fmaxf(mx[j], __shfl_xor(mx[j], 32)); }
    if (lane < 16) { cmax[wave * 64 + 4 * lane + 0] = mx[0]; cmax[wave * 64 + 4 * lane + 1] = mx[1]; cmax[wave * 64 + 4 * lane + 2] = mx[2]; cmax[wave * 64 + 4 * lane + 3] = mx[3]; }
    __syncthreads();
    if (tid < 64) { float m = 0.f;
#pragma unroll
        for (int q = 0; q < 8; ++q) m = fmaxf(m, cmax[q * 64 + tid]);
        if (SAMPLE) m *= 1.6f;
        csc[tid] = m > 1e-30f ? 127.0f / m : 0.f;
        cs0[tid] = m * (1.0f / 127.0f); }
    __syncthreads();
    f32x4 v[16], vn[16];
#pragma unroll
    for (int i = 0; i < 16; ++i) v[i] = __builtin_nontemporal_load((const f32x4*)(src + (size_t)(wave * 64 + 4 * i) * ldw));
#pragma unroll
    for (int t = 0; t < 4; ++t) { const int k0 = (wave + 8 * t) * 64;
        if (t < 3) {
#pragma unroll
            for (int i = 0; i < 16; ++i) vn[i] = __builtin_nontemporal_load((const f32x4*)(src + (size_t)(k0 + 512 + 4 * i) * ldw)); }
#pragma unroll
        for (int i = 0; i < 16; ++i) { LAS float* p = scr + (4 * i + (lane >> 4)) * 65 + 4 * (lane & 15); p[0] = v[i][0]; p[1] = v[i][1]; p[2] = v[i][2]; p[3] = v[i][3]; }
        asm volatile("s_waitcnt lgkmcnt(0)" ::: "memory");
        const int c = lane & 3;
#pragma unroll
        for (int j = 0; j < 4; ++j) { const int n = (lane >> 2) + 16 * j; const LAS float* p = scr + (16 * c) * 65 + n; const float q = csc[n];
            unsigned o[4];
#pragma unroll
            for (int g = 0; g < 4; ++g) { int qi[4];
#pragma unroll
                for (int e = 0; e < 4; ++e) qi[e] = (int)rintf(__builtin_amdgcn_fmed3f(p[(4 * g + e) * 65] * q, -127.f, 127.f));
                o[g] = (unsigned)(qi[0] & 255) | ((unsigned)(qi[1] & 255) << 8) | ((unsigned)(qi[2] & 255) << 16) | ((unsigned)(qi[3] & 255) << 24); }
            __builtin_nontemporal_store((u32x4){o[0], o[1], o[2], o[3]}, (u32x4*)(dst0 + (size_t)n * D + k0 + 16 * c)); }
        asm volatile("s_waitcnt lgkmcnt(0)" ::: "memory");
        if (t < 3) {
#pragma unroll
            for (int i = 0; i < 16; ++i) v[i] = vn[i]; }
    }
    __syncthreads();
}
__device__ __forceinline__ void i8_strip32(const float* __restrict__ W0, int ldw, unsigned char* __restrict__ dst0, float* __restrict__ cs0, LAS unsigned char* lds) {
    const int tid = hide_tid(), lane = tid & 63, wave = tid >> 6, wq = lane >> 3, wl = lane & 7;
    LAS unsigned* scr = (LAS unsigned*)(lds + wave * 16640);
    LAS float* cmax = (LAS float*)(lds + 8 * 16640);
    const float* src = W0 + (size_t)(wave * 256 + 4 * wq) * ldw + 4 * wl;
    f32x4 v[2][4][4];
#pragma unroll
    for (int t = 0; t < 2; ++t)
#pragma unroll
        for (int i = 0; i < 4; ++i)
#pragma unroll
            for (int r = 0; r < 4; ++r) v[t][i][r] = __builtin_nontemporal_load((const f32x4*)(src + (size_t)(128 * t + 32 * i + r) * ldw));
    f32x4 mx = {0.f, 0.f, 0.f, 0.f};
#pragma unroll
    for (int t = 0; t < 2; ++t)
#pragma unroll
        for (int i = 0; i < 4; ++i)
#pragma unroll
            for (int r = 0; r < 4; ++r)
#pragma unroll
                for (int e = 0; e < 4; ++e) mx[e] = fmaxf(mx[e], fabsf(v[t][i][r][e]));
#pragma unroll
    for (int e = 0; e < 4; ++e) { mx[e] = fmaxf(mx[e], __shfl_xor(mx[e], 8)); mx[e] = fmaxf(mx[e], __shfl_xor(mx[e], 16)); mx[e] = fmaxf(mx[e], __shfl_xor(mx[e], 32)); }
    if (wq == 0) { cmax[wave * 32 + 4 * wl + 0] = mx[0]; cmax[wave * 32 + 4 * wl + 1] = mx[1]; cmax[wave * 32 + 4 * wl + 2] = mx[2]; cmax[wave * 32 + 4 * wl + 3] = mx[3]; }
    __syncthreads();
    f32x4 q;
#pragma unroll
    for (int e = 0; e < 4; ++e) { float m = 0.f;
#pragma unroll
        for (int w = 0; w < 8; ++w) m = fmaxf(m, cmax[w * 32 + 4 * wl + e]);
        q[e] = m > 1e-30f ? 127.0f / m : 0.f;
        if (wave == 0 && wq == 0) cs0[4 * wl + e] = m * (1.0f / 127.0f); }
#pragma unroll
    for (int t = 0; t < 2; ++t) {
#pragma unroll
        for (int i = 0; i < 4; ++i)
#pragma unroll
            for (int e = 0; e < 4; ++e) { unsigned o = 0u;
#pragma unroll
                for (int r = 0; r < 4; ++r) o = __builtin_amdgcn_cvt_pk_u8_f32(__builtin_rintf(__builtin_amdgcn_fmed3f(v[t][i][r][e] * q[e], -127.f, 127.f)) + 128.0f, r, o);
                scr[(4 * wl + e) * 33 + 8 * i + wq] = o ^ 0x80808080u; }
        asm volatile("s_waitcnt lgkmcnt(0)" ::: "memory");
        const int c = lane & 7;
#pragma unroll
        for (int j = 0; j < 4; ++j) { const int n = (lane >> 3) + 8 * j; const LAS unsigned* s = scr + n * 33 + 4 * c;
            __builtin_nontemporal_store((u32x4){s[0], s[1], s[2], s[3]}, (u32x4*)(dst0 + (size_t)n * D + wave * 256 + 128 * t + 16 * c)); }
        asm volatile("s_waitcnt lgkmcnt(0)" ::: "memory");
    }
    __syncthreads();
}
__device__ __forceinline__ void i8_strip(ArgsP a, LAS unsigned char* lds, int s) {
    unsigned char* ws = a->ws;
    const int w = s / (DFF / 32), n0 = (s - w * (DFF / 32)) * 32;
    const int drow = (n0 >> 7) * 256 + (n0 & 127) + w * 128;
    i8_strip32(a->in[23 + w] + n0, DFF, ws + WS_WF13 + (size_t)drow * D, (float*)(ws + WS_CS) + drow, lds);
}
__device__ __forceinline__ void win_strip(ArgsP a, LAS unsigned char* lds, int l, int s) {
    unsigned char* ws = a->ws; const int n0 = s * 32;
    i8_strip32(a->in[8] + (size_t)l * D * INC + n0, INC, ws + WS_WIN + ((size_t)l * INC + n0) * D, (float*)(ws + WS_CSIN) + l * INC + n0, lds);
}
__device__ __forceinline__ void deferred_a(ArgsP a, LAS unsigned char* lds, int e, int nel) {
    const int tid = hide_tid(), lane = tid & 63, wave = tid >> 6;
    const int q = CVA_N / nel, r = CVA_N % nel, count = q + (e < r ? 1 : 0), first = e * q + (e < r ? e : r);
    LAS float* scr = (LAS float*)(lds + wave * 16640);
    for (int i = wave; i < count; i += NWAVES) conv_a_item(a, first + i, scr, lane);
}
constexpr int MOE_I = (D / 64) * (DFFE / 64);
constexpr int G1_STRIPS = 468;
constexpr int M1_G1 = 3432, M1_AT0 = 35988;
constexpr int M1_T2 = 1280, M1_T3 = 800, M1_T4 = 1280, M1_TAILS = M1_T2 + M1_T3 + M1_T4;
constexpr int G1_QUOTA = 17160;
__device__ __forceinline__ void quota(int seg0, int segn, int G, int c, int& first, int& count) { const int q = (segn + G - 1) / G; const int lo = c * q; first = seg0 + lo; count = lo >= segn ? 0 : (segn - lo < q ? segn - lo : q); }
struct MoeTile { const float* src; unsigned char* dst0; const float* cs; int ldw, ldd, k0; };
template <int which>
__device__ __forceinline__ MoeTile moe_tile(ArgsP a, int it, int lane) {
    unsigned char* ws = a->ws; MoeTile t;
    if (which == 0) { const int ew = it / MOE_I, r = it - ew * MOE_I, e = ew >> 1, w = ew & 1;
        const int ntn = DFFE >> 5, kb = r / ntn, nb = r - kb * ntn, k0 = kb * 128, n0 = nb * 32, drow = e * 2 * DFFE + (n0 >> 7) * 256 + (n0 & 127) + w * 128;
        t.ldw = DFFE; t.ldd = D; t.k0 = k0; t.src = a->in[27 + w] + (size_t)e * D * DFFE + (size_t)(k0 + 4 * (lane >> 3)) * DFFE + n0 + 4 * (lane & 7);
        t.dst0 = ws + WS_WM13 + (size_t)drow * D; t.cs = (const float*)(ws + WS_CSM) + drow + 4 * (lane & 7); }
    else { const int e = it / MOE_I, r = it - e * MOE_I, ntn = D >> 5, kb = r / ntn, nb = r - kb * ntn, k0 = kb * 128, n0 = nb * 32;
        t.ldw = D; t.ldd = 128; t.k0 = 0; t.src = a->in[29] + (size_t)e * DFFE * D + (size_t)(k0 + 4 * (lane >> 3)) * D + n0 + 4 * (lane & 7);
        t.dst0 = ws + WS_WM2 + ((size_t)((e * (D >> 8) + (n0 >> 8)) * (DFFE >> 7) + (k0 >> 7)) * 256 + (n0 & 255)) * 128; t.cs = nullptr; }
    return t;
}
template <int which>
__device__ __forceinline__ void moe_convert_t(ArgsP a, LAS unsigned char* lds, int first, int count) {
    const int tid = hide_tid(), lane = tid & 63, wave = tid >> 6;
    LAS unsigned* scr = (LAS unsigned*)(lds + wave * 16640);
    int k = wave; if (k >= count) return;
    MoeTile t0 = moe_tile<which>(a, first + k, lane), t1 = t0, t2 = t0;
    f32x4 v0[4][4], v1[4][4], v2[4][4];
#define MC_LOAD(vv, tt) do { _Pragma("unroll") for (int i = 0; i < 4; ++i) _Pragma("unroll") for (int r = 0; r < 4; ++r) vv[i][r] = __builtin_nontemporal_load((const f32x4*)(tt.src + (size_t)(32 * i + r) * tt.ldw)); } while (0)
    MC_LOAD(v0, t0);
    if (k + NWAVES < count) { t1 = moe_tile<which>(a, first + k + NWAVES, lane); MC_LOAD(v1, t1); }
    for (; k < count; k += NWAVES) {
        if (k + 2 * NWAVES < count) { t2 = moe_tile<which>(a, first + k + 2 * NWAVES, lane); MC_LOAD(v2, t2); }
        f32x4 q = {pg8::S_W2, pg8::S_W2, pg8::S_W2, pg8::S_W2};
        if (which == 0) { const f32x4 d = *(const f32x4*)t0.cs;
#pragma unroll
            for (int e = 0; e < 4; ++e) q[e] = d[e] > 1e-30f ? __builtin_amdgcn_rcpf(d[e]) : 0.f; }
        const int wq = lane >> 3, wl = lane & 7;
#pragma unroll
        for (int i = 0; i < 4; ++i)
#pragma unroll
            for (int e = 0; e < 4; ++e) { unsigned o;
                if (which == 0) { o = 0u;
#pragma unroll
                    for (int r = 0; r < 4; ++r) o = __builtin_amdgcn_cvt_pk_u8_f32(__builtin_rintf(__builtin_amdgcn_fmed3f(v0[i][r][e] * q[e], -127.f, 127.f)) + 128.0f, r, o);
                    o ^= 0x80808080u; }
                else o = pg8::pk4_fp8(v0[i][0][e] * q[e], v0[i][1][e] * q[e], v0[i][2][e] * q[e], v0[i][3][e] * q[e]);
                scr[(4 * wl + e) * 33 + 8 * i + wq] = o; }
        asm volatile("s_waitcnt lgkmcnt(0)" ::: "memory");
        const int c = lane & 7;
#pragma unroll
        for (int j = 0; j < 4; ++j) { const int n = (lane >> 3) + 8 * j; const LAS unsigned* s = scr + n * 33 + 4 * c;
            __builtin_nontemporal_store((u32x4){s[0], s[1], s[2], s[3]}, (u32x4*)(t0.dst0 + (size_t)n * t0.ldd + t0.k0 + 16 * c)); }
        asm volatile("s_waitcnt lgkmcnt(0)" ::: "memory");
        t0 = t1; t1 = t2;
#pragma unroll
        for (int i = 0; i < 4; ++i)
#pragma unroll
            for (int r = 0; r < 4; ++r) { v0[i][r] = v1[i][r]; v1[i][r] = v2[i][r]; }
    }
#undef MC_LOAD
}
__device__ __forceinline__ void moe_convert(ArgsP a, LAS unsigned char* lds, int which, int first, int count) { if (which == 0) moe_convert_t<0>(a, lds, first, count); else moe_convert_t<1>(a, lds, first, count); }
__device__ __forceinline__ void at_convert(ArgsP a, LAS unsigned char* lds, int l) {
    const int G = gridDim.x, c = (int)blockIdx.x; int f, n;
    if (l == 0) {
        mod_strips(a, lds, 192 + c, 384, G);
        if (G == 256 && c >= 240) mod_strips(a, lds, 176 + (c - 240), 192, G);
        __syncthreads();
        if (G == 256) {
            const int NS = I8_STRIPS + WIN_STRIPS;
            for (int k = 0; k < 3; ++k) { int s = -1;
                if (c >= 240) { if (k == 0) s = 144 + (c - 240); }
                else if (c >= 192) s = 3 * (c - 192) + k;
                else { if (k == 0) s = 160 + c; else if (k == 1 && c >= 48) s = 352 + (c - 48); }
                if (s >= 0 && s < NS) { if (s < I8_STRIPS) i8_strip(a, lds, s); else win_strip(a, lds, 1, s - I8_STRIPS); } } }
        else { const int NS = I8_STRIPS + WIN_STRIPS, nfree = G > 192 ? G - 192 : 0, hi = 3 * nfree < NS ? 3 * nfree : NS;
          if (c >= 192) { for (int j = 0; j < 3; ++j) { const int s = 3 * (c - 192) + j; if (s < hi) { if (s < I8_STRIPS) i8_strip(a, lds, s); else win_strip(a, lds, 1, s - I8_STRIPS); } } }
          else if (G == 256) {
              for (int k = 0; k < 2; ++k) { const int s = k == 0 ? hi + c : hi + 192 + (c - 80); if (k == 0 || c >= 80) { if (s < I8_STRIPS) i8_strip(a, lds, s); else if (s < NS) win_strip(a, lds, 1, s - I8_STRIPS); } } }
          else { const int nw = G > 192 ? 192 : G; for (int s = hi + c; s < NS; s += nw) { if (s < I8_STRIPS) i8_strip(a, lds, s); else win_strip(a, lds, 1, s - I8_STRIPS); } } }
        { const int tid = hide_tid(), lane = tid & 63, wave = tid >> 6; LAS float* scr = (LAS float*)(lds + wave * 16640);
          quota(0, CVB_N, G, c, f, n); for (int i = wave; i < n; i += NWAVES) conv_b_item(a, f + i, scr, lane); }
        __syncthreads();
        quota(M1_G1, M1_AT0, G, c, f, n); moe_convert(a, lds, 0, f, n);
    } else {
        quota(M1_G1 + M1_AT0, 2 * NEXP * MOE_I - M1_G1 - M1_AT0 - (G == 256 ? M1_TAILS : 0), G, c, f, n); moe_convert(a, lds, 0, f, n);
        __syncthreads();
        quota(0, NEXP * MOE_I, G, c, f, n); moe_convert(a, lds, 1, f, n);
    }
}
__device__ __forceinline__ void quota_bal_hi(int seg0, int n, int G, int c, int& first, int& count) { const int q = n / G, r = n % G, x = c - (G - r); count = q + (x >= 0 ? 1 : 0); first = seg0 + c * q + (x > 0 ? x : 0); }
__device__ __forceinline__ void quota_bal(int seg0, int n, int G, int c, int& first, int& count) { const int q = n / G, r = n % G; count = q + (c < r ? 1 : 0); first = seg0 + c * q + (c < r ? c : r); }

template <int SRC, bool ROUTER, int NSLAB, int OUT  >
__device__ __forceinline__ void phase_norm(ArgsP a, int l, int row_lo, const float* gvec, int ch_sh, int ch_sc, LAS unsigned char* lds = nullptr) {
    const int tid = hide_tid(), lane = tid & 63, wave = tid >> 6, G = gridDim.x;
    unsigned char* ws = a->ws;
    bf16* XW = (bf16*)(ws + WS_XW); bf16* HB = (bf16*)(ws + WS_HB);
    const float* MODL = (const float*)(ws + WS_MOD) + l * 3 * 12288;
    const int lane0 = lane;
    if (ROUTER) {
        LAS f32x4* RT = (LAS f32x4*)lds;
#pragma unroll
        for (int m = 0; m < 8; ++m) { const int id = tid + NTHR * m, ln = id & 63, h = (id >> 6) & 1, j = (id >> 7) & 3, q = id >> 9;
            RT[id] = *(const f32x4*)(a->in[26] + (size_t)(8 * (ln + 64 * j) + q) * NEXP + 4 * h); }
        __syncthreads();
    }
    for (int ridx = row_lo + blockIdx.x * NWAVES + wave; ridx < MROWS; ridx += G * NWAVES) {
        int row = ridx; if (NSLAB > 0) { row = ridx + (MROWS - 1024); if (row >= MROWS) row -= MROWS; }
        int lane = lane0; asm volatile("" : "+v"(lane));
        const bool isctx = row < 2 * LCTX;
        const int v = isctx ? 2 : ((row - 2 * LCTX) >> 12);
        float x[4][8];
        if (SRC == 0 || (SRC == 2 && isctx)) {
            const float* src = isctx ? a->in[2] + (size_t)row * D : a->in[0] + (size_t)(row - 2 * LCTX) * D;
#pragma unroll
            for (int j = 0; j < 4; ++j) { const f32x4 p = *(const f32x4*)(src + 8 * (lane + 64 * j)), q = *(const f32x4*)(src + 8 * (lane + 64 * j) + 4);
#pragma unroll
                for (int e = 0; e < 4; ++e) { x[j][e] = p[e]; x[j][4 + e] = q[e]; } }
        } else {
#pragma unroll
            for (int j = 0; j < 4; ++j) unpack8(*(const u32x4*)(XW + (size_t)row * D + 8 * (lane + 64 * j)), x[j]);
        }
        if (NSLAB > 0 && isctx) {
#pragma unroll
            for (int j = 0; j < 4; ++j) {
                const int c = 8 * (lane + 64 * j);
                const float* sl = (const float*)(ws + WS_SLAB) + (size_t)((((row >> 8) * 8 + (c >> 8)) * NSLAB)) * 65536 + (size_t)(row & 255) * 256 + (c & 255);
                for (int s = 0; s < NSLAB; ++s) { const f32x4 p = *(const f32x4*)(sl + (size_t)s * 65536), q = *(const f32x4*)(sl + (size_t)s * 65536 + 4);
#pragma unroll
                    for (int e = 0; e < 4; ++e) { x[j][e] += p[e]; x[j][4 + e] += q[e]; } }
                *(u32x4*)(XW + (size_t)row * D + c) = pack8(x[j]); }
        }
        float ss = 0.f;
#pragma unroll
        for (int j = 0; j < 4; ++j)
#pragma unroll
            for (int e = 0; e < 8; ++e) ss += x[j][e] * x[j][e];
        ss = wave_sum(ss);
        const float r = __builtin_amdgcn_rsqf(ss * (1.0f / D) + EPS);
        const float* sh = MODL + v * 12288 + ch_sh * 2048; const float* sc = MODL + v * 12288 + ch_sc * 2048;
        float lg[8];
        if (ROUTER) {
#pragma unroll
            for (int e = 0; e < 8; ++e) lg[e] = 0.f;
        }
#pragma unroll
        for (int j = 0; j < 4; ++j) {
            const int c = 8 * (lane + 64 * j);
            float h[8];
#pragma unroll
            for (int hf = 0; hf < 2; ++hf) { const f32x4 g = *(const f32x4*)(gvec + c + 4 * hf), s1 = *(const f32x4*)(sc + c + 4 * hf), s0 = *(const f32x4*)(sh + c + 4 * hf);
#pragma unroll
                for (int e = 0; e < 4; ++e) h[4 * hf + e] = (x[j][4 * hf + e] * r) * g[e] * (s1[e] + 1.0f) + s0[e]; }
            if (OUT == 1) { u32x2 o; o.x = pg8::pk4_fp8(h[0] * pg8::S_H, h[1] * pg8::S_H, h[2] * pg8::S_H, h[3] * pg8::S_H); o.y = pg8::pk4_fp8(h[4] * pg8::S_H, h[5] * pg8::S_H, h[6] * pg8::S_H, h[7] * pg8::S_H);
                *(u32x2*)((unsigned char*)HB + (size_t)row * D + c) = o; }
            else if (OUT == 0) *(u32x4*)(HB + (size_t)row * D + c) = pack8(h);
            if (OUT == 2 || ROUTER) {
#pragma unroll
                for (int e = 0; e < 8; ++e) x[j][e] = h[e]; }
        }
        if (OUT == 2) {
            float am = 0.f;
#pragma unroll
            for (int j = 0; j < 4; ++j)
#pragma unroll
                for (int e = 0; e < 8; ++e) am = fmaxf(am, fabsf(x[j][e]));
#pragma unroll
            for (int o = 1; o < 64; o <<= 1) am = fmaxf(am, __shfl_xor(am, o));
            const float qs = am > 1e-30f ? 127.0f / am : 0.f;
            if (lane == 0) ((float*)(ws + WS_RS))[row] = am * (1.0f / 127.0f);
#pragma unroll
            for (int j = 0; j < 4; ++j) { unsigned w[2];
#pragma unroll
                for (int hf = 0; hf < 2; ++hf) { const int q0 = (int)rintf(x[j][4 * hf + 0] * qs), q1 = (int)rintf(x[j][4 * hf + 1] * qs), q2 = (int)rintf(x[j][4 * hf + 2] * qs), q3 = (int)rintf(x[j][4 * hf + 3] * qs);
                    w[hf] = (unsigned)(q0 & 255) | ((unsigned)(q1 & 255) << 8) | ((unsigned)(q2 & 255) << 16) | ((unsigned)(q3 & 255) << 24); }
                *(u32x2*)((unsigned char*)HB + (size_t)row * D + 8 * (lane + 64 * j)) = (u32x2){w[0], w[1]}; }
        }
        if (ROUTER) {
#pragma unroll
            for (int j = 0; j < 4; ++j) {
                const LAS f32x4* RT = (const LAS f32x4*)lds;
#pragma unroll
                for (int q = 0; q < 8; ++q) { const f32x4 w0 = RT[((q * 4 + j) * 2 + 0) * 64 + lane], w1 = RT[((q * 4 + j) * 2 + 1) * 64 + lane];
                    lg[0] += x[j][q] * w0[0]; lg[1] += x[j][q] * w0[1]; lg[2] += x[j][q] * w0[2]; lg[3] += x[j][q] * w0[3];
                    lg[4] += x[j][q] * w1[0]; lg[5] += x[j][q] * w1[1]; lg[6] += x[j][q] * w1[2]; lg[7] += x[j][q] * w1[3]; }
                asm volatile("" ::: "memory");
            }
        }
        if (ROUTER) {
#pragma unroll
            for (int e = 0; e < 8; ++e) lg[e] = wave_sum(lg[e]);
            int e1 = 0; float v1 = lg[0];
#pragma unroll
            for (int e = 1; e < 8; ++e) if (lg[e] > v1) { v1 = lg[e]; e1 = e; }
            int e2 = -1; float v2 = -3.0e38f;
#pragma unroll
            for (int e = 0; e < 8; ++e) if (e != e1 && lg[e] > v2) { v2 = lg[e]; e2 = e; }
            if (lane == 0) {
                unsigned* cnt = (unsigned*)(ws + WS_CTL) + CW_CNT;
                const int p1 = (int)atomicAdd(cnt + 64 * e1, 1u), p2 = (int)atomicAdd(cnt + 64 * e2, 1u);
                const float g2 = 1.0f / (1.0f + __expf(v1 - v2)), g1 = 1.0f - g2;
                int* tk = (int*)(ws + WS_TOK) + (size_t)(row - 2 * LCTX) * 8;
                tk[0] = e1; tk[1] = e2; tk[2] = p1; tk[3] = p2; ((float*)tk)[4] = g1; ((float*)tk)[5] = g2;
            }
        }
    }
}

__device__ __forceinline__ void rope_angles(int pos, bool latent, int quarter_lane_i0  , bool colhalf, float expo_scale, float (&cs)[8], float (&sn)[8]) {
    const float p = latent ? (float)(colhalf ? (pos & 63) : (pos >> 6)) : 0.f;
#pragma unroll
    for (int e = 0; e < 8; ++e) {
        const float inv = __builtin_amdgcn_exp2f(-(float)(quarter_lane_i0 + e) * expo_scale);
        float rev = p * inv * 0.15915494309189535f; rev -= rintf(rev);
        cs[e] = latent ? __builtin_amdgcn_cosf(rev) : 1.f; sn[e] = latent ? __builtin_amdgcn_sinf(rev) : 0.f;
    }
}
__device__ __forceinline__ void phase_postproj(ArgsP a, int l, LAS unsigned char* lds) {
    const int tid = hide_tid(), lane = tid & 63, wave = tid >> 6, G = gridDim.x;
    unsigned char* ws = a->ws;
    bf16* PROJ = (bf16*)(ws + WS_PROJ); bf16* MIX = (bf16*)(ws + WS_MIX);
    const float LOG2_THETA = 13.287712379549449f;
    float gAq[8], gAk[8], gCq[8], gCk[8], cwv[3][8], gbv[8];
#pragma unroll
    for (int e = 0; e < 8; ++e) { gAq[e] = a->in[10][l * 64 + 8 * (lane & 7) + e]; gAk[e] = a->in[11][l * 64 + 8 * (lane & 7) + e]; gCq[e] = a->in[19][l * 128 + 8 * (lane & 15) + e]; gCk[e] = a->in[20][l * 128 + 8 * (lane & 15) + e];
        cwv[0][e] = a->in[17][l * 3 * 512 + 8 * lane + e]; cwv[1][e] = a->in[17][l * 3 * 512 + 512 + 8 * lane + e]; cwv[2][e] = a->in[17][l * 3 * 512 + 1024 + 8 * lane + e]; gbv[e] = a->in[18][l * 512 + 8 * lane + e]; }
    for (int row = blockIdx.x * NWAVES + wave; row < MROWS; row += G * NWAVES) {
        const bool latent = row >= 2 * LCTX;
        const int pos = latent ? ((row - 2 * LCTX) & (SEQ - 1)) : (row & (LCTX - 1));
        const int seglen = latent ? SEQ : LCTX;
        bf16* pr = PROJ + (size_t)row * INC;
        const u32x4 zero4 = {0u, 0u, 0u, 0u};
        u32x4 wA[2], wC[3], bC0 = zero4, bX0 = zero4, bC1, bX1, bC2 = zero4, bX2 = zero4, bB;
#pragma unroll
        for (int i = 0; i < 2; ++i) wA[i] = *(const u32x4*)(pr + (lane + 64 * i) * 8);
#pragma unroll
        for (int i = 0; i < 3; ++i) { const int chunk = lane + 64 * i; wC[i] = *(const u32x4*)(pr + C_CQ + (chunk < 160 ? chunk : 0) * 8); }
        bC1 = *(const u32x4*)(pr + C_BC + 8 * lane); bX1 = *(const u32x4*)(pr + C_BX + 8 * lane); bB = *(const u32x4*)(pr + C_BB + 8 * lane);
        if (pos > 0) { bC0 = *(const u32x4*)(pr - INC + C_BC + 8 * lane); bX0 = *(const u32x4*)(pr - INC + C_BX + 8 * lane); }
        if (pos < seglen - 1) { bC2 = *(const u32x4*)(pr + INC + C_BC + 8 * lane); bX2 = *(const u32x4*)(pr + INC + C_BX + 8 * lane); }
        {
            const int l8 = lane & 7;
            float cs[8], sn[8];
            rope_angles(pos, latent, 8 * (l8 & 1), l8 >= 4, 2.0f * LOG2_THETA / 32.0f, cs, sn);
            const bool minus = (l8 & 2) == 0;
#pragma unroll
            for (int i = 0; i < 2; ++i) {
                const int chunk = lane + 64 * i, vec = chunk >> 3; const bool isq = vec < 8;
                float f[8]; unpack8(wA[i], f);
                float ss = 0.f;
#pragma unroll
                for (int e = 0; e < 8; ++e) ss += f[e] * f[e];
                ss += __shfl_xor(ss, 1); ss += __shfl_xor(ss, 2); ss += __shfl_xor(ss, 4);
                const float r = __builtin_amdgcn_rsqf(ss * (1.0f / 64.0f) + EPS);
                const float qs = isq ? 0.125f * 1.4426950408889634f : 1.0f;
                float y[8], o[8];
#pragma unroll
                for (int e = 0; e < 8; ++e) y[e] = f[e] * r * (isq ? gAq[e] : gAk[e]);
#pragma unroll
                for (int e = 0; e < 8; ++e) { const float p = __shfl_xor(y[e], 2); o[e] = (y[e] * cs[e] + (minus ? -p : p) * sn[e]) * qs; }
                *(u32x4*)(pr + chunk * 8) = pack8(o);
            }
        }
        {
            const int l16 = lane & 15;
            float cs[8], sn[8];
            rope_angles(pos, latent, 8 * (l16 & 3), l16 >= 8, 2.0f * LOG2_THETA / 64.0f, cs, sn);
            const bool minus = (l16 & 4) == 0;
#pragma unroll
            for (int i = 0; i < 3; ++i) {
                const int chunk = lane + 64 * i; const bool act = chunk < 160; const int vec = chunk >> 4; const bool isq = vec < 8;
                bf16* p8 = pr + C_CQ + (act ? chunk : 0) * 8;
                float f[8]; unpack8(wC[i], f);
                float ss = 0.f;
#pragma unroll
                for (int e = 0; e < 8; ++e) ss += f[e] * f[e];
                ss += __shfl_xor(ss, 1); ss += __shfl_xor(ss, 2); ss += __shfl_xor(ss, 4); ss += __shfl_xor(ss, 8);
                const float r = __builtin_amdgcn_rsqf(ss * (1.0f / 128.0f) + EPS);
                const float qs = isq ? 0.08838834764831845f * 1.4426950408889634f : 1.0f;
                float y[8], o[8];
#pragma unroll
                for (int e = 0; e < 8; ++e) y[e] = f[e] * r * (isq ? gCq[e] : gCk[e]);
#pragma unroll
                for (int e = 0; e < 8; ++e) { const float p = __shfl_xor(y[e], 4); o[e] = (y[e] * cs[e] + (minus ? -p : p) * sn[e]) * qs; }
                if (act) *(u32x4*)p8 = pack8(o);
            }
        }
        {
            const int c0 = 8 * lane;
            float u0[8], u1[8], u2[8], fb[8], t0[8], t1[8];
            unpack8(bC1, t0); unpack8(bX1, t1);
#pragma unroll
            for (int e = 0; e < 8; ++e) u1[e] = t0[e] * t1[e];
            unpack8(bC0, t0); unpack8(bX0, t1);
#pragma unroll
            for (int e = 0; e < 8; ++e) u0[e] = t0[e] * t1[e];
            unpack8(bC2, t0); unpack8(bX2, t1);
#pragma unroll
            for (int e = 0; e < 8; ++e) u2[e] = t0[e] * t1[e];
            unpack8(bB, fb);
            float vv[8], ss = 0.f;
#pragma unroll
            for (int e = 0; e < 8; ++e) { vv[e] = fb[e] * (u0[e] * cwv[0][e] + u1[e] * cwv[1][e] + u2[e] * cwv[2][e]); ss += vv[e] * vv[e]; }
            ss = wave_sum(ss);
            const float r = __builtin_amdgcn_rsqf(ss * (1.0f / 512.0f) + EPS);
#pragma unroll
            for (int e = 0; e < 8; ++e) vv[e] = vv[e] * r * gbv[e];
            *(u32x4*)(MIX + (size_t)row * MIXW + 512 + c0) = pack8(vv);
        }
    }
    __syncthreads();
    {
        LAS unsigned short* tl = (LAS unsigned short*)lds;
        bf16* VTA = (bf16*)(ws + WS_VTA); bf16* VTC = (bf16*)(ws + WS_VTC);
        u32x4 wv[2];
#define VT_LOAD(itx) do { const int _hs = (itx) % 6, _q = (itx) / 6, _jt = _q % 68, _b = _q / 68; const int _col = _hs < 4 ? C_AV + _hs * 128 : C_CV + (_hs - 4) * 128; const int _r0 = rowmap(_b, _jt * 64); \
            _Pragma("unroll") for (int _i = 0; _i < 2; ++_i) { const int _idx = tid + 512 * _i; wv[_i] = *(const u32x4*)(PROJ + (size_t)(_r0 + (_idx >> 4)) * INC + _col + 8 * (_idx & 15)); } } while (0)
        const int it0 = G > 64 ? ((int)blockIdx.x + G - 64) % G : (int)blockIdx.x;
        if (it0 < NB * 68 * 6) VT_LOAD(it0);
        for (int it = it0; it < NB * 68 * 6; it += G) {
            const int hs = it % 6, q = it / 6, jt = q % 68, b = q / 68, j0 = jt * 64;
#pragma unroll
            for (int i = 0; i < 2; ++i) { const int idx = tid + 512 * i, key = idx >> 4, ch = idx & 15;
                *(LAS u32x4*)(tl + key * 136 + 8 * ch) = wv[i]; }
            if (it + G < NB * 68 * 6) VT_LOAD(it + G);
            __syncthreads();
            bf16* dst = hs < 4 ? VTA + (size_t)((b * 4 + hs) * 128) * NKEY : VTC + (size_t)((b * 2 + hs - 4) * 128) * NKEY;
#pragma unroll
            for (int i = 0; i < 2; ++i) { const int idx = tid + 512 * i, dv = idx >> 3, kc = idx & 7;
                unsigned short e[8];
#pragma unroll
                for (int k = 0; k < 8; ++k) { const int q = 8 * kc + k, key = (q & ~12) | ((q & 4) << 1) | ((q & 8) >> 1); e[k] = tl[key * 136 + dv]; }
                u32x4 o; o.x = e[0] | ((unsigned)e[1] << 16); o.y = e[2] | ((unsigned)e[3] << 16); o.z = e[4] | ((unsigned)e[5] << 16); o.w = e[6] | ((unsigned)e[7] << 16);
                *(u32x4*)(dst + (size_t)dv * NKEY + j0 + 8 * kc) = o; }
            __syncthreads();
        }
    }
}

constexpr int KT_STRIDE = 272, VT_STRIDE = 144, KT_BYTES = 64 * KT_STRIDE, VT_BYTES = 128 * VT_STRIDE, ATT_STAGE = KT_BYTES + VT_BYTES;
struct TileSched { int n, nloc, blk0; };
__device__ __forceinline__ int ts_j0(const TileSched& ts, int t) { return t < ts.nloc ? LCTX + (ts.blk0 + (t >> 1)) * 128 + (t & 1) * 64 : (t - ts.nloc) * 64; }

template <int DK, bool WINDOW>
__device__ __forceinline__ void attn_core(LAS unsigned char* lds, const bf16* __restrict__ proj, const bf16* __restrict__ vt, int b, int qrow_wave, int qcol, int ktile_col, int kwave_off, int qpos_wave,
                                          const TileSched ts, f32x16 (&O)[4], float& m_out, float& l_out) {
    const int tid = hide_tid(), lane = tid & 63, r = lane & 31, hh = lane >> 5;
    bf16x8 Qf[DK / 16];
    { const bf16* qp = proj + (size_t)(qrow_wave + r) * INC + qcol + 8 * hh;
#pragma unroll
      for (int ks = 0; ks < DK / 16; ++ks) Qf[ks] = *(const bf16x8*)(qp + 16 * ks); }
#pragma unroll
    for (int blk = 0; blk < 4; ++blk)
#pragma unroll
        for (int i = 0; i < 16; ++i) O[blk][i] = 0.f;
    float m = -__builtin_inff(), lsum = 0.f;
    const int qpos = qpos_wave + r;
    u32x4 kreg[2], vreg[2];
#define kkey (tid >> 4)
#define kch (tid & 15)
#define vdv (tid >> 3)
#define vch (tid & 7)
    LAS unsigned char* const kbuf = lds; LAS unsigned char* const vbuf = lds + 2 * KT_BYTES;
#define ATT_ISSUE_K(t) do { const int _r0 = rowmap(b, ts_j0(ts, (t))); \
        _Pragma("unroll") for (int _i = 0; _i < 2; ++_i) kreg[_i] = *(const u32x4*)(proj + (size_t)(_r0 + kkey + 32 * _i) * INC + ktile_col + 8 * kch); } while (0)
#define ATT_ISSUE_V(t) do { const int _j0 = ts_j0(ts, (t)); \
        _Pragma("unroll") for (int _i = 0; _i < 2; ++_i) vreg[_i] = *(const u32x4*)(vt + (size_t)(vdv + 64 * _i) * NKEY + _j0 + 8 * vch); } while (0)
#define ATT_COMMIT_K(buf) do { LAS unsigned char* _kt = kbuf + (buf) * KT_BYTES; \
        _Pragma("unroll") for (int _i = 0; _i < 2; ++_i) *(LAS u32x4*)(_kt + (kkey + 32 * _i) * KT_STRIDE + kch * 16) = kreg[_i]; } while (0)
#define ATT_COMMIT_V(buf) do { LAS unsigned char* _vl = vbuf + (buf) * VT_BYTES; \
        _Pragma("unroll") for (int _i = 0; _i < 2; ++_i) *(LAS u32x4*)(_vl + (vdv + 64 * _i) * VT_STRIDE + vch * 16) = vreg[_i]; } while (0)
#define ATT_QK(S, buf) do { const LAS unsigned char* _kt = kbuf + (buf) * KT_BYTES; \
        _Pragma("unroll") for (int kb = 0; kb < 2; ++kb) { _Pragma("unroll") for (int i = 0; i < 16; ++i) S[kb][i] = 0.f; \
            _Pragma("unroll") for (int ks = 0; ks < DK / 16; ++ks) { const bf16x8 ka = *(const LAS bf16x8*)(_kt + (32 * kb + r) * KT_STRIDE + (kwave_off + 16 * ks + 8 * hh) * 2); \
                S[kb] = __builtin_amdgcn_mfma_f32_32x32x16_bf16(ka, Qf[ks], S[kb], 0, 0, 0); } } } while (0)
#define ATT_SOFTMAX(S, tt, Pf, alpha) do { \
        if (WINDOW && (tt) < ts.nloc) { const int kpos0 = (ts.blk0 + ((tt) >> 1)) * 128 + ((tt) & 1) * 64; \
            _Pragma("unroll") for (int kb = 0; kb < 2; ++kb) _Pragma("unroll") for (int i = 0; i < 16; ++i) { const int d = kpos0 + 32 * kb + (i & 3) + 8 * (i >> 2) + 4 * hh - qpos; \
                if (d > 128 || d < -128) S[kb][i] = -__builtin_inff(); } } \
        float mx = S[0][0]; \
        _Pragma("unroll") for (int kb = 0; kb < 2; ++kb) _Pragma("unroll") for (int i = 0; i < 16; ++i) mx = fmaxf(mx, S[kb][i]); \
        mx = fmaxf(mx, __shfl_xor(mx, 32)); \
        alpha = 1.0f; \
        if (mx > m + 8.0f) { const float mo = m; m = mx; alpha = __builtin_amdgcn_exp2f(mo - mx); }     \
        const float muse = (m == -__builtin_inff()) ? 0.f : m; \
        float ps = 0.f; \
        _Pragma("unroll") for (int kb = 0; kb < 2; ++kb) _Pragma("unroll") for (int i = 0; i < 16; ++i) { const float p = __builtin_amdgcn_exp2f(S[kb][i] - muse); S[kb][i] = p; ps += p; } \
        lsum = lsum * alpha + ps; \
        _Pragma("unroll") for (int kb = 0; kb < 2; ++kb) _Pragma("unroll") for (int s = 0; s < 2; ++s) { u32x4 w; w.x = pk2(S[kb][8 * s + 0], S[kb][8 * s + 1]); w.y = pk2(S[kb][8 * s + 2], S[kb][8 * s + 3]); \
            w.z = pk2(S[kb][8 * s + 4], S[kb][8 * s + 5]); w.w = pk2(S[kb][8 * s + 6], S[kb][8 * s + 7]); Pf[kb][s] = __builtin_bit_cast(bf16x8, w); } } while (0)
#define ATT_RESCALE(alpha) do { if (__any(alpha != 1.0f)) { _Pragma("unroll") for (int blk = 0; blk < 4; ++blk) _Pragma("unroll") for (int i = 0; i < 16; ++i) O[blk][i] *= alpha; } } while (0)

    ATT_ISSUE_K(0); ATT_ISSUE_V(0);
    { u32x4 k1[2]; const bool h1 = ts.n > 1;
      if (h1) { const int r1 = rowmap(b, ts_j0(ts, 1));
#pragma unroll
          for (int i = 0; i < 2; ++i) k1[i] = *(const u32x4*)(proj + (size_t)(r1 + kkey + 32 * i) * INC + ktile_col + 8 * kch); }
      ATT_COMMIT_K(0); ATT_COMMIT_V(0);
      if (h1) { LAS unsigned char* kt1 = kbuf + KT_BYTES;
#pragma unroll
          for (int i = 0; i < 2; ++i) *(LAS u32x4*)(kt1 + (kkey + 32 * i) * KT_STRIDE + kch * 16) = k1[i]; } }
    __syncthreads();
    bf16x8 Pf[2][2];
    { f32x16 S[2]; float alpha; ATT_QK(S, 0); ATT_SOFTMAX(S, 0, Pf, alpha); (void)alpha; }
    __syncthreads();
    for (int t = 0; t < ts.n; ++t) {
        const bool has1 = t + 1 < ts.n, has2 = t + 2 < ts.n;
        if (has2) ATT_ISSUE_K(t + 2);
        if (has1) ATT_ISSUE_V(t + 1);
        f32x16 S[2];
        if (has1) ATT_QK(S, (t + 1) & 1);
        { const LAS unsigned char* vl = vbuf + (t & 1) * VT_BYTES;
#pragma unroll
          for (int blk = 0; blk < 4; ++blk)
#pragma unroll
            for (int kb = 0; kb < 2; ++kb)
#pragma unroll
                for (int s = 0; s < 2; ++s) { const bf16x8 va = *(const LAS bf16x8*)(vl + (32 * blk + r) * VT_STRIDE + (32 * kb + 16 * s + 8 * hh) * 2);
                    O[blk] = __builtin_amdgcn_mfma_f32_32x32x16_bf16(va, Pf[kb][s], O[blk], 0, 0, 0); } }
        if (has1) { float alpha; ATT_SOFTMAX(S, t + 1, Pf, alpha); ATT_RESCALE(alpha); }
        if (has2) ATT_COMMIT_K(t & 1);
        if (has1) ATT_COMMIT_V((t + 1) & 1);
        __syncthreads();
    }
#undef ATT_ISSUE_K
#undef ATT_ISSUE_V
#undef ATT_COMMIT_K
#undef ATT_COMMIT_V
#undef ATT_QK
#undef ATT_SOFTMAX
#undef ATT_RESCALE
#undef kkey
#undef kch
#undef vdv
#undef vch
    m_out = m; l_out = lsum + __shfl_xor(lsum, 32);
}

__device__ __forceinline__ void phase_attention(ArgsP a, int l, LAS unsigned char* lds, int cv_slot) {
    const int tid = hide_tid(), lane = tid & 63, wave = __builtin_amdgcn_readfirstlane(tid >> 6), G = gridDim.x;
    unsigned char* ws = a->ws;
    const bf16* PROJ = (const bf16*)(ws + WS_PROJ); bf16* MIX = (bf16*)(ws + WS_MIX); float* SSQ = (float*)(ws + WS_SSQ);
    const bf16* VTA = (const bf16*)(ws + WS_VTA); const bf16* VTC = (const bf16*)(ws + WS_VTC);
    const int nctx = (l == 0) ? 16 : 0, total = 512 + 2 * nctx;
    const float lam_init = (l == 0) ? 0.2f : 0.35550906f;
    float lam;
    { const float q1 = a->in[12][l * 64 + lane], k1 = a->in[13][l * 64 + lane], q2 = a->in[14][l * 64 + lane], k2 = a->in[15][l * 64 + lane];
      const float d1 = wave_sum(q1 * k1), d2 = wave_sum(q2 * k2); lam = __expf(d1) - __expf(d2) + lam_init; }
    const int nunits = (int)blockIdx.x < total ? (total - (int)blockIdx.x + G - 1) / G : 0, slotpos = cv_slot < nunits ? cv_slot : nunits;
    for (int st = 0; st <= nunits; ++st) {
        if (st == slotpos) { __syncthreads(); at_convert(a, lds, l); __syncthreads(); }
        if (st == nunits) break;
        const int w = (int)blockIdx.x + st * G;
        const bool isA = (w < 256) || (w >= 512 && w < 512 + nctx);
        const bool isctx = w >= 512;
        if (isA) {
            int b, h, qb;
            if (!isctx) { const int bh = w & 7; b = bh >> 2; h = bh & 3; qb = w >> 3; } else { const int q = w - 512; b = q >> 3; h = (q >> 1) & 3; qb = q & 1; }
            const int comp = wave >> 2, rg = wave & 3;
            const int qrow0 = isctx ? b * LCTX + qb * 128 : 2 * LCTX + b * SEQ + qb * 128;
            TileSched ts; ts.nloc = 0; ts.blk0 = 0; ts.n = isctx ? 4 : 68;
            f32x16 O[4]; float m, ls;
            attn_core<64, false>(lds, PROJ, VTA + (size_t)((b * 4 + h) * 128) * NKEY, b, qrow0 + rg * 32, C_AQ + h * 128 + comp * 64, C_AK + h * 128, comp * 64, 0, ts, O, m, ls);
            const float inv = 1.0f / ls;
            const int lz = hide_tid() & 63, r = lz & 31, hh = lz >> 5, lane = lz;
            LAS float* ex = (LAS float*)lds;
            if (comp == 1) {
#pragma unroll
                for (int blk = 0; blk < 4; ++blk)
#pragma unroll
                    for (int i = 0; i < 16; ++i) ex[(rg * 64 + blk * 16 + i) * 64 + lane] = O[blk][i] * inv;
            }
            __syncthreads();
            if (comp == 0) {
                float ss = 0.f;
#pragma unroll
                for (int blk = 0; blk < 4; ++blk)
#pragma unroll
                    for (int i = 0; i < 16; ++i) { const float o = O[blk][i] * inv - lam * ex[(rg * 64 + blk * 16 + i) * 64 + lane]; O[blk][i] = o; ss += o * o; }
                ss += __shfl_xor(ss, 32);
                const float rn = __builtin_amdgcn_rsqf(ss * (1.0f / 128.0f) + EPS) * (1.0f - lam_init);
                const float* sg = a->in[16] + l * 128;
                bf16* orow = MIX + (size_t)(qrow0 + rg * 32 + r) * MIXW + h * 128;
#pragma unroll
                for (int blk = 0; blk < 4; ++blk)
#pragma unroll
                    for (int g4 = 0; g4 < 4; ++g4) { const int dv = 32 * blk + 8 * g4 + 4 * hh; const f32x4 gg = *(const f32x4*)(sg + dv);
                        u32x2 o; o.x = pk2(O[blk][4 * g4 + 0] * rn * gg[0], O[blk][4 * g4 + 1] * rn * gg[1]); o.y = pk2(O[blk][4 * g4 + 2] * rn * gg[2], O[blk][4 * g4 + 3] * rn * gg[3]);
                        *(u32x2*)(orow + dv) = o; }
            }
            __syncthreads();
        } else {
            int b, kvh, hp, qb;
            if (!isctx) { const int q = w - 256, cb = q & 7; b = cb >> 2; kvh = (cb >> 1) & 1; hp = cb & 1; qb = q >> 3; }
            else { const int q = w - 512 - nctx; b = q >> 3; kvh = (q >> 2) & 1; hp = (q >> 1) & 1; qb = q & 1; }
            const int head = kvh * 4 + hp * 2 + (wave >> 2), rg = wave & 3;
            const int qrow0 = isctx ? b * LCTX + qb * 128 : 2 * LCTX + b * SEQ + qb * 128;
            TileSched ts;
            if (isctx) { ts.nloc = 0; ts.blk0 = 0; ts.n = 4; }
            else { const int lo = qb > 0 ? qb - 1 : 0, hi = qb < 31 ? qb + 1 : 31; ts.blk0 = lo; ts.nloc = 2 * (hi - lo + 1); ts.n = ts.nloc + 4; }
            f32x16 O[4]; float m, ls;
            attn_core<128, true>(lds, PROJ, VTC + (size_t)((b * 2 + kvh) * 128) * NKEY, b, qrow0 + rg * 32, C_CQ + head * 128, C_CK + kvh * 128, 0, qb * 128 + rg * 32, ts, O, m, ls);
            const int lz = hide_tid() & 63, r = lz & 31, hh = lz >> 5;
            const float sink = a->in[21][l * 8 + head] * 1.4426950408889634f;
            const float inv = 1.0f / (ls + __builtin_amdgcn_exp2f(sink - m));
            float ss = 0.f;
            bf16* orow = MIX + (size_t)(qrow0 + rg * 32 + r) * MIXW + 1024 + head * 128;
#pragma unroll
            for (int blk = 0; blk < 4; ++blk)
#pragma unroll
                for (int g4 = 0; g4 < 4; ++g4) { const int dv = 32 * blk + 8 * g4 + 4 * hh;
                    const float o0 = O[blk][4 * g4 + 0] * inv, o1 = O[blk][4 * g4 + 1] * inv, o2 = O[blk][4 * g4 + 2] * inv, o3 = O[blk][4 * g4 + 3] * inv;
                    ss += o0 * o0 + o1 * o1 + o2 * o2 + o3 * o3;
                    const f32x4 gc = *(const f32x4*)(a->in[22] + l * 1024 + head * 128 + dv);
                    u32x2 o; o.x = pk2(o0 * gc[0], o1 * gc[1]); o.y = pk2(o2 * gc[2], o3 * gc[3]); *(u32x2*)(orow + dv) = o; }
            ss += __shfl_xor(ss, 32);
            if (hh == 0) SSQ[(size_t)(qrow0 + rg * 32 + r) * 8 + head] = ss;
        }
    }
}

__device__ __forceinline__ void phase_normc(ArgsP a, int l) {
    const int tid = hide_tid(), lane = tid & 63, wave = tid >> 6, G = gridDim.x;
    unsigned char* ws = a->ws; bf16* MIX = (bf16*)(ws + WS_MIX); const float* SSQ = (const float*)(ws + WS_SSQ);
    const int row_lo = (l == 0) ? 0 : 2 * LCTX;
    for (int row = row_lo + blockIdx.x * NWAVES + wave; row < MROWS; row += G * NWAVES) {
        const f32x4 s0 = *(const f32x4*)(SSQ + (size_t)row * 8), s1 = *(const f32x4*)(SSQ + (size_t)row * 8 + 4);
        const float ss = (s0[0] + s0[1]) + (s0[2] + s0[3]) + (s1[0] + s1[1]) + (s1[2] + s1[3]);
        const float rn = __builtin_amdgcn_rsqf(ss * (1.0f / 1024.0f) + EPS);
#pragma unroll
        for (int i = 0; i < 2; ++i) { const int c = 8 * (lane + 64 * i); bf16* p = MIX + (size_t)row * MIXW + 1024 + c;
            float f[8]; unpack8(*(const u32x4*)p, f); const float* g = a->in[22] + l * 1024 + c;
#pragma unroll
            for (int e = 0; e < 8; ++e) f[e] = f[e] * rn * g[e];
            *(u32x4*)p = pack8(f); }
    }
}

__device__ __forceinline__ int moe_offsets(const unsigned* cnt, int (&off)[NEXP], int (&cn)[NEXP]) {
    int o = 0;
#pragma unroll
    for (int e = 0; e < NEXP; ++e) { cn[e] = (int)cnt[64 * e]; off[e] = o; o += (cn[e] + 255) & ~255; }
    return o >> 8;
}
__device__ __forceinline__ void phase_gather(ArgsP a) {
    const int tid = hide_tid(), lane = tid & 63, wave = tid >> 6, G = gridDim.x;
    unsigned char* ws = a->ws;
    const unsigned* cnt = (const unsigned*)(ws + WS_CTL) + CW_CNT;
    int off[NEXP], cn[NEXP]; const int npan = moe_offsets(cnt, off, cn);
    if (blockIdx.x == 0 && tid == 0) { int* pe = (int*)(ws + WS_CTL) + CW_PEXP; pe[96] = npan;
#pragma unroll
        for (int e = 0; e < NEXP; ++e) { const int p0 = off[e] >> 8, np = (cn[e] + 255) >> 8; for (int p = 0; p < np; ++p) pe[p0 + p] = e; } }
    if (blockIdx.x == 0) { int NF, R, SK; pg8::moe_tail_params(npan, D / 256, G, NF, R, SK); pg8::StaticOrder so; so.init(npan, D / 256, G, 0, DFFE / 128);
        if (tid < R) { pg8::Unit u; so.map(NF + tid, u); ((int*)(ws + WS_CTL) + CW_TMODE)[u.pm * 8 + u.pn] = tid + 1; } }
    const unsigned char* HB = ws + WS_HB; unsigned char* HP = ws + WS_HPERM;
    const int gw = blockIdx.x * NWAVES + wave, NGW = G * NWAVES;
    for (int t = gw; t < NB * SEQ; t += NGW) {
        int* tk = (int*)(ws + WS_TOK) + (size_t)t * 8;
        const int e1 = tk[0], e2 = tk[1], p1 = tk[2], p2 = tk[3];
        int s1 = 0, s2 = 0;
#pragma unroll
        for (int e = 0; e < NEXP; ++e) { if (e == e1) s1 = off[e] + p1; if (e == e2) s2 = off[e] + p2; }
        if (lane == 0) { tk[6] = s1; tk[7] = s2; const float rs = ((const float*)(ws + WS_RS))[2 * LCTX + t]; ((float*)(ws + WS_RSS))[s1] = rs; ((float*)(ws + WS_RSS))[s2] = rs; }
        const u32x4* src = (const u32x4*)(HB + (size_t)(2 * LCTX + t) * D);
        u32x4* d1 = (u32x4*)(HP + (size_t)s1 * D); u32x4* d2 = (u32x4*)(HP + (size_t)s2 * D);
#pragma unroll
        for (int i = 0; i < 2; ++i) { const u32x4 v = src[lane + 64 * i]; d1[lane + 64 * i] = v; d2[lane + 64 * i] = v; }
    }
#pragma unroll
    for (int e = 0; e < NEXP; ++e) { const int npad = ((cn[e] + 255) & ~255) - cn[e];
        for (int p = gw; p < npad; p += NGW) { u32x4* d = (u32x4*)(HP + (size_t)(off[e] + cn[e] + p) * D);
#pragma unroll
            for (int i = 0; i < 2; ++i) d[lane + 64 * i] = (u32x4){0u, 0u, 0u, 0u};
            if (lane == 0) ((float*)(ws + WS_RSS))[off[e] + cn[e] + p] = 0.f; } }
}
__device__ __forceinline__ void slab_sum(const float* slab, int mode, int SK, int slot, int c, float (&y)[8]) {
#pragma unroll
    for (int e = 0; e < 8; ++e) y[e] = 0.f;
    for (int s = 0; s < SK; ++s) { const float* p = slab + (size_t)((mode - 1) * SK + s) * 65536 + (slot & 255) * 256 + (c & 255);
        const f32x4 a0 = *(const f32x4*)p, a1 = *(const f32x4*)(p + 4);
#pragma unroll
        for (int e = 0; e < 4; ++e) { y[e] += a0[e]; y[4 + e] += a1[e]; } }
}
__device__ __forceinline__ void phase_combine(ArgsP a, int l) {
    const int tid = hide_tid(), lane = tid & 63, wave = tid >> 6, G = gridDim.x;
    unsigned char* ws = a->ws;
    const bf16* XW = (const bf16*)(ws + WS_XW); const bf16* YS = (const bf16*)(ws + WS_YS); const float* slab = (const float*)(ws + WS_SLAB);
    const float* MODL = (const float*)(ws + WS_MOD) + l * 3 * 12288;
    const int* tmode = (const int*)(ws + WS_CTL) + CW_TMODE;
    int NF, R, SK; pg8::moe_tail_params(((const int*)(ws + WS_CTL) + CW_PEXP)[96], D / 256, G, NF, R, SK);
    for (int t = blockIdx.x * NWAVES + wave; t < NB * SEQ; t += G * NWAVES) {
        const int* tk = (const int*)(ws + WS_TOK) + (size_t)t * 8;
        const float g1 = ((const float*)tk)[4], g2 = ((const float*)tk)[5]; const int s1 = tk[6], s2 = tk[7];
        const float* gf = MODL + (t >> 12) * 12288 + 5 * 2048;
        const bf16* xr = XW + (size_t)(2 * LCTX + t) * D; float* orow = a->out + (size_t)t * D;
        int m1[4], m2[4];
#pragma unroll
        for (int i = 0; i < 4; ++i) { const int ct = (lane + 64 * i) >> 5; m1[i] = tmode[(s1 >> 8) * 8 + ct]; m2[i] = tmode[(s2 >> 8) * 8 + ct]; }
        u32x4 w1[4], w2[4], wx[4]; f32x4 ga[4], gb[4];
#pragma unroll
        for (int i = 0; i < 4; ++i) { const int c = 8 * (lane + 64 * i);
            w1[i] = (u32x4){0u, 0u, 0u, 0u}; w2[i] = (u32x4){0u, 0u, 0u, 0u};
            if (m1[i] == 0) w1[i] = *(const u32x4*)(YS + (size_t)s1 * D + c);
            if (m2[i] == 0) w2[i] = *(const u32x4*)(YS + (size_t)s2 * D + c);
            wx[i] = *(const u32x4*)(xr + c); ga[i] = *(const f32x4*)(gf + c); gb[i] = *(const f32x4*)(gf + c + 4); }
#pragma unroll
        for (int i = 0; i < 4; ++i) { const int c = 8 * (lane + 64 * i);
            float y1[8], y2[8], xv[8];
            if (m1[i] == 0) unpack8(w1[i], y1); else slab_sum(slab, m1[i], SK, s1, c, y1);
            if (m2[i] == 0) unpack8(w2[i], y2); else slab_sum(slab, m2[i], SK, s2, c, y2);
            unpack8(wx[i], xv);
            f32x4 o0, o1;
#pragma unroll
            for (int e = 0; e < 4; ++e) { o0[e] = xv[e] + ga[i][e] * (g1 * y1[e] + g2 * y2[e]); o1[e] = xv[4 + e] + gb[i][e] * (g1 * y1[4 + e] + g2 * y2[4 + e]); }
            *(f32x4*)(orow + c) = o0; *(f32x4*)(orow + c + 4) = o1; }
    }
}

constexpr int NPHASE = 21;
__global__ void __launch_bounds__(NTHR, 2) mk_fwd(Args args) {
    extern __shared__ __attribute__((aligned(16))) unsigned char lds_raw[];
    LAS unsigned char* lds = (LAS unsigned char*)lds_raw;
    volatile LAS unsigned* MISC = (volatile LAS unsigned*)(lds + MISC_OFF);
    const int tid = threadIdx.x, G = gridDim.x;
    ArgsP ap = (ArgsP)__builtin_amdgcn_kernarg_segment_ptr();
    unsigned char* ws = ap->ws;
    unsigned* ctl = (unsigned*)(ws + WS_CTL);
    if (tid < 64) MISC[tid] = 0u;
    __syncthreads();
    const int lo = ap->ph_lo, hi = ap->ph_hi;
    XcdBarrier bar; bar.bar = ctl + CW_BAR; bar.x = 0; bar.st = nullptr;
    if (hi - lo > 1) bar = xcd_barrier_post(ctl + CW_BAR, MISC + 8);
#define IN(k) (lo <= (k) && (k) < hi)
#define SEAM(k) do { if (IN(k) && IN((k) + 1)) xcd_barrier(bar); } while (0)
    const float* MOD = (const float*)(ws + WS_MOD);
    bf16* HB = (bf16*)(ws + WS_HB); bf16* PROJ = (bf16*)(ws + WS_PROJ); bf16* MIX = (bf16*)(ws + WS_MIX); bf16* XW = (bf16*)(ws + WS_XW);
    bf16* ACT = (bf16*)(ws + WS_ACT);

    if (IN(0)) phase_prologue(ap, lds);
    SEAM(0);
    { constexpr int l = 0;
        const int pb = (l == 0) ? 1 : 10;
        if (IN(pb + 0)) { if (l == 0) phase_norm<0, false, 0, 2>(ap, 0, 0, ap->in[6], 0, 1); else phase_norm<1, false, 11, 2>(ap, 1, 0, ap->in[6] + D, 0, 1); }
        SEAM(pb + 0);
        if (IN(pb + 1)) { pg8::Gemm g{HB, (const bf16*)(ws + WS_WIN + (size_t)l * INC * D), D / 2}; pg8::RangeOrder<pg8::StaticOrder> S; S.so.init(MROWS / 256, INC / 256, G, (int)blockIdx.x, D / 128);
            pg8::EpiStoreI8 E{PROJ, INC, (const float*)(ws + WS_RS), (const float*)(ws + WS_CSIN) + l * INC};
            S.i0 = 0; S.n = 1 << 30; pg8::gemm_phase<2>(lds, g, S, E);
            { const int rem = S.so.nwg % G; const bool all = rem == 0; const int nel = all ? G : G - rem, e = all ? (int)blockIdx.x : (int)blockIdx.x - rem;
              __syncthreads();
              if (e >= 0) { if (l == 0) deferred_a(ap, lds, e, nel); else { int f, n; quota(0, M1_G1, nel, e, f, n); moe_convert(ap, lds, 0, f, n); } } } }
        SEAM(pb + 1);
        if (IN(pb + 2)) phase_postproj(ap, l, lds);
        SEAM(pb + 2);
        if (IN(pb + 3)) { phase_attention(ap, l, lds, ((int)blockIdx.x >> 3) % 3); __syncthreads(); }
        SEAM(pb + 3);
        if (IN(pb + 5)) { pg8::Gemm g{MIX, (const bf16*)(ws + WS_WOUT) + (size_t)l * D * D, MIXW};
            pg8::EpiResidT<l == 0, true> E{XW, MOD + l * 3 * 12288, 2, (float*)(ws + WS_SLAB), 1.0f};
            pg8::CtxTailOrder S; S.so.init(32, D / 256, G, (int)blockIdx.x, MIXW / 64); S.SK = (l == 0) ? 8 : 0; S.two = 1;
            pg8::gemm_phase<0>(lds, g, S, E);
            if (l == 0 && G == 256 && (int)blockIdx.x >= 128) { int f, n; __syncthreads(); quota(2 * NEXP * MOE_I - M1_TAILS, M1_T2, 128, (int)blockIdx.x - 128, f, n); moe_convert(ap, lds, 0, f, n); } }
        SEAM(pb + 5);
        if (IN(pb + 6)) { if (l == 0) phase_norm<2, false, 8, 2>(ap, 0, 0, ap->in[7], 3, 4); else phase_norm<1, true, 0, 2>(ap, 1, 2 * LCTX, ap->in[7] + D, 3, 4, lds); }
        SEAM(pb + 6);
        if (l == 0) {
            if (IN(8)) { pg8::Gemm g{HB, (const bf16*)(ws + WS_WF13), D / 2}; pg8::RangeOrder<pg8::StaticOrder> S; S.so.init(MROWS / 256, 2 * DFF / 256, G, (int)blockIdx.x, D / 128);
                pg8::EpiSwigluI8 E{(unsigned char*)ACT, -(DFF / 128), (const float*)(ws + WS_RS), (const float*)(ws + WS_CS)};
                S.i0 = 0; S.n = 1 << 30; pg8::gemm_phase<2>(lds, g, S, E);
                if (G == 256 && (int)blockIdx.x >= 216) { int f, n; __syncthreads(); quota(2 * NEXP * MOE_I - M1_TAILS + M1_T2, M1_T3, 40, (int)blockIdx.x - 216, f, n); moe_convert(ap, lds, 0, f, n); } }
            SEAM(8);
            if (IN(9)) { pg8::Gemm g{ACT, (const bf16*)(ws + WS_WF2), DFF / 2}; pg8::CtxTailOrder S; S.so.init(32, D / 256, G, (int)blockIdx.x, DFF / 128); S.SK = 11; S.two = 0;
                pg8::EpiResidT<false, false> E{XW, MOD, 5, (float*)(ws + WS_SLAB), pg8::DS2}; pg8::gemm_phase<1, pg8::EpiResidT<false, false>, pg8::CtxTailOrder, true>(lds, g, S, E);
                if (G == 256 && (int)blockIdx.x >= 176) { int f, n; __syncthreads(); quota(2 * NEXP * MOE_I - M1_TAILS + M1_T2 + M1_T3, M1_T4, 80, (int)blockIdx.x - 176, f, n); moe_convert(ap, lds, 0, f, n); } }
            SEAM(9);
        } else {
            if (IN(17)) phase_gather(ap);
            SEAM(17);
            const int* pexp = (const int*)ctl + CW_PEXP;
            if (IN(18)) { const int npan = __builtin_amdgcn_readfirstlane(pexp[96]);
                pg8::Gemm g{(const bf16*)(ws + WS_HPERM), (const bf16*)(ws + WS_WM13), D / 2}; pg8::RangeOrder<pg8::MoeOrder> S; S.so.so.init(npan, 2 * DFFE / 256, G, (int)blockIdx.x, D / 128); S.so.pexp = pexp;
                pg8::EpiSwigluI8 E{(unsigned char*)ACT, -(DFFE / 128), (const float*)(ws + WS_RSS), (const float*)(ws + WS_CSM)};
                S.i0 = 0; S.n = 1 << 30; pg8::gemm_phase<2>(lds, g, S, E); }
            SEAM(18);
            if (IN(19)) { const int npan = __builtin_amdgcn_readfirstlane(pexp[96]);
                pg8::Gemm g{ACT, (const bf16*)(ws + WS_WM2), DFFE / 2}; pg8::MoeTailOrder S; S.so.init(npan, D / 256, G, (int)blockIdx.x, DFFE / 128); S.pexp = pexp; pg8::moe_tail_params(npan, D / 256, G, S.NF, S.R, S.SK);
                pg8::EpiStoreBf16T<false> E{(bf16*)(ws + WS_YS), D, (float*)(ws + WS_SLAB), pg8::DS2}; pg8::gemm_phase<1, pg8::EpiStoreBf16T<false>, pg8::MoeTailOrder, true>(lds, g, S, E); }
            SEAM(19);
            if (IN(20)) phase_combine(ap, 1);
        }
    }
    { constexpr int l = 1;
        const int pb = (l == 0) ? 1 : 10;
        if (IN(pb + 0)) { if (l == 0) phase_norm<0, false, 0, 2>(ap, 0, 0, ap->in[6], 0, 1); else phase_norm<1, false, 11, 2>(ap, 1, 0, ap->in[6] + D, 0, 1); }
        SEAM(pb + 0);
        if (IN(pb + 1)) { pg8::Gemm g{HB, (const bf16*)(ws + WS_WIN + (size_t)l * INC * D), D / 2}; pg8::RangeOrder<pg8::StaticOrder> S; S.so.init(MROWS / 256, INC / 256, G, (int)blockIdx.x, D / 128);
            pg8::EpiStoreI8 E{PROJ, INC, (const float*)(ws + WS_RS), (const float*)(ws + WS_CSIN) + l * INC};
            S.i0 = 0; S.n = 1 << 30; pg8::gemm_phase<2>(lds, g, S, E);
            { const int rem = S.so.nwg % G; const bool all = rem == 0; const int nel = all ? G : G - rem, e = all ? (int)blockIdx.x : (int)blockIdx.x - rem;
              __syncthreads();
              if (e >= 0) { if (l == 0) deferred_a(ap, lds, e, nel); else { int f, n; quota(0, M1_G1, nel, e, f, n); moe_convert(ap, lds, 0, f, n); } } } }
        SEAM(pb + 1);
        if (IN(pb + 2)) phase_postproj(ap, l, lds);
        SEAM(pb + 2);
        if (IN(pb + 3)) { phase_attention(ap, l, lds, ((int)blockIdx.x >> 3) % 3); __syncthreads(); }
        SEAM(pb + 3);
        if (IN(pb + 5)) { pg8::Gemm g{MIX, (const bf16*)(ws + WS_WOUT) + (size_t)l * D * D, MIXW};
            pg8::EpiResidT<l == 0, true> E{XW, MOD + l * 3 * 12288, 2, (float*)(ws + WS_SLAB), 1.0f};
            pg8::CtxTailOrder S; S.so.init(32, D / 256, G, (int)blockIdx.x, MIXW / 64); S.SK = (l == 0) ? 8 : 0; S.two = 1;
            pg8::gemm_phase<0>(lds, g, S, E);
            if (l == 0 && G == 256 && (int)blockIdx.x >= 128) { int f, n; __syncthreads(); quota(2 * NEXP * MOE_I - M1_TAILS, M1_T2, 128, (int)blockIdx.x - 128, f, n); moe_convert(ap, lds, 0, f, n); } }
        SEAM(pb + 5);
        if (IN(pb + 6)) { if (l == 0) phase_norm<2, false, 8, 2>(ap, 0, 0, ap->in[7], 3, 4); else phase_norm<1, true, 0, 2>(ap, 1, 2 * LCTX, ap->in[7] + D, 3, 4, lds); }
        SEAM(pb + 6);
        if (l == 0) {
            if (IN(8)) { pg8::Gemm g{HB, (const bf16*)(ws + WS_WF13), D / 2}; pg8::RangeOrder<pg8::StaticOrder> S; S.so.init(MROWS / 256, 2 * DFF / 256, G, (int)blockIdx.x, D / 128);
                pg8::EpiSwigluI8 E{(unsigned char*)ACT, -(DFF / 128), (const float*)(ws + WS_RS), (const float*)(ws + WS_CS)};
                S.i0 = 0; S.n = 1 << 30; pg8::gemm_phase<2>(lds, g, S, E);
                if (G == 256 && (int)blockIdx.x >= 216) { int f, n; __syncthreads(); quota(2 * NEXP * MOE_I - M1_TAILS + M1_T2, M1_T3, 40, (int)blockIdx.x - 216, f, n); moe_convert(ap, lds, 0, f, n); } }
            SEAM(8);
            if (IN(9)) { pg8::Gemm g{ACT, (const bf16*)(ws + WS_WF2), DFF / 2}; pg8::CtxTailOrder S; S.so.init(32, D / 256, G, (int)blockIdx.x, DFF / 128); S.SK = 11; S.two = 0;
                pg8::EpiResidT<false, false> E{XW, MOD, 5, (float*)(ws + WS_SLAB), pg8::DS2}; pg8::gemm_phase<1, pg8::EpiResidT<false, false>, pg8::CtxTailOrder, true>(lds, g, S, E);
                if (G == 256 && (int)blockIdx.x >= 176) { int f, n; __syncthreads(); quota(2 * NEXP * MOE_I - M1_TAILS + M1_T2 + M1_T3, M1_T4, 80, (int)blockIdx.x - 176, f, n); moe_convert(ap, lds, 0, f, n); } }
            SEAM(9);
        } else {
            if (IN(17)) phase_gather(ap);
            SEAM(17);
            const int* pexp = (const int*)ctl + CW_PEXP;
            if (IN(18)) { const int npan = __builtin_amdgcn_readfirstlane(pexp[96]);
                pg8::Gemm g{(const bf16*)(ws + WS_HPERM), (const bf16*)(ws + WS_WM13), D / 2}; pg8::RangeOrder<pg8::MoeOrder> S; S.so.so.init(npan, 2 * DFFE / 256, G, (int)blockIdx.x, D / 128); S.so.pexp = pexp;
                pg8::EpiSwigluI8 E{(unsigned char*)ACT, -(DFFE / 128), (const float*)(ws + WS_RSS), (const float*)(ws + WS_CSM)};
                S.i0 = 0; S.n = 1 << 30; pg8::gemm_phase<2>(lds, g, S, E); }
            SEAM(18);
            if (IN(19)) { const int npan = __builtin_amdgcn_readfirstlane(pexp[96]);
                pg8::Gemm g{ACT, (const bf16*)(ws + WS_WM2), DFFE / 2}; pg8::MoeTailOrder S; S.so.init(npan, D / 256, G, (int)blockIdx.x, DFFE / 128); S.pexp = pexp; pg8::moe_tail_params(npan, D / 256, G, S.NF, S.R, S.SK);
                pg8::EpiStoreBf16T<false> E{(bf16*)(ws + WS_YS), D, (float*)(ws + WS_SLAB), pg8::DS2}; pg8::gemm_phase<1, pg8::EpiStoreBf16T<false>, pg8::MoeTailOrder, true>(lds, g, S, E); }
            SEAM(19);
            if (IN(20)) phase_combine(ap, 1);
        }
    }
#undef IN
#undef SEAM
}

extern "C" void kernel_launch(void* const* d_in, const int* in_sizes, int n_in, void* d_out, int out_size, void* d_ws, size_t ws_size, hipStream_t stream) {
    static int grid = 0;
    if (grid == 0) {
        if (n_in != 30 || out_size != NB * SEQ * D || ws_size < WS_END) { fprintf(stderr, "kernel_launch: unexpected shapes (n_in %d out %d ws %zu need %zu)\n", n_in, out_size, ws_size, (size_t)WS_END); grid = -1; return; }
        int dev = 0, cus = 0, per_cu = 0;
        if (hipGetDevice(&dev) != hipSuccess || hipDeviceGetAttribute(&cus, hipDeviceAttributeMultiprocessorCount, dev) != hipSuccess) { grid = -1; return; }
        if (hipFuncSetAttribute((const void*)mk_fwd, hipFuncAttributeMaxDynamicSharedMemorySize, LDS_BYTES) != hipSuccess) { fprintf(stderr, "kernel_launch: hipFuncSetAttribute failed\n"); grid = -1; return; }
        if (hipOccupancyMaxActiveBlocksPerMultiprocessor(&per_cu, (const void*)mk_fwd, NTHR, LDS_BYTES) != hipSuccess || per_cu < 1) { fprintf(stderr, "kernel_launch: occupancy query says %d\n", per_cu); grid = -1; return; }
        (void)hipGetLastError();
        grid = cus;
    }
    if (grid < 0) return;
    (void)hipMemsetAsync((char*)d_ws + WS_CTL, 0, CTL_ZERO_BYTES, stream);
    Args a{};
    for (int i = 0; i < 30; ++i) a.in[i] = (const float*)d_in[i];
    a.out = (float*)d_out; a.ws = (unsigned char*)d_ws;
#if MK_N_LAUNCHES == 1
    a.ph_lo = 0; a.ph_hi = NPHASE;
    hipLaunchKernelGGL(mk_fwd, dim3(grid), dim3(NTHR), LDS_BYTES, stream, a);
#else
    for (int p = 0; p < NPHASE; ++p) { a.ph_lo = p; a.ph_hi = p + 1; hipLaunchKernelGGL(mk_fwd, dim3(grid), dim3(NTHR), LDS_BYTES, stream, a); }
#endif
}
```
